# Optimizing an MI355X kernel written in HIP

```python
import jax, jax.numpy as jnp
from jax import lax
import numpy as np

D_MODEL = 1024
BATCH = 16
SEQ = 2048
DEPTH = 2
DEC_BATCH = 4
DEC_SEQ = 8192
PAST_LEN = 128

HEAD_DIM = 64
A_HEADS = 8
A_KV_HEADS = 2
A_GROUP = A_HEADS // A_KV_HEADS
A_RADIUS = 128
B_HEADS = 8
B_CONFIGS = ((128, 1), (512, 4), (2048, 16))
M_HEADS = 4
M_HEAD_DIM = 128
N_MEM = 256
N_BRANCH = 3
BRANCH_WIDTH = 512
D_FF = 2816
LN_EPS = 1e-5
ALPHA = (2 * DEPTH) ** 0.25
BETA = (8 * DEPTH) ** -0.25
NEG_INF = -1e30

QA_COLS = A_HEADS * HEAD_DIM
KVA_COLS = 2 * A_KV_HEADS * HEAD_DIM
QKVB_COLS = 3 * B_HEADS * HEAD_DIM
QM_COLS = M_HEADS * M_HEAD_DIM
GATE_COLS = N_BRANCH * D_MODEL
IN_COLS = QA_COLS + KVA_COLS + QKVB_COLS + QM_COLS + GATE_COLS

kernel_name = "hybrid_bidir_encoder"


def _alibi_slopes(n):
    return jnp.asarray(2.0 ** (-8.0 * np.arange(1, n + 1) / n), dtype=jnp.float32)


def _layer_norm(x, g, b):
    xf = x.astype(jnp.float32)
    mu = xf.mean(-1, keepdims=True)
    var = jnp.square(xf - mu).mean(-1, keepdims=True)
    return ((xf - mu) * lax.rsqrt(var + LN_EPS) * g.astype(jnp.float32) + b.astype(jnp.float32)).astype(x.dtype)


def _swiglu(x, w_in, w_out):
    gate, up = jnp.split(x @ w_in, 2, axis=-1)
    return (jax.nn.silu(gate) * up) @ w_out


def _banded_attention(q, k, v, radius, slopes, dist_scale, sink=None):
    bsz, length, n_kv, grp, dh = q.shape
    blk = radius
    nb = -(-length // blk)
    pad = nb * blk - length
    qb = jnp.pad(q, ((0, 0), (0, pad), (0, 0), (0, 0), (0, 0))).reshape(bsz, nb, blk, n_kv, grp, dh)

    def _blocks(t):
        tp = jnp.pad(t, ((0, 0), (blk, pad + blk), (0, 0), (0, 0))).reshape(bsz, nb + 2, blk, n_kv, dh)
        return jnp.concatenate([tp[:, :-2], tp[:, 1:-1], tp[:, 2:]], axis=2)

    kb, vb = _blocks(k), _blocks(v)
    s = jnp.einsum('bnqhgd,bnkhd->bnhgqk', qb, kb, preferred_element_type=jnp.float32) * (dh ** -0.5)
    qi = jnp.arange(blk)[:, None]
    ki = jnp.arange(3 * blk)[None, :]
    rel = ki - blk - qi
    dist = jnp.abs(rel).astype(jnp.float32) * dist_scale
    key_pos = jnp.arange(nb)[:, None, None] * blk - blk + ki[None]
    valid = (jnp.abs(rel)[None] <= radius) & (key_pos >= 0) & (key_pos < length)
    s = s - slopes[:, :, None, None] * dist
    s = jnp.where(valid[None, :, None, None], s, NEG_INF)
    m = s.max(-1)
    if sink is not None:
        m = jnp.maximum(m, sink[:, :, None])
    p = jnp.exp(s - m[..., None])
    denom = p.sum(-1)
    total = denom + jnp.exp(sink[:, :, None] - m) if sink is not None else denom
    o = jnp.einsum('bnhgqk,bnkhd->bnqhgd', p, vb.astype(jnp.float32))
    o = o / total.transpose(0, 1, 4, 2, 3)[..., None]
    o = o.reshape(bsz, nb * blk, n_kv, grp, dh)[:, :length]
    lse = (m + jnp.log(denom)).transpose(0, 1, 4, 2, 3).reshape(bsz, nb * blk, n_kv, grp)[:, :length]
    return o, lse


def _dilated_attention(q, k, v, slopes):
    bsz, seq, nh, dh = q.shape
    outs, lses = [], []
    for window, dil in B_CONFIGS:
        radius = window // (2 * dil)
        sub_len = seq // dil

        def _sub(t):
            return t.reshape(bsz, sub_len, dil, nh, dh).transpose(0, 2, 1, 3, 4).reshape(bsz * dil, sub_len, nh, dh)

        o, lse = _banded_attention(_sub(q)[:, :, :, None], _sub(k), _sub(v), radius, slopes[:, None], dil)
        outs.append(o.reshape(bsz, dil, sub_len, nh, dh).transpose(0, 2, 1, 3, 4).reshape(bsz, seq, nh, dh))
        lses.append(lse.reshape(bsz, dil, sub_len, nh).transpose(0, 2, 1, 3).reshape(bsz, seq, nh))
    w = jax.nn.softmax(jnp.stack(lses), axis=0)
    return jnp.einsum('cbsh,cbshd->bshd', w, jnp.stack(outs))


def _memory_attention(q, mem, w_mem_kv):
    bsz, n_mem, _ = mem.shape
    km, vm = jnp.split(mem @ w_mem_kv, 2, axis=-1)
    km = km.reshape(bsz, n_mem, M_HEADS, M_HEAD_DIM)
    vm = vm.reshape(bsz, n_mem, M_HEADS, M_HEAD_DIM)
    s = jnp.einsum('bshd,bmhd->bhsm', q, km, preferred_element_type=jnp.float32) * (M_HEAD_DIM ** -0.5)
    p = jax.nn.softmax(s, axis=-1)
    return jnp.einsum('bhsm,bmhd->bshd', p, vm.astype(jnp.float32))


def _token_mix(x, mem, w_in, w_mem_kv, sink_a, w_branch, w_out):
    bsz, seq, _ = x.shape
    h = x @ w_in
    q_a, kv_a, qkv_b, q_m, gates = jnp.split(
        h, [QA_COLS, QA_COLS + KVA_COLS, QA_COLS + KVA_COLS + QKVB_COLS, QA_COLS + KVA_COLS + QKVB_COLS + QM_COLS], axis=-1)
    k_a, v_a = jnp.split(kv_a.reshape(bsz, seq, 2, A_KV_HEADS, HEAD_DIM), 2, axis=2)
    o_a, _ = _banded_attention(q_a.reshape(bsz, seq, A_KV_HEADS, A_GROUP, HEAD_DIM), k_a[:, :, 0], v_a[:, :, 0], A_RADIUS,
                               _alibi_slopes(A_HEADS).reshape(A_KV_HEADS, A_GROUP), 1,
                               sink=sink_a.astype(jnp.float32).reshape(A_KV_HEADS, A_GROUP))
    qkv_b = qkv_b.reshape(bsz, seq, 3, B_HEADS, HEAD_DIM)
    o_b = _dilated_attention(qkv_b[:, :, 0], qkv_b[:, :, 1], qkv_b[:, :, 2], _alibi_slopes(B_HEADS))
    o_m = _memory_attention(q_m.reshape(bsz, seq, M_HEADS, M_HEAD_DIM), mem, w_mem_kv)
    branches = jnp.stack([o_a.reshape(bsz, seq, BRANCH_WIDTH), o_b.reshape(bsz, seq, BRANCH_WIDTH),
                          o_m.reshape(bsz, seq, BRANCH_WIDTH)], axis=2).astype(x.dtype)
    proj = jnp.einsum('bsie,ied->bsid', branches, w_branch)
    g = jax.nn.sigmoid(gates).reshape(bsz, seq, N_BRANCH, D_MODEL)
    return (g * proj).sum(axis=2) @ w_out


def setup_inputs(seed: int = 0) -> dict:
    key = jax.random.key(seed)
    ks = jax.random.split(key, 20)
    f32 = jnp.float32

    def nrm(k, shape, scale):
        return jax.random.normal(k, shape, f32) * scale

    return {
        "x_prompt": nrm(ks[0], (BATCH, SEQ, D_MODEL), 1.0),
        "x_sample": nrm(ks[1], (DEC_BATCH, DEC_SEQ, D_MODEL), 1.0),
        "mem_prompt": nrm(ks[2], (BATCH, N_MEM, D_MODEL), 1.0),
        "mem_sample": nrm(ks[3], (DEC_BATCH, N_MEM, D_MODEL), 1.0),
        "ffn1_w_in": nrm(ks[4], (DEPTH, D_MODEL, 2 * D_FF), D_MODEL ** -0.5),
        "ffn1_w_out": nrm(ks[5], (DEPTH, D_FF, D_MODEL), BETA * D_FF ** -0.5),
        "ln1_g": 1.0 + nrm(ks[6], (DEPTH, D_MODEL), 0.02),
        "ln1_b": nrm(ks[7], (DEPTH, D_MODEL), 0.02),
        "w_in": nrm(ks[8], (DEPTH, D_MODEL, IN_COLS), D_MODEL ** -0.5),
        "w_mem_kv": nrm(ks[9], (DEPTH, D_MODEL, 2 * QM_COLS), D_MODEL ** -0.5),
        "sink_a": nrm(ks[10], (DEPTH, A_HEADS), 1.0),
        "w_branch": nrm(ks[11], (DEPTH, N_BRANCH, BRANCH_WIDTH, D_MODEL), BRANCH_WIDTH ** -0.5),
        "w_out": nrm(ks[12], (DEPTH, D_MODEL, D_MODEL), BETA * D_MODEL ** -0.5),
        "ln2_g": 1.0 + nrm(ks[13], (DEPTH, D_MODEL), 0.02),
        "ln2_b": nrm(ks[14], (DEPTH, D_MODEL), 0.02),
        "ffn2_w_in": nrm(ks[15], (DEPTH, D_MODEL, 2 * D_FF), D_MODEL ** -0.5),
        "ffn2_w_out": nrm(ks[16], (DEPTH, D_FF, D_MODEL), BETA * D_FF ** -0.5),
        "ln3_g": 1.0 + nrm(ks[17], (DEPTH, D_MODEL), 0.02),
        "ln3_b": nrm(ks[18], (DEPTH, D_MODEL), 0.02),
    }


def reference(x_prompt, x_sample, mem_prompt, mem_sample, ffn1_w_in, ffn1_w_out, ln1_g, ln1_b, w_in, w_mem_kv,
              sink_a, w_branch, w_out, ln2_g, ln2_b, ffn2_w_in, ffn2_w_out, ln3_g, ln3_b):
    def trunk(x, mem):
        for l in range(DEPTH):
            x = _layer_norm(ALPHA * x + 0.5 * _swiglu(x, ffn1_w_in[l], ffn1_w_out[l]), ln1_g[l], ln1_b[l])
            x = _layer_norm(ALPHA * x + _token_mix(x, mem, w_in[l], w_mem_kv[l], sink_a[l], w_branch[l], w_out[l]),
                            ln2_g[l], ln2_b[l])
            x = _layer_norm(ALPHA * x + 0.5 * _swiglu(x, ffn2_w_in[l], ffn2_w_out[l]), ln3_g[l], ln3_b[l])
        return x

    y_prompt = trunk(x_prompt, mem_prompt)
    y_sample = trunk(x_sample, mem_sample)
    return (y_prompt, y_sample)
```

```cpp
#include <hip/hip_runtime.h>
#include <hip/hip_cooperative_groups.h>
#include <cstdio>
#include <cstdint>
namespace cg = cooperative_groups;

#define LAS __attribute__((address_space(3)))
typedef unsigned short bf16_t;
typedef short bf16x8 __attribute__((ext_vector_type(8)));
typedef short s16x4 __attribute__((ext_vector_type(4)));
typedef float f32x4 __attribute__((ext_vector_type(4)));
typedef float f32x2 __attribute__((ext_vector_type(2)));
typedef unsigned u32x4 __attribute__((ext_vector_type(4)));
typedef unsigned u32x2 __attribute__((ext_vector_type(2)));

constexpr int D = 1024, DFF = 2816, NLAYER = 2;
constexpr int TC = 16384;
constexpr int NCHUNK = 4;
constexpr int INC = 5888, PROJC = 2816, GATEC = 3072, BRC = 1536;
constexpr int NMEM = 256, MEMROWS = 5120;
constexpr float LN_EPS = 1e-5f;
constexpr float ALPHA = 1.41421356237309515f;
constexpr float LOG2E = 1.44269504088896341f;

constexpr size_t MiB = 1u << 20;
constexpr size_t W_LAYER_ELEMS = (size_t)5632 * 1024 + (size_t)1024 * 2816 + (size_t)5888 * 1024 + (size_t)3 * 1024 * 512 + (size_t)1024 * 1024 + (size_t)5632 * 1024 + (size_t)1024 * 2816;
constexpr size_t OFF_W1IN = 0, OFF_W1OUT = OFF_W1IN + (size_t)5632 * 1024, OFF_WIN = OFF_W1OUT + (size_t)1024 * 2816, OFF_WBR = OFF_WIN + (size_t)5888 * 1024,
                 OFF_WOUT = OFF_WBR + (size_t)3 * 1024 * 512, OFF_W2IN = OFF_WOUT + (size_t)1024 * 1024, OFF_W2OUT = OFF_W2IN + (size_t)5632 * 1024;
constexpr size_t WS_W = 0;
constexpr size_t WS_WMEM = 100 * MiB;
constexpr size_t WS_MEMB = 108 * MiB;
constexpr size_t WS_MEMKV = 118 * MiB;
constexpr size_t WS_XB = 158 * MiB;
constexpr size_t WS_U = 190 * MiB;
constexpr size_t U_H = 0;
constexpr size_t U_PROJ = 0;
constexpr size_t U_GATES = 88 * MiB;
constexpr size_t U_BR = 184 * MiB;
constexpr size_t U_BPART = 232 * MiB;
constexpr size_t U_LSE = 280 * MiB;
constexpr size_t U_MIXF = 0;
constexpr size_t U_MIXB = 232 * MiB;
constexpr size_t WS_X16 = WS_U + 282 * MiB;
constexpr size_t WS_CTL = WS_X16 + 32 * MiB;
constexpr size_t CTL_BYTES = 32768;
constexpr size_t CTL_XBUF = 65536;
constexpr size_t WS_END = WS_CTL + 1 * MiB;
static_assert(W_LAYER_ELEMS * 2 * 2 <= 100 * MiB, "weights fit");

constexpr int REP_ATT = 1, REP_UP = 1, REP_INPROJ = 1, REP_BR = 1, REP_PRO = 1, REP_SYNC = 1, REP_CMB = 1;
constexpr int LDS_BYTES = 147456 + 256;
constexpr int LDS_MISC = 147456;

__device__ __forceinline__ unsigned cvt_pk_bf16(float lo, float hi) { unsigned r; asm("v_cvt_pk_bf16_f32 %0, %1, %2" : "=v"(r) : "v"(lo), "v"(hi)); return r; }
__device__ __forceinline__ float bf_lo(unsigned u) { return __uint_as_float(u << 16); }
__device__ __forceinline__ float bf_hi(unsigned u) { return __uint_as_float(u & 0xffff0000u); }
typedef _Float16 f16x2 __attribute__((ext_vector_type(2)));
__device__ __forceinline__ unsigned cvt_pk_h(float lo, float hi) { const f16x2 v = {(_Float16)lo, (_Float16)hi}; return __builtin_bit_cast(unsigned, v); }
__device__ __forceinline__ float h_lo(unsigned u) { return (float)__builtin_bit_cast(f16x2, u)[0]; }
__device__ __forceinline__ float h_hi(unsigned u) { return (float)__builtin_bit_cast(f16x2, u)[1]; }
__device__ __forceinline__ float fast_exp2(float x) { return __builtin_amdgcn_exp2f(x); }
__device__ __forceinline__ float fast_rcp(float x) { return __builtin_amdgcn_rcpf(x); }
__device__ __forceinline__ float sigmoidf_fast(float v) { return fast_rcp(1.0f + fast_exp2(-LOG2E * v)); }
__device__ __forceinline__ float wave_sum(float v) {
#pragma unroll
    for (int o = 1; o < 64; o <<= 1) v += __shfl_xor(v, o);
    return v;
}

#define XB_TMO      128
#define XB_XCNT(j)  (256  + 64 * (j))
#define XB_XSUB(j)  (1280 + 64 * (j))
#define XB_XGEN(j)  (2304 + 64 * (j))
#define XB_TOP      3328
#define XB_TOPGEN   3392
#define XCD_BAR_WORDS 3456
#define XB_SPIN_CAP (1u << 18)

__device__ __forceinline__ unsigned xb_ld(unsigned* p)              { return __hip_atomic_load(p, __ATOMIC_RELAXED, __HIP_MEMORY_SCOPE_AGENT); }
__device__ __forceinline__ unsigned xb_add(unsigned* p, unsigned v) { return __hip_atomic_fetch_add(p, v, __ATOMIC_RELAXED, __HIP_MEMORY_SCOPE_AGENT); }
__device__ __forceinline__ unsigned xb_xcc_id() { return (unsigned)__builtin_amdgcn_s_getreg((3 << 11) | 20) & 0xFu; }
#define XB_SPIN(cond, bar) do { unsigned _sp = 0; while (cond) { __builtin_amdgcn_s_sleep(1); \
    if ((++_sp & 255u) == 0u) { if (xb_ld(&(bar)[XB_TMO])) break; if (_sp > XB_SPIN_CAP) { atomicAdd(&(bar)[XB_TMO], 1u); break; } } } } while (0)

struct XcdBarrier {
    unsigned* bar; unsigned x;
    volatile LAS unsigned* st;
};

__device__ __forceinline__ XcdBarrier xcd_barrier_post(unsigned* bar, volatile LAS unsigned* st) {
    XcdBarrier b; b.bar = bar; b.x = xb_xcc_id(); b.st = st;
    if (threadIdx.x == 0) (void)xb_add(&bar[XB_XCNT(b.x)], 1u);
    return b;
}
__device__ __forceinline__ void xcd_barrier_complete(unsigned* bar, unsigned x, unsigned& nloc, unsigned& nx) {
    const unsigned G = gridDim.x * gridDim.y * gridDim.z;
    unsigned sum, cnt, mine, sp = 0u;
    for (;;) {
        sum = 0u; cnt = 0u; mine = 0u;
#pragma unroll
        for (unsigned j = 0; j < 16; ++j) { const unsigned c = xb_ld(&bar[XB_XCNT(j)]); sum += c; cnt += (c > 0u) ? 1u : 0u; mine = (j == x) ? c : mine; }
        if (sum == G) break;
        __builtin_amdgcn_s_sleep(1);
        if ((++sp & 255u) == 0u) { if (xb_ld(&bar[XB_TMO])) break; if (sp > XB_SPIN_CAP) { atomicAdd(&bar[XB_TMO], 1u); break; } }
    }
    nloc = mine > 0u ? mine : 1u; nx = cnt > 0u ? cnt : 1u;
}

__device__ __forceinline__ void xcd_barrier(const XcdBarrier& b) {
    asm volatile("s_waitcnt vmcnt(0)" ::: "memory");
    __syncthreads();
    if (threadIdx.x == 0) {
        unsigned* bar = b.bar;
        __builtin_amdgcn_s_waitcnt(0);
        unsigned nloc = b.st[0], nx = b.st[1];
        if (nloc == 0u) { xcd_barrier_complete(bar, b.x, nloc, nx); b.st[0] = nloc; b.st[1] = nx; }
        const unsigned old = xb_add(&bar[XB_XSUB(b.x)], 1u);
        const unsigned gen = old / nloc;
        if (old + 1u == (gen + 1u) * nloc) {
            __builtin_amdgcn_fence(__ATOMIC_RELEASE, "agent");
            asm volatile("s_waitcnt vmcnt(0)" ::: "memory");
            const unsigned og = xb_add(&bar[XB_TOP], 1u);
            const unsigned tg = og / nx;
            if (og + 1u == (tg + 1u) * nx) xb_add(&bar[XB_TOPGEN], 1u);
            else XB_SPIN(xb_ld(&bar[XB_TOPGEN]) == tg, bar);
            __builtin_amdgcn_fence(__ATOMIC_ACQUIRE, "agent");
            xb_add(&bar[XB_XGEN(b.x)], 1u);
            asm volatile("s_waitcnt vmcnt(0)" ::: "memory");
        } else {
            XB_SPIN(xb_ld(&bar[XB_XGEN(b.x)]) == gen, bar);
            __builtin_amdgcn_fence(__ATOMIC_ACQUIRE, "agent");
            asm volatile("s_waitcnt vmcnt(0)" ::: "memory");
        }
    }
    __syncthreads();
}


namespace pg8 {
constexpr int BM = 256, BK = 64, HALF = 128, HTB = HALF * BK * 2, STAGE_BYTES = 8 * HTB, NXCD = 8, WGM = 8;
__host__ __device__ __forceinline__ int lds_byte(int r, int c) { const int st = (r >> 4) * 2 + (c >> 5), rr = r & 15, cc = c & 31, ob = rr * 64 + cc * 2; return st * 1024 + (ob ^ (((ob >> 9) & 1) << 5)); }
__host__ __device__ __forceinline__ void stage_rc(int b, int& R, int& C) { const int st = b / 1024, sb = b % 1024, swz = sb ^ (((sb >> 9) & 1) << 5); R = (st >> 1) * 16 + swz / 64; C = (st & 1) * 32 + (swz % 64) / 2; }
__host__ __device__ __forceinline__ int perm32(int rho) { const int n = rho >> 4, i = rho & 15; return 8 * (i >> 2) + 4 * n + (i & 3); }

struct Unit { int pm, pn, z; };
struct Gemm { const bf16_t* A; const bf16_t* Bt; int M, N, K, lda, ldb; size_t za, zb; };

struct Order {
    int nM, nN, nZ, nwg, G, c;
    __device__ void init(int M, int N, int nZ_, int G_, int c_) { nM = M / BM; nN = N / BM; nZ = nZ_; nwg = nM * nN; G = G_; c = c_; }
    __device__ bool next(int i, Unit& u) const {
        const int ti = i / nZ; u.z = i - ti * nZ;
        const long L = (long)ti * G + c; if (L >= nwg) return false;
        int wgid = (int)L; { const int q = nwg / NXCD, r = nwg % NXCD, xcd = wgid % NXCD, off = wgid / NXCD; wgid = (xcd < r ? xcd * (q + 1) : r * (q + 1) + (xcd - r) * q) + off; }
        const int nig = WGM * nN, gid = wgid / nig, fm = gid * WGM, gsz = (nM - fm) < WGM ? (nM - fm) : WGM;
        u.pm = fm + ((wgid % nig) % gsz); u.pn = (wgid % nig) / gsz; return true;
    }
};

template <class Epi>
__device__ __forceinline__ void gemm_phase(LAS unsigned char* lds, const Gemm g, const Order& S, const Epi& E) {
    int tid = threadIdx.x; asm volatile("" : "+v"(tid));
    const int wid = __builtin_amdgcn_readfirstlane(tid >> 6), lane = tid & 63, wr = wid >> 2, wc = wid & 3, fr = lane & 15, fq = lane >> 4;
    const int K = g.K, nt = K / BK;
    unsigned voffA[2], voffB[2];
#pragma unroll
    for (int i = 0; i < 2; ++i) { int R, C; stage_rc(tid * 16 + i * 8192, R, C); const int Rb = Epi::PERM ? ((R & ~31) + perm32(R & 31)) : R;
        voffA[i] = (unsigned)(R * g.lda + C) * 2u; voffB[i] = (unsigned)(Rb * g.ldb + C) * 2u; }
    const size_t kstep = (size_t)(BK * 2);
    const size_t hstepA = (size_t)HALF * g.lda * 2, hstepB = (size_t)HALF * g.ldb * 2;
    const unsigned ldsw = (unsigned)wid * 1024u;
    const int aoff = lds_byte(wr * 64 + fr, fq * 8), boff = lds_byte(wc * 32 + fr, fq * 8);
#define PG8_SA(b, h) (((b) * 2 + (h)) * HTB)
#define PG8_SB(b, h) ((4 + (b) * 2 + (h)) * HTB)
#define PG8_STAGE(bufoff, gbase, voff) do { _Pragma("unroll") for (int _i = 0; _i < 2; ++_i) \
        __builtin_amdgcn_global_load_lds((const unsigned*)((const char*)(gbase) + (voff)[_i]), (LAS unsigned*)(lds + (bufoff) + ldsw + _i * 8192), 16, 0, 0); } while (0)
#define PG8_LDA(dst, b, h) do { _Pragma("unroll") for (int m = 0; m < 4; ++m) _Pragma("unroll") for (int k = 0; k < 2; ++k) dst[m][k] = *(const LAS bf16x8*)(lds + PG8_SA(b, h) + aoff + m * 2048 + k * 1024); } while (0)
#define PG8_LDB(dst, b, h) do { _Pragma("unroll") for (int n = 0; n < 2; ++n) _Pragma("unroll") for (int k = 0; k < 2; ++k) dst[n][k] = *(const LAS bf16x8*)(lds + PG8_SB(b, h) + boff + n * 2048 + k * 1024); } while (0)
#define PG8_MMA(ai, bj, At, Bt) do { __builtin_amdgcn_s_setprio(1); _Pragma("unroll") for (int m = 0; m < 4; ++m) _Pragma("unroll") for (int n = 0; n < 2; ++n) _Pragma("unroll") for (int k = 0; k < 2; ++k) \
        acc[ai][bj][m][n] = __builtin_amdgcn_mfma_f32_16x16x32_bf16(Bt[n][k], At[m][k], acc[ai][bj][m][n], 0, 0, 0); __builtin_amdgcn_s_setprio(0); } while (0)
#define PG8_WAIT_V(n) asm volatile("s_waitcnt vmcnt(" #n ")" ::: "memory")
#define PG8_WAIT_L(n) asm volatile("s_waitcnt lgkmcnt(" #n ")" ::: "memory")
#define PG8_BAR __builtin_amdgcn_s_barrier()
#define PG8_SCHED __builtin_amdgcn_sched_barrier(0)
    Unit cur, nxt; int ui = 0;
    if (!S.next(0, cur)) return;
    f32x4 acc[2][2][4][2];
#pragma unroll
    for (int a = 0; a < 2; ++a)
#pragma unroll
        for (int b = 0; b < 2; ++b)
#pragma unroll
            for (int m = 0; m < 4; ++m)
#pragma unroll
                for (int n = 0; n < 2; ++n) acc[a][b][m][n] = (f32x4){0.f, 0.f, 0.f, 0.f};
    bf16x8 At[4][2], B0[2][2], B1[2][2];
    const char* cA = (const char*)(g.A + (size_t)cur.pm * BM * g.lda + (size_t)cur.z * g.za);
    const char* cB = (const char*)(g.Bt + (size_t)cur.pn * BM * g.ldb + (size_t)cur.z * g.zb);
    PG8_STAGE(PG8_SB(0, 0), cB, voffB); PG8_STAGE(PG8_SA(0, 0), cA, voffA); PG8_STAGE(PG8_SB(0, 1), cB + hstepB, voffB); PG8_STAGE(PG8_SA(0, 1), cA + hstepA, voffA);
    if (wr == 1) PG8_BAR;
    PG8_WAIT_V(4); PG8_BAR;
    PG8_STAGE(PG8_SB(1, 0), cB + kstep, voffB); PG8_STAGE(PG8_SA(1, 0), cA + kstep, voffA); PG8_STAGE(PG8_SB(1, 1), cB + hstepB + kstep, voffB);
    PG8_WAIT_V(6); PG8_BAR;
    for (;;) {
        const bool has_next = S.next(ui + 1, nxt);
        const char* nA = has_next ? (const char*)(g.A + (size_t)nxt.pm * BM * g.lda + (size_t)nxt.z * g.za) : cA;
        const char* nB = has_next ? (const char*)(g.Bt + (size_t)nxt.pn * BM * g.ldb + (size_t)nxt.z * g.zb) : cB;
        for (int t = 0; t < nt; t += 2) {
            const bool last = (t == nt - 2);
            const char* a1 = cA + (size_t)(t + 1) * kstep;
            const char* a2 = last ? nA : cA + (size_t)(t + 2) * kstep; const char* b2 = last ? nB : cB + (size_t)(t + 2) * kstep;
            const char* a3 = a2 + kstep; const char* b3 = b2 + kstep;
            PG8_LDB(B0, 0, 0); PG8_SCHED; PG8_LDA(At, 0, 0); PG8_STAGE(PG8_SA(1, 1), a1 + hstepA, voffA);
            PG8_WAIT_L(8); PG8_BAR; PG8_WAIT_L(0); PG8_MMA(0, 0, At, B0); PG8_BAR; PG8_SCHED;
            PG8_LDB(B1, 0, 1); PG8_STAGE(PG8_SB(0, 0), b2, voffB);
            PG8_BAR; PG8_WAIT_L(0); PG8_MMA(0, 1, At, B1); PG8_BAR;
            PG8_LDA(At, 0, 1); PG8_STAGE(PG8_SA(0, 0), a2, voffA);
            PG8_BAR; PG8_WAIT_L(0); PG8_MMA(1, 0, At, B0); PG8_BAR; PG8_SCHED;
            PG8_STAGE(PG8_SB(0, 1), b2 + hstepB, voffB);
            PG8_WAIT_V(6); PG8_BAR; PG8_MMA(1, 1, At, B1); PG8_BAR;
            PG8_LDB(B0, 1, 0); PG8_SCHED; PG8_LDA(At, 1, 0); PG8_STAGE(PG8_SA(0, 1), a2 + hstepA, voffA);
            PG8_WAIT_L(8); PG8_BAR; PG8_WAIT_L(0); PG8_MMA(0, 0, At, B0); PG8_BAR; PG8_SCHED;
            PG8_LDB(B1, 1, 1); PG8_STAGE(PG8_SB(1, 0), b3, voffB);
            PG8_BAR; PG8_WAIT_L(0); PG8_MMA(0, 1, At, B1); PG8_BAR;
            PG8_LDA(At, 1, 1); PG8_STAGE(PG8_SA(1, 0), a3, voffA);
            PG8_BAR; PG8_WAIT_L(0); PG8_MMA(1, 0, At, B0); PG8_BAR; PG8_SCHED;
            PG8_STAGE(PG8_SB(1, 1), b3 + hstepB, voffB);
            PG8_WAIT_V(6); PG8_BAR; PG8_MMA(1, 1, At, B1); PG8_BAR;
        }
        if constexpr (!Epi::AFTER_DRAIN) E(acc, cur, wr, wc, fr, fq);
        if (!has_next) break;
        if (!(Epi::KEEP_ACC && nxt.z != 0)) {
#pragma unroll
        for (int a = 0; a < 2; ++a)
#pragma unroll
            for (int b = 0; b < 2; ++b)
#pragma unroll
                for (int m = 0; m < 4; ++m)
#pragma unroll
                    for (int n = 0; n < 2; ++n) acc[a][b][m][n] = (f32x4){0.f, 0.f, 0.f, 0.f};
        }
        cur = nxt; cA = nA; cB = nB; ++ui;
    }
    PG8_WAIT_V(0);
    if (wr == 0) PG8_BAR;
    PG8_BAR;
    if constexpr (Epi::AFTER_DRAIN) E.fused(acc, cur, wr, wc, fr, fq, lds, wid, lane);
#undef PG8_SA
#undef PG8_SB
#undef PG8_STAGE
#undef PG8_LDA
#undef PG8_LDB
#undef PG8_MMA
#undef PG8_WAIT_V
#undef PG8_WAIT_L
#undef PG8_BAR
#undef PG8_SCHED
}

struct EpiSwiglu {
    static constexpr bool PERM = true, AFTER_DRAIN = false, KEEP_ACC = false;
    bf16_t* O; int ldc;
    __device__ __forceinline__ void operator()(const f32x4 (&acc)[2][2][4][2], const Unit& u, int wr, int wc, int fr, int fq) const {
        const int row0 = u.pm * BM + wr * 64 + fr, col0 = u.pn * HALF + wc * 32 + 8 * fq;
#pragma unroll
        for (int ai = 0; ai < 2; ++ai)
#pragma unroll
            for (int m = 0; m < 4; ++m) {
                bf16_t* rowp = O + (size_t)(row0 + ai * HALF + m * 16) * ldc + col0;
                float r[8];
#pragma unroll
                for (int n = 0; n < 2; ++n)
#pragma unroll
                    for (int j = 0; j < 4; ++j) { const float gv = acc[ai][0][m][n][j], uv = acc[ai][1][m][n][j]; r[n * 4 + j] = gv * sigmoidf_fast(gv) * uv; }
                u32x4 w; w.x = cvt_pk_bf16(r[0], r[1]); w.y = cvt_pk_bf16(r[2], r[3]); w.z = cvt_pk_bf16(r[4], r[5]); w.w = cvt_pk_bf16(r[6], r[7]);
                *(u32x4*)rowp = w;
            }
    }
};
struct EpiResidLN {
    static constexpr bool PERM = true, AFTER_DRAIN = true, KEEP_ACC = false;
    float* xout; bf16_t* X16; bf16_t* XB; const float* gam; const float* bet; float beta;
    unsigned long long* xbuf; unsigned* cnt; unsigned want;
    __device__ __forceinline__ void fused(f32x4 (&acc)[2][2][4][2], const Unit& u, int wr, int wc, int fr, int fq, LAS unsigned char* lds, int wid, int lane) const {
        LAS f32x2* P = (LAS f32x2*)lds;
        LAS f32x2* S = (LAS f32x2*)(lds + 8192);
        const int row0 = u.pm * BM + wr * 64 + fr, col0 = u.pn * BM + wc * 32 + 8 * fq;
        {
            u32x4 hw[2][2];
#pragma unroll
            for (int bj = 0; bj < 2; ++bj) hw[0][bj] = *(const u32x4*)(X16 + (size_t)row0 * D + col0 + bj * HALF);
#pragma unroll
            for (int gi = 0; gi < 8; ++gi) {
                const int ai = gi >> 2, m = gi & 3;
                if (gi + 1 < 8) { const int ai1 = (gi + 1) >> 2, m1 = (gi + 1) & 3;
#pragma unroll
                    for (int bj = 0; bj < 2; ++bj) hw[(gi + 1) & 1][bj] = *(const u32x4*)(X16 + (size_t)(row0 + ai1 * HALF + m1 * 16) * D + col0 + bj * HALF); }
                asm volatile("" ::: "memory");
#pragma unroll
                for (int bj = 0; bj < 2; ++bj) { const u32x4 h = hw[gi & 1][bj];
                    const f32x4 x0 = (f32x4){h_lo(h.x), h_hi(h.x), h_lo(h.y), h_hi(h.y)}, x1 = (f32x4){h_lo(h.z), h_hi(h.z), h_lo(h.w), h_hi(h.w)};
                    acc[ai][bj][m][0] = x0 * ALPHA + acc[ai][bj][m][0] * beta; acc[ai][bj][m][1] = x1 * ALPHA + acc[ai][bj][m][1] * beta; }
                asm volatile("" : "+v"(acc[ai][0][m][0]), "+v"(acc[ai][0][m][1]), "+v"(acc[ai][1][m][0]), "+v"(acc[ai][1][m][1]));
            }
        }
#pragma unroll
        for (int ai = 0; ai < 2; ++ai)
#pragma unroll
            for (int m = 0; m < 4; ++m) {
                float s = 0.f;
#pragma unroll
                for (int bj = 0; bj < 2; ++bj)
#pragma unroll
                    for (int n = 0; n < 2; ++n) { const f32x4 x = acc[ai][bj][m][n]; s += (x[0] + x[1]) + (x[2] + x[3]); }
                s += __shfl_xor(s, 16); s += __shfl_xor(s, 32);
                const float mw = s * (1.0f / 64.0f); float q = 0.f;
#pragma unroll
                for (int bj = 0; bj < 2; ++bj)
#pragma unroll
                    for (int n = 0; n < 2; ++n) { const f32x4 d = acc[ai][bj][m][n] - mw; q += (d[0] * d[0] + d[1] * d[1]) + (d[2] * d[2] + d[3] * d[3]); }
                q += __shfl_xor(q, 16); q += __shfl_xor(q, 32);
                if (fq == 0) P[(ai * HALF + wr * 64 + m * 16 + fr) * 4 + wc] = (f32x2){mw, q};
            }
        asm volatile("s_waitcnt lgkmcnt(0)" ::: "memory"); __builtin_amdgcn_s_barrier(); asm volatile("" ::: "memory");
        const int row = wid * 32 + (lane & 31);
        if (lane < 32) {
            const f32x2 a = P[row * 4 + 0], b = P[row * 4 + 1], c = P[row * 4 + 2], d = P[row * 4 + 3];
            const float mt = (a.x + b.x + c.x + d.x) * 0.25f;
            const float da = a.x - mt, db = b.x - mt, dc = c.x - mt, dd = d.x - mt;
            const float m2 = (a.y + b.y) + (c.y + d.y) + 64.0f * ((da * da + db * db) + (dc * dc + dd * dd));
            unsigned long long* slot = xbuf + ((size_t)((u.pm & 63) * BM + row) * 4 + u.pn);
            __hip_atomic_store(slot, ((unsigned long long)__float_as_uint(m2) << 32) | __float_as_uint(mt), __ATOMIC_RELAXED, __HIP_MEMORY_SCOPE_AGENT);
        }
        asm volatile("s_waitcnt vmcnt(0)" ::: "memory");
        if (lane == 0) __hip_atomic_fetch_add(cnt + 64 * (u.pm & 63), 1u, __ATOMIC_RELAXED, __HIP_MEMORY_SCOPE_AGENT);
        if (wid == 0) {
            unsigned spins = 0;
            while ((unsigned)__builtin_amdgcn_readfirstlane(__hip_atomic_load(cnt + 64 * (u.pm & 63), __ATOMIC_RELAXED, __HIP_MEMORY_SCOPE_AGENT)) < want) { __builtin_amdgcn_s_sleep(2); if (++spins > (1u << 22)) break; }
            __builtin_amdgcn_fence(__ATOMIC_ACQUIRE, "agent");
        }
        asm volatile("s_waitcnt vmcnt(0) lgkmcnt(0)" ::: "memory"); __builtin_amdgcn_s_barrier(); asm volatile("" ::: "memory");
        if (lane < 32) {
            const unsigned long long* slot = xbuf + (size_t)((u.pm & 63) * BM + row) * 4; float mt[4], m2[4]; float ms = 0.f;
#pragma unroll
            for (int t = 0; t < 4; ++t) { const unsigned long long w = __hip_atomic_load(slot + t, __ATOMIC_RELAXED, __HIP_MEMORY_SCOPE_AGENT); mt[t] = __uint_as_float((unsigned)w); m2[t] = __uint_as_float((unsigned)(w >> 32)); ms += mt[t]; }
            const float mean = ms * 0.25f; float q = 0.f;
#pragma unroll
            for (int t = 0; t < 4; ++t) { const float dm = mt[t] - mean; q += m2[t] + 256.0f * dm * dm; }
            S[row] = (f32x2){mean, 1.0f / sqrtf(q * (1.0f / 1024.0f) + LN_EPS)};
        }
        asm volatile("s_waitcnt lgkmcnt(0)" ::: "memory"); __builtin_amdgcn_s_barrier(); asm volatile("" ::: "memory");
        f32x4 gv[2][2], bv[2][2];
#pragma unroll
        for (int bj = 0; bj < 2; ++bj)
#pragma unroll
            for (int n = 0; n < 2; ++n) { gv[bj][n] = *(const f32x4*)(gam + col0 + bj * HALF + 4 * n); bv[bj][n] = *(const f32x4*)(bet + col0 + bj * HALF + 4 * n); }
#pragma unroll
        for (int ai = 0; ai < 2; ++ai)
#pragma unroll
            for (int m = 0; m < 4; ++m) { const int r = ai * HALF + wr * 64 + m * 16 + fr; const f32x2 sr = S[r]; const size_t off = (size_t)(u.pm * BM + r) * D + col0;
#pragma unroll
                for (int bj = 0; bj < 2; ++bj) {
                    const f32x4 y0 = (acc[ai][bj][m][0] - sr.x) * sr.y * gv[bj][0] + bv[bj][0], y1 = (acc[ai][bj][m][1] - sr.x) * sr.y * gv[bj][1] + bv[bj][1];
                    if (xout) { *(f32x4*)(xout + off + bj * HALF) = y0; *(f32x4*)(xout + off + bj * HALF + 4) = y1; }
                    else { u32x4 hw; hw.x = cvt_pk_h(y0[0], y0[1]); hw.y = cvt_pk_h(y0[2], y0[3]); hw.z = cvt_pk_h(y1[0], y1[1]); hw.w = cvt_pk_h(y1[2], y1[3]); *(u32x4*)(X16 + off + bj * HALF) = hw;
                        u32x4 w; w.x = cvt_pk_bf16(y0[0], y0[1]); w.y = cvt_pk_bf16(y0[2], y0[3]); w.z = cvt_pk_bf16(y1[0], y1[1]); w.w = cvt_pk_bf16(y1[2], y1[3]); *(u32x4*)(XB + off + bj * HALF) = w; } }
                asm volatile("" ::: "memory"); }
    }
};
struct EpiInproj {
    static constexpr bool PERM = true, AFTER_DRAIN = false, KEEP_ACC = false;
    bf16_t* P; bf16_t* G;
    __device__ __forceinline__ void operator()(const f32x4 (&acc)[2][2][4][2], const Unit& u, int wr, int wc, int fr, int fq) const {
        const bool isg = u.pn >= 11;
        bf16_t* base = isg ? G : P; const int ldc = isg ? GATEC : PROJC; const int colt = isg ? (u.pn - 11) * BM : u.pn * BM;
        const int row0 = u.pm * BM + wr * 64 + fr, col0 = colt + wc * 32 + 8 * fq;
#pragma unroll
        for (int ai = 0; ai < 2; ++ai)
#pragma unroll
            for (int m = 0; m < 4; ++m) { bf16_t* rowp = base + (size_t)(row0 + ai * HALF + m * 16) * ldc + col0;
#pragma unroll
                for (int bj = 0; bj < 2; ++bj) { f32x4 v0 = acc[ai][bj][m][0], v1 = acc[ai][bj][m][1];
                    if (isg) {
#pragma unroll
                        for (int j = 0; j < 4; ++j) { v0[j] = fmaxf(sigmoidf_fast(v0[j]), 1e-30f); v1[j] = fmaxf(sigmoidf_fast(v1[j]), 1e-30f); } }
                    u32x4 w; w.x = cvt_pk_bf16(v0[0], v0[1]); w.y = cvt_pk_bf16(v0[2], v0[3]); w.z = cvt_pk_bf16(v1[0], v1[1]); w.w = cvt_pk_bf16(v1[2], v1[3]);
                    *(u32x4*)(rowp + bj * HALF) = w; } }
    }
};
struct EpiBf16Plain {
    static constexpr bool PERM = true, AFTER_DRAIN = false, KEEP_ACC = false;
    bf16_t* O; int ldc;
    __device__ __forceinline__ void operator()(const f32x4 (&acc)[2][2][4][2], const Unit& u, int wr, int wc, int fr, int fq) const {
        const int row0 = u.pm * BM + wr * 64 + fr, col0 = u.pn * BM + wc * 32 + 8 * fq;
#pragma unroll
        for (int ai = 0; ai < 2; ++ai)
#pragma unroll
            for (int m = 0; m < 4; ++m) { bf16_t* rowp = O + (size_t)(row0 + ai * HALF + m * 16) * ldc + col0;
#pragma unroll
                for (int bj = 0; bj < 2; ++bj) { const f32x4 v0 = acc[ai][bj][m][0], v1 = acc[ai][bj][m][1];
                    u32x4 w; w.x = cvt_pk_bf16(v0[0], v0[1]); w.y = cvt_pk_bf16(v0[2], v0[3]); w.z = cvt_pk_bf16(v1[0], v1[1]); w.w = cvt_pk_bf16(v1[2], v1[3]);
                    *(u32x4*)(rowp + bj * HALF) = w; } }
    }
};
struct EpiBranch {
    static constexpr bool PERM = true, AFTER_DRAIN = false, KEEP_ACC = true;
    const bf16_t* G; bf16_t* O;
    __device__ __forceinline__ void operator()(f32x4 (&acc)[2][2][4][2], const Unit& u, int wr, int wc, int fr, int fq) const {
        const int row0 = u.pm * BM + wr * 64 + fr, col0 = u.pn * BM + wc * 32 + 8 * fq;
        const bool mid = u.z < 2;
        const bf16_t* g0p = G + (size_t)u.z * D + col0; const bf16_t* g1p = G + (size_t)(mid ? u.z + 1 : u.z) * D + col0;
        u32x4 gq[2][2][2];
#pragma unroll
        for (int bj = 0; bj < 2; ++bj) { gq[0][bj][0] = *(const u32x4*)(g0p + (size_t)row0 * GATEC + bj * HALF); gq[0][bj][1] = *(const u32x4*)(g1p + (size_t)row0 * GATEC + bj * HALF); }
#pragma unroll
        for (int gi = 0; gi < 8; ++gi) {
            const int ai = gi >> 2, m = gi & 3; const size_t row = (size_t)(row0 + ai * HALF + m * 16);
            if (gi + 1 < 8) { const size_t row1 = (size_t)(row0 + ((gi + 1) >> 2) * HALF + ((gi + 1) & 3) * 16);
#pragma unroll
                for (int bj = 0; bj < 2; ++bj) { gq[(gi + 1) & 1][bj][0] = *(const u32x4*)(g0p + row1 * GATEC + bj * HALF); gq[(gi + 1) & 1][bj][1] = *(const u32x4*)(g1p + row1 * GATEC + bj * HALF); } }
            asm volatile("" ::: "memory");
#pragma unroll
            for (int bj = 0; bj < 2; ++bj) {
                const int col = col0 + bj * HALF;
                const u32x4 gw = gq[gi & 1][bj][0];
                f32x4 g0 = (f32x4){bf_lo(gw.x), bf_hi(gw.x), bf_lo(gw.y), bf_hi(gw.y)}, g1 = (f32x4){bf_lo(gw.z), bf_hi(gw.z), bf_lo(gw.w), bf_hi(gw.w)};
                if (mid) {
                    const u32x4 nw = gq[gi & 1][bj][1];
#pragma unroll
                    for (int j = 0; j < 2; ++j) { const unsigned a = j == 0 ? nw.x : nw.y, b = j == 0 ? nw.z : nw.w;
                        g0[2 * j] *= fast_rcp(bf_lo(a)); g0[2 * j + 1] *= fast_rcp(bf_hi(a)); g1[2 * j] *= fast_rcp(bf_lo(b)); g1[2 * j + 1] *= fast_rcp(bf_hi(b)); }
                    acc[ai][bj][m][0] *= g0; acc[ai][bj][m][1] *= g1;
                } else {
                    const f32x4 v0 = g0 * acc[ai][bj][m][0], v1 = g1 * acc[ai][bj][m][1];
                    u32x4 w; w.x = cvt_pk_bf16(v0[0], v0[1]); w.y = cvt_pk_bf16(v0[2], v0[3]); w.z = cvt_pk_bf16(v1[0], v1[1]); w.w = cvt_pk_bf16(v1[2], v1[3]);
                    *(u32x4*)(O + row * D + col) = w; }
            }
            asm volatile("" : "+v"(acc[ai][0][m][0]), "+v"(acc[ai][0][m][1]), "+v"(acc[ai][1][m][0]), "+v"(acc[ai][1][m][1]));
        }
    }
};
}

__device__ __forceinline__ void tr_item(const float* W, int ldw, bf16_t* WT, int ldt, int k0, int n0, int c0, float scale, LAS float* scr, int lane) {
    float wv[32];
#pragma unroll
    for (int i = 0; i < 32; ++i) wv[i] = W[(size_t)(k0 + 2 * i + (lane >> 5)) * ldw + c0 + (lane & 31)];
#pragma unroll
    for (int i = 0; i < 32; ++i) scr[(2 * i + (lane >> 5)) * 33 + (lane & 31)] = wv[i];
    asm volatile("s_waitcnt lgkmcnt(0)" ::: "memory");
    const int c = lane & 7;
#pragma unroll
    for (int j = 0; j < 4; ++j) { const int n = (lane >> 3) + 8 * j; const LAS float* sp = scr + (8 * c) * 33 + n;
        u32x4 o; o.x = cvt_pk_bf16(sp[0 * 33] * scale, sp[1 * 33] * scale); o.y = cvt_pk_bf16(sp[2 * 33] * scale, sp[3 * 33] * scale);
        o.z = cvt_pk_bf16(sp[4 * 33] * scale, sp[5 * 33] * scale); o.w = cvt_pk_bf16(sp[6 * 33] * scale, sp[7 * 33] * scale);
        *(u32x4*)(WT + (size_t)(n0 + n) * ldt + k0 + 8 * c) = o; }
    asm volatile("s_waitcnt lgkmcnt(0)" ::: "memory");
}
template <int MODE>
__device__ __forceinline__ void tr_matrix(const float* W, int K, int N, int ldw, bf16_t* WT, int ldt, LAS float* scr, int gw, int ngw, int lane) {
    const int nblk = N / 32, nitems = (K / 64) * nblk;
    for (int it = gw; it < nitems; it += ngw) {
        const int kb = it / nblk, nb = it - kb * nblk, n0 = nb * 32; int c0 = n0; float scale = 1.f;
        if (MODE == 1) { const int tile = n0 >> 8, bj = (n0 >> 7) & 1, c = n0 & 127; c0 = bj * DFF + tile * 128 + c; }
        if (MODE == 2) { if (n0 < 512 || (n0 >= 768 && n0 < 1280)) scale = 0.125f * LOG2E; else if (n0 >= 2304 && n0 < 2816) scale = 0.08838834764831845f * LOG2E; }
        tr_item(W, ldw, WT, ldt, kb * 64, n0, c0, scale, scr, lane);
    }
}

struct AttnP {
    const bf16_t *q, *k, *v; bf16_t* o; float* lse;
    int q_rs, q_toff, kv_rs, o_rs, o_toff, lse_rs, lse_toff;
    int qpos0, qpos_tstep, k_lo, nsteps, sub_len, radius;
    float slope2, slope_tmul;
    float sink2[4];
};
__device__ __forceinline__ s16x4 vtr(const LAS unsigned char* p) {
    typedef short v4i16_t __attribute__((ext_vector_type(4)));
    return __builtin_bit_cast(s16x4, __builtin_amdgcn_ds_read_tr16_b64_v4i16((LAS v4i16_t*)p));
}
__device__ __forceinline__ float rowgrp_max(float m) {
    const auto r = __builtin_amdgcn_permlane16_swap(__float_as_uint(m), __float_as_uint(m), false, false);
    const float a = fmaxf(__uint_as_float(r[0]), __uint_as_float(r[1]));
    const auto r2 = __builtin_amdgcn_permlane32_swap(__float_as_uint(a), __float_as_uint(a), false, false);
    return fmaxf(__uint_as_float(r2[0]), __uint_as_float(r2[1]));
}
__device__ __forceinline__ float rowgrp_sum(float m) {
    const auto r = __builtin_amdgcn_permlane16_swap(__float_as_uint(m), __float_as_uint(m), false, false);
    const float a = __uint_as_float(r[0]) + __uint_as_float(r[1]);
    const auto r2 = __builtin_amdgcn_permlane32_swap(__float_as_uint(a), __float_as_uint(a), false, false);
    return __uint_as_float(r2[0]) + __uint_as_float(r2[1]);
}
template <int DH, int NT, int MODE>
__device__ __forceinline__ void attn_item(const AttnP& P, LAS unsigned char* vl, int lane_in, const LAS unsigned char* kl = nullptr) {
    int lane = lane_in; asm volatile("" : "+v"(lane));
    constexpr bool MASK = MODE < 2, SINK = MODE == 0, LSE = MODE == 1, INLDS = MODE == 3;
    constexpr int NSTEPS = MODE == 0 ? 9 : (MODE == 1 ? 6 : 8), QTSTEP = MODE == 1 ? 16 : 0;
    constexpr float RADF = MODE == 0 ? 128.f : 64.f, SLOPE_TMUL = MODE == 0 ? 0.5f : 1.0f;
    constexpr int KS = DH / 32, ND = DH / 16, VP = DH * 2 + 32, NVL = DH / 16;
    const int fr = lane & 15, g = lane >> 4;
    bf16x8 qf[NT][KS];
#pragma unroll
    for (int i = 0; i < NT; ++i)
#pragma unroll
        for (int ks = 0; ks < KS; ++ks) qf[i][ks] = *(const bf16x8*)(P.q + (size_t)i * P.q_toff + (size_t)fr * P.q_rs + ks * 32 + g * 8);
    f32x4 o[NT][ND]; float mrun[NT], lrun[NT];
#pragma unroll
    for (int i = 0; i < NT; ++i) {
#pragma unroll
        for (int d = 0; d < ND; ++d) o[i][d] = (f32x4){0.f, 0.f, 0.f, 0.f};
        mrun[i] = SINK ? P.sink2[i] : -1e30f; lrun[i] = (SINK && g == 0) ? 1.f : 0.f; }
    bf16x8 kf[2][KS]; u32x4 vr[NVL];
    constexpr int CPR = DH / 8;
    const int kmax = P.sub_len - 1, klo = P.k_lo, kvrs = P.kv_rs;
    const bf16_t* kbase = P.k + g * 8; const bf16_t* vbase = P.v;
    if (!INLDS) {
#pragma unroll
        for (int a = 0; a < 2; ++a) { int kp = klo + 16 * a + fr; kp = kp < 0 ? 0 : (kp > kmax ? kmax : kp);
#pragma unroll
            for (int ks = 0; ks < KS; ++ks) kf[a][ks] = *(const bf16x8*)(kbase + (size_t)kp * kvrs + ks * 32); }
#pragma unroll
        for (int it = 0; it < NVL; ++it) { const int idx = it * 64 + lane, r = idx / CPR, ch = idx % CPR; int kp = klo + r; kp = kp < 0 ? 0 : (kp > kmax ? kmax : kp);
            vr[it] = *(const u32x4*)(vbase + (size_t)kp * kvrs + ch * 8); }
    }
    const LAS unsigned char* vrd = vl + (4 * g + (fr >> 2)) * VP + 8 * (fr & 3);
    const float qbase = (float)(4 * g - P.qpos0 - fr);
    for (int s = 0; s < NSTEPS; ++s) {
        const int k0 = klo + 32 * s;
        asm volatile("" ::: "memory");
        bf16x8 kc[2][KS];
        if (INLDS) {
#pragma unroll
            for (int a = 0; a < 2; ++a)
#pragma unroll
                for (int ks = 0; ks < KS; ++ks) kc[a][ks] = *(const LAS bf16x8*)(kl + (32 * s + 16 * a + fr) * VP + (ks * 32 + 8 * g) * 2);
        } else {
#pragma unroll
        for (int it = 0; it < NVL; ++it) { const int idx = it * 64 + lane, r = idx / CPR, ch = idx % CPR; *(LAS u32x4*)(vl + r * VP + ch * 16) = vr[it]; }
#pragma unroll
        for (int a = 0; a < 2; ++a)
#pragma unroll
            for (int ks = 0; ks < KS; ++ks) kc[a][ks] = kf[a][ks];
        }
        if (!INLDS && s + 1 < NSTEPS) {
            const int k1 = k0 + 32;
#pragma unroll
            for (int a = 0; a < 2; ++a) { int kp = k1 + 16 * a + fr; kp = kp < 0 ? 0 : (kp > kmax ? kmax : kp);
#pragma unroll
                for (int ks = 0; ks < KS; ++ks) kf[a][ks] = *(const bf16x8*)(kbase + (size_t)kp * kvrs + ks * 32); }
#pragma unroll
            for (int it = 0; it < NVL; ++it) { const int idx = it * 64 + lane, r = idx / CPR, ch = idx % CPR; int kp = k1 + r; kp = kp < 0 ? 0 : (kp > kmax ? kmax : kp);
                vr[it] = *(const u32x4*)(vbase + (size_t)kp * kvrs + ch * 8); }
        }
        asm volatile("s_waitcnt lgkmcnt(0)" ::: "memory");
        const bool edge = (k0 < 0) || (k0 + 31 > kmax);
        const float kf0 = (float)k0 + qbase;
        float koff[2][4];
#pragma unroll
        for (int a = 0; a < 2; ++a)
#pragma unroll
            for (int r = 0; r < 4; ++r) { koff[a][r] = (float)(16 * a + r); if (MASK && edge) { const int kp = k0 + 16 * a + 4 * g + r; if (kp < 0 || kp > kmax) koff[a][r] = INFINITY; } }
        bf16x8 pf[NT]; float alv[NT]; bool act[NT];
#pragma unroll
        for (int i = 0; i < NT; ++i) {
            act[i] = !(MODE == 1) || (s >= (i >> 1) && s <= (i >> 1) + 4);
            if (!act[i]) { alv[i] = 1.0f; continue; }
            f32x4 sc[2];
#pragma unroll
            for (int a = 0; a < 2; ++a) { sc[a] = (f32x4){0.f, 0.f, 0.f, 0.f};
#pragma unroll
                for (int ks = 0; ks < KS; ++ks) sc[a] = __builtin_amdgcn_mfma_f32_16x16x32_bf16(kc[a][ks], qf[i][ks], sc[a], 0, 0, 0); }
            if (MASK) {
                float slope = P.slope2;
#pragma unroll
                for (int t = 0; t < i; ++t) slope *= SLOPE_TMUL;
                const float base = kf0 - (float)(i * QTSTEP);
#pragma unroll
                for (int a = 0; a < 2; ++a)
#pragma unroll
                    for (int r = 0; r < 4; ++r) { const float ad = fabsf(base + koff[a][r]);
                        sc[a][r] = (ad <= RADF) ? fmaf(-slope, ad, sc[a][r]) : -INFINITY; }
            }
            float mx = fmaxf(fmaxf(fmaxf(sc[0][0], sc[0][1]), fmaxf(sc[0][2], sc[0][3])), fmaxf(fmaxf(sc[1][0], sc[1][1]), fmaxf(sc[1][2], sc[1][3])));
            mx = rowgrp_max(mx);
            const float mnew = fmaxf(mrun[i], mx); alv[i] = fast_exp2(mrun[i] - mnew);
            mrun[i] = mnew;
            float ps = 0.f;
#pragma unroll
            for (int a = 0; a < 2; ++a)
#pragma unroll
                for (int r = 0; r < 4; ++r) { const float p = fast_exp2(sc[a][r] - mnew); sc[a][r] = p; ps += p; }
            lrun[i] = lrun[i] * alv[i] + ps;
            union { bf16x8 v; unsigned u[4]; } pk;
            pk.u[0] = cvt_pk_bf16(sc[0][0], sc[0][1]); pk.u[1] = cvt_pk_bf16(sc[0][2], sc[0][3]); pk.u[2] = cvt_pk_bf16(sc[1][0], sc[1][1]); pk.u[3] = cvt_pk_bf16(sc[1][2], sc[1][3]);
            pf[i] = pk.v;
        }
        bool resc[NT];
#pragma unroll
        for (int i = 0; i < NT; ++i) resc[i] = act[i];
#pragma unroll
        for (int d = 0; d < ND; ++d) {
            const LAS unsigned char* vs = INLDS ? vrd + s * 32 * VP : vrd;
            const s16x4 lo = vtr(vs + d * 32), hi = vtr(vs + 16 * VP + d * 32);
            const bf16x8 vt = (bf16x8){lo[0], lo[1], lo[2], lo[3], hi[0], hi[1], hi[2], hi[3]};
#pragma unroll
            for (int i = 0; i < NT; ++i) { if (resc[i]) o[i][d] = o[i][d] * alv[i]; if (act[i]) o[i][d] = __builtin_amdgcn_mfma_f32_16x16x32_bf16(vt, pf[i], o[i][d], 0, 0, 0); }
        }
        asm volatile("" ::: "memory");
    }
#pragma unroll
    for (int i = 0; i < NT; ++i) {
        const float l = rowgrp_sum(lrun[i]);
        const float inv = 1.0f / l;
        bf16_t* orow = P.o + (size_t)i * P.o_toff + (size_t)fr * P.o_rs + 4 * g;
#pragma unroll
        for (int d = 0; d < ND; ++d) { u32x2 w; w.x = cvt_pk_bf16(o[i][d][0] * inv, o[i][d][1] * inv); w.y = cvt_pk_bf16(o[i][d][2] * inv, o[i][d][3] * inv); *(u32x2*)(orow + 16 * d) = w; }
        if (LSE) { if (g == 0) P.lse[(size_t)i * P.lse_toff + (size_t)fr * P.lse_rs] = mrun[i] + __log2f(l); }
    }
}

struct Args {
    const float* in[19];
    float* out; unsigned char* ws;
};

__global__ void __launch_bounds__(512, 2) mega_fwd(Args args) {
    extern __shared__ __attribute__((aligned(16))) unsigned char lds_raw[];
    LAS unsigned char* lds = (LAS unsigned char*)lds_raw;
    cg::grid_group grid = cg::this_grid();
    const int G = gridDim.x, bx = blockIdx.x;
    volatile LAS unsigned* MISC = (volatile LAS unsigned*)(lds + LDS_MISC);
    if (threadIdx.x < 32) MISC[threadIdx.x] = 0u;
    __syncthreads();
    grid.sync();
    const XcdBarrier bar = xcd_barrier_post((unsigned*)(args.ws + WS_CTL), MISC + 8);
    constexpr int PH_PER_CHUNK = NLAYER * 9, NPH = 2 + NCHUNK * PH_PER_CHUNK;
    for (int ph_i = 0; ph_i < NPH; ++ph_i) {
        int ph = ph_i; asm volatile("" : "+s"(ph));
        int lane = threadIdx.x & 63; asm volatile("" : "+v"(lane));
        const int wave = __builtin_amdgcn_readfirstlane(threadIdx.x >> 6);
        const int vcu = (G % 8 == 0) ? (bx % 8) * (G / 8) + bx / 8 : bx;
        const int gw = vcu * 8 + wave, NGW = G * 8;
        unsigned char* ws = args.ws;
        bf16_t* Wb = (bf16_t*)(ws + WS_W); bf16_t* Wmem = (bf16_t*)(ws + WS_WMEM); bf16_t* memb = (bf16_t*)(ws + WS_MEMB); bf16_t* memkv = (bf16_t*)(ws + WS_MEMKV);
        bf16_t* xb = (bf16_t*)(ws + WS_XB);
        bf16_t* hb = (bf16_t*)(ws + WS_U + U_H); bf16_t* proj = (bf16_t*)(ws + WS_U + U_PROJ); bf16_t* gates = (bf16_t*)(ws + WS_U + U_GATES); bf16_t* br = (bf16_t*)(ws + WS_U + U_BR);
        bf16_t* bpart = (bf16_t*)(ws + WS_U + U_BPART); float* lseb = (float*)(ws + WS_U + U_LSE); float* mixf = (float*)(ws + WS_U + U_MIXF); bf16_t* mixb = (bf16_t*)(ws + WS_U + U_MIXB);
        int load_chunk = -1;
        if (ph == 0) { for (int rep = 0; rep < REP_PRO; ++rep) {
            LAS float* scr = (LAS float*)(lds + wave * 16384);
            for (int l = 0; l < NLAYER; ++l) {
                bf16_t* WL = Wb + (size_t)l * W_LAYER_ELEMS;
                tr_matrix<1>(args.in[4] + (size_t)l * D * 2 * DFF, D, 2 * DFF, 2 * DFF, WL + OFF_W1IN, D, scr, gw, NGW, lane);
                tr_matrix<0>(args.in[5] + (size_t)l * DFF * D, DFF, D, D, WL + OFF_W1OUT, DFF, scr, gw, NGW, lane);
                tr_matrix<2>(args.in[8] + (size_t)l * D * INC, D, INC, INC, WL + OFF_WIN, D, scr, gw, NGW, lane);
                tr_matrix<0>(args.in[9] + (size_t)l * D * 1024, D, 1024, 1024, Wmem + (size_t)l * 1024 * D, D, scr, gw, NGW, lane);
                for (int i = 0; i < 3; ++i) tr_matrix<0>(args.in[11] + ((size_t)l * 3 + i) * 512 * D, 512, D, D, WL + OFF_WBR + (size_t)i * D * 512, 512, scr, gw, NGW, lane);
                tr_matrix<0>(args.in[12] + (size_t)l * D * D, D, D, D, WL + OFF_WOUT, D, scr, gw, NGW, lane);
                tr_matrix<1>(args.in[15] + (size_t)l * D * 2 * DFF, D, 2 * DFF, 2 * DFF, WL + OFF_W2IN, D, scr, gw, NGW, lane);
                tr_matrix<0>(args.in[16] + (size_t)l * DFF * D, DFF, D, D, WL + OFF_W2OUT, DFF, scr, gw, NGW, lane);
            }
            for (int m = gw; m < MEMROWS; m += NGW) {
                const float* src = (m < 4096) ? args.in[2] + (size_t)m * D : args.in[3] + (size_t)(m - 4096) * D;
#pragma unroll
                for (int j = 0; j < 4; ++j) { const f32x4 v = *((const f32x4*)src + lane + 64 * j); u32x2 w; w.x = cvt_pk_bf16(v[0], v[1]); w.y = cvt_pk_bf16(v[2], v[3]); *((u32x2*)(memb + (size_t)m * D) + lane + 64 * j) = w; }
            } }
            load_chunk = 0;
        } else if (ph == 1) {
            pg8::Gemm g{memb, Wmem, MEMROWS, 2048, D, D, D, 0, 0}; pg8::Order S; S.init(MEMROWS, 2048, 1, G, bx);
            pg8::EpiBf16Plain E{memkv, 2048};
            pg8::gemm_phase(lds, g, S, E);
        } else {
            const int q = ph - 2, c = q / PH_PER_CHUNK, r = q - c * PH_PER_CHUNK;
            const bool is_prompt = c < 2;
            float* X = args.out + (size_t)c * TC * D;
            const int L = is_prompt ? 2048 : 8192;
            {
                const int l = r / 9, k = r - l * 9;
                const bf16_t* WL = Wb + (size_t)l * W_LAYER_ELEMS;
                if (k == 0 || k == 7) {
                    pg8::Gemm g{xb, WL + (k == 0 ? OFF_W1IN : OFF_W2IN), TC, 2 * DFF, D, D, D, 0, 0}; pg8::Order S; S.init(TC, 2 * DFF, 1, G, bx); pg8::EpiSwiglu E{hb, DFF}; for (int rep = 0; rep < REP_UP; ++rep) pg8::gemm_phase(lds, g, S, E);
                    if (l == 0 && k == 0) {
                        const float* xin = is_prompt ? args.in[0] + (size_t)c * TC * D : args.in[1] + (size_t)(c - 2) * TC * D;
                        for (int m0 = gw; m0 < TC; m0 += 4 * NGW) {
                            f32x4 v[4][4];
#pragma unroll
                            for (int r = 0; r < 4; ++r) { const int mm = m0 + r * NGW; const size_t m = (size_t)(mm < TC ? mm : m0);
#pragma unroll
                                for (int j = 0; j < 4; ++j) v[r][j] = *((const f32x4*)(xin + m * D) + lane + 64 * j); }
#pragma unroll
                            for (int r = 0; r < 4; ++r) { const int mm = m0 + r * NGW; if (mm >= TC) continue;
#pragma unroll
                                for (int j = 0; j < 4; ++j) { u32x2 hw; hw.x = cvt_pk_h(v[r][j][0], v[r][j][1]); hw.y = cvt_pk_h(v[r][j][2], v[r][j][3]); *((u32x2*)((bf16_t*)(ws + WS_X16) + (size_t)mm * D) + lane + 64 * j) = hw; } }
                        }
                    }
                } else if (k == 1 || k == 8 || k == 6) {
                    const bool ffn = (k != 6); const int sidx = (k == 1) ? 0 : (k == 6 ? 1 : 2);
                    const bool last = (l == NLAYER - 1 && k == 8);
                    pg8::Gemm g{ffn ? hb : mixb, WL + (k == 1 ? OFF_W1OUT : (k == 8 ? OFF_W2OUT : OFF_WOUT)), TC, D, ffn ? DFF : D, ffn ? DFF : D, ffn ? DFF : D, 0, 0};
                    pg8::Order S; S.init(TC, D, 1, G, bx);
                    const int nuse = (c * NLAYER + l) * 3 + sidx;
                    pg8::EpiResidLN E{last ? X : nullptr, (bf16_t*)(ws + WS_X16), xb, args.in[sidx == 0 ? 6 : (sidx == 1 ? 13 : 17)] + l * D, args.in[sidx == 0 ? 7 : (sidx == 1 ? 14 : 18)] + l * D, ffn ? 0.5f : 1.0f,
                                      (unsigned long long*)(ws + WS_CTL + CTL_XBUF), (unsigned*)(ws + WS_CTL + 16384), 32u * (unsigned)(nuse + 1)};
                    pg8::gemm_phase(lds, g, S, E);
                    if (last && c + 1 < NCHUNK) load_chunk = c + 1;
                } else if (k == 2) {
                    pg8::Gemm g{xb, WL + OFF_WIN, TC, INC, D, D, D, 0, 0}; pg8::Order S; S.init(TC, INC, 1, G, bx); pg8::EpiInproj E{proj, gates}; for (int rep = 0; rep < REP_INPROJ; ++rep) pg8::gemm_phase(lds, g, S, E);
                } else if (k == 3) {
                    LAS unsigned char* vl = lds + wave * 9216;
                    const float* sink = args.in[10] + l * 8;
                    const int memrow0 = is_prompt ? c * 8 * NMEM : 4096 + (c - 2) * 2 * NMEM;
                    for (int rep = 0; rep < REP_ATT; ++rep) {
                    for (int u = vcu; u < 256; u += G) {
                        const int nqb = L / 256; const int qb = u % nqb, hh = (u / nqb) & 3, sq = u / (nqb * 4);
                        const bf16_t* mb = memkv + (size_t)(memrow0 + sq * NMEM) * 2048 + l * 1024 + hh * 128;
                        __syncthreads();
#pragma unroll 2
                        for (int j = 0; j < 8; ++j) { const int idx = j * 512 + (int)threadIdx.x, rrow = idx >> 4, pc = idx & 15;
                            const u32x4 kv = *(const u32x4*)(mb + (size_t)rrow * 2048 + pc * 8), vv = *(const u32x4*)(mb + 512 + (size_t)rrow * 2048 + pc * 8);
                            *(LAS u32x4*)(lds + rrow * 288 + pc * 16) = kv; *(LAS u32x4*)(lds + 73728 + rrow * 288 + pc * 16) = vv; }
                        __syncthreads();
                        AttnP P;
                        const int tok0 = sq * L + qb * 256 + wave * 32;
                        P.q = proj + (size_t)tok0 * PROJC + 2304 + hh * 128; P.q_rs = PROJC; P.q_toff = 16 * PROJC;
                        P.k = mb; P.v = mb + 512; P.kv_rs = 2048;
                        P.o = br + (size_t)tok0 * BRC + 1024 + hh * 128; P.o_rs = BRC; P.o_toff = 16 * BRC; P.lse = nullptr; P.lse_rs = 0; P.lse_toff = 0;
                        P.qpos0 = 0; P.qpos_tstep = 0; P.k_lo = 0; P.nsteps = 8; P.sub_len = NMEM; P.radius = 1 << 20;
                        P.slope2 = 0.f; P.slope_tmul = 1.f;
#pragma unroll
                        for (int i = 0; i < 4; ++i) P.sink2[i] = 0.f;
                        attn_item<128, 2, 3>(P, lds + 73728, lane, lds);
                    }
                    __syncthreads();
                    for (int it = gw; it < 4 * 2048; it += NGW) {
                        const int type = it >> 11, id = it & 2047;
                        AttnP P;
                        if (type == 0) {
                            const int hk = id & 1, tb = id >> 1; const int tok0 = tb * 16; const int sq = tok0 / L, pos0 = tok0 - sq * L;
                            const bf16_t* base = proj + (size_t)(sq * L) * PROJC;
                            P.q = proj + (size_t)tok0 * PROJC + hk * 256; P.q_rs = PROJC; P.q_toff = 64;
                            P.k = base + 512 + hk * 64; P.v = base + 512 + 128 + hk * 64; P.kv_rs = PROJC;
                            P.o = br + (size_t)tok0 * BRC + hk * 256; P.o_rs = BRC; P.o_toff = 64; P.lse = nullptr; P.lse_rs = 0; P.lse_toff = 0;
                            P.qpos0 = pos0; P.qpos_tstep = 0; P.k_lo = pos0 - 128; P.nsteps = 9; P.sub_len = L; P.radius = 128;
                            P.slope2 = LOG2E * exp2f(-(float)(hk * 4 + 1)); P.slope_tmul = 0.5f;
#pragma unroll
                            for (int i = 0; i < 4; ++i) P.sink2[i] = sink[hk * 4 + i] * LOG2E;
                            attn_item<64, 4, 0>(P, vl, lane);
                        } else {
                            const int cfg = type - 1, dil = cfg == 0 ? 1 : (cfg == 1 ? 4 : 16);
                            const int h = id & 7, blk = id >> 3;
                            const int sub_len = L / dil, bps = sub_len / 64;
                            const int sr = blk / bps, jb = blk - sr * bps; const int sq = sr / dil, rs = sr - sq * dil; const int j0 = jb * 64;
                            const bf16_t* base = proj + (size_t)(sq * L + rs) * PROJC + 768 + h * 64;
                            const size_t tok0 = (size_t)sq * L + rs + (size_t)j0 * dil;
                            P.q = proj + tok0 * PROJC + 768 + h * 64; P.q_rs = PROJC * dil; P.q_toff = 16 * PROJC * dil;
                            P.k = base + 512; P.v = base + 1024; P.kv_rs = PROJC * dil;
                            P.o = bpart + (size_t)cfg * TC * 512 + tok0 * 512 + h * 64; P.o_rs = 512 * dil; P.o_toff = 16 * 512 * dil;
                            P.lse = lseb + (size_t)cfg * TC * 8 + tok0 * 8 + h; P.lse_rs = 8 * dil; P.lse_toff = 16 * 8 * dil;
                            P.qpos0 = j0; P.qpos_tstep = 16; P.k_lo = j0 - 64; P.nsteps = 6; P.sub_len = sub_len; P.radius = 64;
                            P.slope2 = LOG2E * exp2f(-(float)(h + 1)) * (float)dil; P.slope_tmul = 1.0f;
#pragma unroll
                            for (int i = 0; i < 4; ++i) P.sink2[i] = 0.f;
                            attn_item<64, 4, 1>(P, vl, lane);
                        }
                    }
                    }
                } else if (k == 4) {
                    for (int rep = 0; rep < REP_CMB; ++rep) for (int m0 = gw; m0 < TC; m0 += 4 * NGW) {
                        const int h = lane >> 3;
                        float l0[4], l1[4], l2[4]; u32x4 a[4], b[4], cc[4];
#pragma unroll
                        for (int r = 0; r < 4; ++r) { const int mm = m0 + r * NGW; const size_t m = (size_t)(mm < TC ? mm : m0);
                            l0[r] = lseb[m * 8 + h]; l1[r] = lseb[(size_t)TC * 8 + m * 8 + h]; l2[r] = lseb[(size_t)2 * TC * 8 + m * 8 + h];
                            a[r] = *((const u32x4*)(bpart + m * 512) + lane); b[r] = *((const u32x4*)(bpart + (size_t)TC * 512 + m * 512) + lane); cc[r] = *((const u32x4*)(bpart + (size_t)2 * TC * 512 + m * 512) + lane); }
#pragma unroll
                        for (int r = 0; r < 4; ++r) { const int mm = m0 + r * NGW; if (mm >= TC) continue;
                            const float mx = fmaxf(l0[r], fmaxf(l1[r], l2[r])); float w0 = fast_exp2(l0[r] - mx), w1 = fast_exp2(l1[r] - mx), w2 = fast_exp2(l2[r] - mx); const float inv = 1.0f / (w0 + w1 + w2); w0 *= inv; w1 *= inv; w2 *= inv;
                            u32x4 w;
                            w.x = cvt_pk_bf16(w0 * bf_lo(a[r].x) + w1 * bf_lo(b[r].x) + w2 * bf_lo(cc[r].x), w0 * bf_hi(a[r].x) + w1 * bf_hi(b[r].x) + w2 * bf_hi(cc[r].x));
                            w.y = cvt_pk_bf16(w0 * bf_lo(a[r].y) + w1 * bf_lo(b[r].y) + w2 * bf_lo(cc[r].y), w0 * bf_hi(a[r].y) + w1 * bf_hi(b[r].y) + w2 * bf_hi(cc[r].y));
                            w.z = cvt_pk_bf16(w0 * bf_lo(a[r].z) + w1 * bf_lo(b[r].z) + w2 * bf_lo(cc[r].z), w0 * bf_hi(a[r].z) + w1 * bf_hi(b[r].z) + w2 * bf_hi(cc[r].z));
                            w.w = cvt_pk_bf16(w0 * bf_lo(a[r].w) + w1 * bf_lo(b[r].w) + w2 * bf_lo(cc[r].w), w0 * bf_hi(a[r].w) + w1 * bf_hi(b[r].w) + w2 * bf_hi(cc[r].w));
                            *((u32x4*)(br + (size_t)mm * BRC + 512) + lane) = w; }
                    }
                } else {
                    pg8::Gemm g{br, WL + OFF_WBR, TC, D, 512, BRC, 512, 512, (size_t)D * 512}; pg8::Order S; S.init(TC, D, 3, G, bx); pg8::EpiBranch E{gates, mixb}; for (int rep = 0; rep < REP_BR; ++rep) pg8::gemm_phase(lds, g, S, E);
                }
            }
        }
        if (load_chunk >= 0) {
            const float* xin = load_chunk < 2 ? args.in[0] + (size_t)load_chunk * TC * D : args.in[1] + (size_t)(load_chunk - 2) * TC * D;
            for (int m0 = gw; m0 < TC; m0 += 4 * NGW) {
                f32x4 v[4][4];
#pragma unroll
                for (int r = 0; r < 4; ++r) { const int mm = m0 + r * NGW; const size_t m = (size_t)(mm < TC ? mm : m0);
#pragma unroll
                    for (int j = 0; j < 4; ++j) v[r][j] = *((const f32x4*)(xin + m * D) + lane + 64 * j); }
#pragma unroll
                for (int r = 0; r < 4; ++r) { const int mm = m0 + r * NGW; if (mm >= TC) continue;
#pragma unroll
                    for (int j = 0; j < 4; ++j) { u32x2 w; w.x = cvt_pk_bf16(v[r][j][0], v[r][j][1]); w.y = cvt_pk_bf16(v[r][j][2], v[r][j][3]); *((u32x2*)(xb + (size_t)mm * D) + lane + 64 * j) = w; } }
            }
        }
        for (int rep = 0; rep < REP_SYNC; ++rep) xcd_barrier(bar);
    }
}

extern "C" void kernel_launch(void* const* d_in, const int* in_sizes, int n_in, void* d_out, int out_size, void* d_ws, size_t ws_size, hipStream_t stream) {
    static int grid = 0;
    if (grid == 0) {
        if (n_in != 19 || ws_size < WS_END) { fprintf(stderr, "kernel_launch: need 19 inputs and %zu bytes of workspace; got %d, %zu\n", (size_t)WS_END, n_in, ws_size); grid = -1; return; }
        int dev = 0, cus = 0, per_cu = 0;
        hipGetDevice(&dev); hipDeviceGetAttribute(&cus, hipDeviceAttributeMultiprocessorCount, dev);
        if (hipFuncSetAttribute((const void*)mega_fwd, hipFuncAttributeMaxDynamicSharedMemorySize, LDS_BYTES) != hipSuccess) { fprintf(stderr, "kernel_launch: hipFuncSetAttribute failed\n"); grid = -1; return; }
        if (hipOccupancyMaxActiveBlocksPerMultiprocessor(&per_cu, (const void*)mega_fwd, 512, LDS_BYTES) != hipSuccess || per_cu < 1) { fprintf(stderr, "kernel_launch: occupancy query says %d\n", per_cu); per_cu = 1; }
        (void)hipGetLastError();
        grid = cus;
        if (grid != 256) { fprintf(stderr, "kernel_launch: built for a 256-CU device (fused LayerNorm epilogue needs one 256x256 unit per workgroup); got %d CUs\n", cus); grid = -1; return; }
    }
    if (grid < 0) return;
    if (hipMemsetAsync((char*)d_ws + WS_CTL, 0, CTL_BYTES, stream) != hipSuccess) { fprintf(stderr, "kernel_launch: memset failed\n"); return; }
    Args a{};
    for (int i = 0; i < 19; ++i) a.in[i] = (const float*)d_in[i];
    a.out = (float*)d_out; a.ws = (unsigned char*)d_ws;
    void* kargs[] = {&a};
    hipError_t e = hipLaunchCooperativeKernel((const void*)mega_fwd, dim3(grid), dim3(512), kargs, LDS_BYTES, stream);
    if (e != hipSuccess) fprintf(stderr, "cooperative launch failed: %s (grid %d)\n", hipGetErrorString(e), grid);
}
```

```cpp
#include <hip/hip_runtime.h>
#include <hip/hip_cooperative_groups.h>
#include <cstdio>
#include <cstdint>
namespace cg = cooperative_groups;

#define LAS __attribute__((address_space(3)))
typedef unsigned short bf16_t;
typedef short bf16x8 __attribute__((ext_vector_type(8)));
typedef short s16x4 __attribute__((ext_vector_type(4)));
typedef float f32x4 __attribute__((ext_vector_type(4)));
typedef float f32x2 __attribute__((ext_vector_type(2)));
typedef unsigned u32x4 __attribute__((ext_vector_type(4)));
typedef unsigned u32x2 __attribute__((ext_vector_type(2)));

constexpr int D = 1024, DFF = 2816, NLAYER = 2;
constexpr int TC = 16384;
constexpr int NCHUNK = 4;
constexpr int INC = 5888, PROJC = 2816, GATEC = 3072, BRC = 1536;
constexpr int NMEM = 256, MEMROWS = 5120;
constexpr float LN_EPS = 1e-5f;
constexpr float ALPHA = 1.41421356237309515f;
constexpr float LOG2E = 1.44269504088896341f;

constexpr size_t MiB = 1u << 20;
constexpr size_t W_LAYER_ELEMS = (size_t)5632 * 1024 + (size_t)1024 * 2816 + (size_t)5888 * 1024 + (size_t)3 * 1024 * 512 + (size_t)1024 * 1024 + (size_t)5632 * 1024 + (size_t)1024 * 2816;
constexpr size_t OFF_W1IN = 0, OFF_W1OUT = OFF_W1IN + (size_t)5632 * 1024, OFF_WIN = OFF_W1OUT + (size_t)1024 * 2816, OFF_WBR = OFF_WIN + (size_t)5888 * 1024,
                 OFF_WOUT = OFF_WBR + (size_t)3 * 1024 * 512, OFF_W2IN = OFF_WOUT + (size_t)1024 * 1024, OFF_W2OUT = OFF_W2IN + (size_t)5632 * 1024;
constexpr size_t WS_W = 0;
constexpr size_t WS_WMEM = 100 * MiB;
constexpr size_t WS_MEMB = 108 * MiB;
constexpr size_t WS_MEMKV = 118 * MiB;
constexpr size_t WS_XB = 158 * MiB;
constexpr size_t WS_U = 190 * MiB;
constexpr size_t U_H = 0;
constexpr size_t U_PROJ = 0;
constexpr size_t U_GATES = 88 * MiB;
constexpr size_t U_BR = 184 * MiB;
constexpr size_t U_BPART = 232 * MiB;
constexpr size_t U_LSE = 280 * MiB;
constexpr size_t U_MIXF = 0;
constexpr size_t U_MIXB = 232 * MiB;
constexpr size_t WS_X16 = WS_U + 282 * MiB;
constexpr size_t WS_CTL = WS_X16 + 32 * MiB;
constexpr size_t CTL_BYTES = 32768;
constexpr size_t CTL_XBUF = 65536;
constexpr size_t WS_END = WS_CTL + 1 * MiB;
static_assert(W_LAYER_ELEMS * 2 * 2 <= 100 * MiB, "weights fit");

constexpr int REP_ATT = 1, REP_UP = 1, REP_INPROJ = 1, REP_BR = 1, REP_PRO = 1, REP_SYNC = 1, REP_CMB = 1;
constexpr int LDS_BYTES = 147456 + 256;
constexpr int LDS_MISC = 147456;

__device__ __forceinline__ unsigned cvt_pk_bf16(float lo, float hi) { unsigned r; asm("v_cvt_pk_bf16_f32 %0, %1, %2" : "=v"(r) : "v"(lo), "v"(hi)); return r; }
__device__ __forceinline__ float bf_lo(unsigned u) { return __uint_as_float(u << 16); }
__device__ __forceinline__ float bf_hi(unsigned u) { return __uint_as_float(u & 0xffff0000u); }
typedef _Float16 f16x2 __attribute__((ext_vector_type(2)));
__device__ __forceinline__ unsigned cvt_pk_h(float lo, float hi) { const f16x2 v = {(_Float16)lo, (_Float16)hi}; return __builtin_bit_cast(unsigned, v); }
__device__ __forceinline__ float h_lo(unsigned u) { return (float)__builtin_bit_cast(f16x2, u)[0]; }
__device__ __forceinline__ float h_hi(unsigned u) { return (float)__builtin_bit_cast(f16x2, u)[1]; }
__device__ __forceinline__ float fast_exp2(float x) { return __builtin_amdgcn_exp2f(x); }
__device__ __forceinline__ float fast_rcp(float x) { return __builtin_amdgcn_rcpf(x); }
__device__ __forceinline__ float sigmoidf_fast(float v) { return fast_rcp(1.0f + fast_exp2(-LOG2E * v)); }
__device__ __forceinline__ float wave_sum(float v) {
#pragma unroll
    for (int o = 1; o < 64; o <<= 1) v += __shfl_xor(v, o);
    return v;
}

#define XB_TMO      128
#define XB_XCNT(j)  (256  + 64 * (j))
#define XB_XSUB(j)  (1280 + 64 * (j))
#define XB_XGEN(j)  (2304 + 64 * (j))
#define XB_TOP      3328
#define XB_TOPGEN   3392
#define XCD_BAR_WORDS 3456
#define XB_SPIN_CAP (1u << 18)

__device__ __forceinline__ unsigned xb_ld(unsigned* p)              { return __hip_atomic_load(p, __ATOMIC_RELAXED, __HIP_MEMORY_SCOPE_AGENT); }
__device__ __forceinline__ unsigned xb_add(unsigned* p, unsigned v) { return __hip_atomic_fetch_add(p, v, __ATOMIC_RELAXED, __HIP_MEMORY_SCOPE_AGENT); }
__device__ __forceinline__ unsigned xb_xcc_id() { return (unsigned)__builtin_amdgcn_s_getreg((3 << 11) | 20) & 0xFu; }
#define XB_SPIN(cond, bar) do { unsigned _sp = 0; while (cond) { __builtin_amdgcn_s_sleep(1); \
    if ((++_sp & 255u) == 0u) { if (xb_ld(&(bar)[XB_TMO])) break; if (_sp > XB_SPIN_CAP) { atomicAdd(&(bar)[XB_TMO], 1u); break; } } } } while (0)

struct XcdBarrier {
    unsigned* bar; unsigned x;
    volatile LAS unsigned* st;
};

__device__ __forceinline__ XcdBarrier xcd_barrier_post(unsigned* bar, volatile LAS unsigned* st) {
    XcdBarrier b; b.bar = bar; b.x = xb_xcc_id(); b.st = st;
    if (threadIdx.x == 0) (void)xb_add(&bar[XB_XCNT(b.x)], 1u);
    return b;
}
__device__ __forceinline__ void xcd_barrier_complete(unsigned* bar, unsigned x, unsigned& nloc, unsigned& nx) {
    const unsigned G = gridDim.x * gridDim.y * gridDim.z;
    unsigned sum, cnt, mine, sp = 0u;
    for (;;) {
        sum = 0u; cnt = 0u; mine = 0u;
#pragma unroll
        for (unsigned j = 0; j < 16; ++j) { const unsigned c = xb_ld(&bar[XB_XCNT(j)]); sum += c; cnt += (c > 0u) ? 1u : 0u; mine = (j == x) ? c : mine; }
        if (sum == G) break;
        __builtin_amdgcn_s_sleep(1);
        if ((++sp & 255u) == 0u) { if (xb_ld(&bar[XB_TMO])) break; if (sp > XB_SPIN_CAP) { atomicAdd(&bar[XB_TMO], 1u); break; } }
    }
    nloc = mine > 0u ? mine : 1u; nx = cnt > 0u ? cnt : 1u;
}

__device__ __forceinline__ void xcd_barrier(const XcdBarrier& b) {
    asm volatile("s_waitcnt vmcnt(0)" ::: "memory");
    __syncthreads();
    if (threadIdx.x == 0) {
        unsigned* bar = b.bar;
        __builtin_amdgcn_s_waitcnt(0);
        unsigned nloc = b.st[0], nx = b.st[1];
        if (nloc == 0u) { xcd_barrier_complete(bar, b.x, nloc, nx); b.st[0] = nloc; b.st[1] = nx; }
        const unsigned old = xb_add(&bar[XB_XSUB(b.x)], 1u);
        const unsigned gen = old / nloc;
        if (old + 1u == (gen + 1u) * nloc) {
            __builtin_amdgcn_fence(__ATOMIC_RELEASE, "agent");
            asm volatile("s_waitcnt vmcnt(0)" ::: "memory");
            const unsigned og = xb_add(&bar[XB_TOP], 1u);
            const unsigned tg = og / nx;
            if (og + 1u == (tg + 1u) * nx) xb_add(&bar[XB_TOPGEN], 1u);
            else XB_SPIN(xb_ld(&bar[XB_TOPGEN]) == tg, bar);
            __builtin_amdgcn_fence(__ATOMIC_ACQUIRE, "agent");
            xb_add(&bar[XB_XGEN(b.x)], 1u);
            asm volatile("s_waitcnt vmcnt(0)" ::: "memory");
        } else {
            XB_SPIN(xb_ld(&bar[XB_XGEN(b.x)]) == gen, bar);
            __builtin_amdgcn_fence(__ATOMIC_ACQUIRE, "agent");
            asm volatile("s_waitcnt vmcnt(0)" ::: "memory");
        }
    }
    __syncthreads();
}


namespace pg8 {
constexpr int BM = 256, BK = 64, HALF = 128, HTB = HALF * BK * 2, STAGE_BYTES = 8 * HTB, NXCD = 8, WGM = 4;
__host__ __device__ __forceinline__ int lds_byte(int r, int c) { const int st = (r >> 4) * 2 + (c >> 5), rr = r & 15, cc = c & 31, ob = rr * 64 + cc * 2; return st * 1024 + (ob ^ (((ob >> 9) & 1) << 5)); }
__host__ __device__ __forceinline__ void stage_rc(int b, int& R, int& C) { const int st = b / 1024, sb = b % 1024, swz = sb ^ (((sb >> 9) & 1) << 5); R = (st >> 1) * 16 + swz / 64; C = (st & 1) * 32 + (swz % 64) / 2; }
__host__ __device__ __forceinline__ int perm32(int rho) { const int n = rho >> 4, i = rho & 15; return 8 * (i >> 2) + 4 * n + (i & 3); }

struct Unit { int pm, pn, z; };
struct Gemm { const bf16_t* A; const bf16_t* Bt; int M, N, K, lda, ldb; size_t za, zb; };

struct Order {
    int nM, nN, nZ, nwg, G, c;
    __device__ void init(int M, int N, int nZ_, int G_, int c_) { nM = M / BM; nN = N / BM; nZ = nZ_; nwg = nM * nN; G = G_; c = c_; }
    __device__ bool next(int i, Unit& u) const {
        const int ti = i / nZ; u.z = i - ti * nZ;
        const long L = (long)ti * G + c; if (L >= nwg) return false;
        int wgid = (int)L; { const int q = nwg / NXCD, r = nwg % NXCD, xcd = wgid % NXCD, off = wgid / NXCD; wgid = (xcd < r ? xcd * (q + 1) : r * (q + 1) + (xcd - r) * q) + off; }
        const int nig = WGM * nN, gid = wgid / nig, fm = gid * WGM, gsz = (nM - fm) < WGM ? (nM - fm) : WGM;
        u.pm = fm + ((wgid % nig) % gsz); u.pn = (wgid % nig) / gsz; return true;
    }
};

template <class Epi>
__device__ __forceinline__ void gemm_phase(LAS unsigned char* lds, const Gemm g, const Order& S, const Epi& E) {
    int tid = threadIdx.x; asm volatile("" : "+v"(tid));
    const int wid = __builtin_amdgcn_readfirstlane(tid >> 6), lane = tid & 63, wr = wid >> 2, wc = wid & 3, fr = lane & 15, fq = lane >> 4;
    const int K = g.K, nt = K / BK;
    unsigned voffA[2], voffB[2];
#pragma unroll
    for (int i = 0; i < 2; ++i) { int R, C; stage_rc(tid * 16 + i * 8192, R, C); const int Rb = Epi::PERM ? ((R & ~31) + perm32(R & 31)) : R;
        voffA[i] = (unsigned)(R * g.lda + C) * 2u; voffB[i] = (unsigned)(Rb * g.ldb + C) * 2u; }
    const size_t kstep = (size_t)(BK * 2);
    const size_t hstepA = (size_t)HALF * g.lda * 2, hstepB = (size_t)HALF * g.ldb * 2;
    const unsigned ldsw = (unsigned)wid * 1024u;
    const int aoff = lds_byte(wr * 64 + fr, fq * 8), boff = lds_byte(wc * 32 + fr, fq * 8);
#define PG8_SA(b, h) (((b) * 2 + (h)) * HTB)
#define PG8_SB(b, h) ((4 + (b) * 2 + (h)) * HTB)
#define PG8_STAGE(bufoff, gbase, voff) do { _Pragma("unroll") for (int _i = 0; _i < 2; ++_i) \
        __builtin_amdgcn_global_load_lds((const unsigned*)((const char*)(gbase) + (voff)[_i]), (LAS unsigned*)(lds + (bufoff) + ldsw + _i * 8192), 16, 0, 0); } while (0)
#define PG8_LDA(dst, b, h) do { _Pragma("unroll") for (int m = 0; m < 4; ++m) _Pragma("unroll") for (int k = 0; k < 2; ++k) dst[m][k] = *(const LAS bf16x8*)(lds + PG8_SA(b, h) + aoff + m * 2048 + k * 1024); } while (0)
#define PG8_LDB(dst, b, h) do { _Pragma("unroll") for (int n = 0; n < 2; ++n) _Pragma("unroll") for (int k = 0; k < 2; ++k) dst[n][k] = *(const LAS bf16x8*)(lds + PG8_SB(b, h) + boff + n * 2048 + k * 1024); } while (0)
#define PG8_MMA(ai, bj, At, Bt) do { __builtin_amdgcn_s_setprio(1); _Pragma("unroll") for (int m = 0; m < 4; ++m) _Pragma("unroll") for (int n = 0; n < 2; ++n) _Pragma("unroll") for (int k = 0; k < 2; ++k) \
        acc[ai][bj][m][n] = __builtin_amdgcn_mfma_f32_16x16x32_bf16(Bt[n][k], At[m][k], acc[ai][bj][m][n], 0, 0, 0); __builtin_amdgcn_s_setprio(0); } while (0)
#define PG8_WAIT_V(n) asm volatile("s_waitcnt vmcnt(" #n ")" ::: "memory")
#define PG8_WAIT_L(n) asm volatile("s_waitcnt lgkmcnt(" #n ")" ::: "memory")
#define PG8_BAR __builtin_amdgcn_s_barrier()
#define PG8_SCHED __builtin_amdgcn_sched_barrier(0)
    Unit cur, nxt; int ui = 0;
    if (!S.next(0, cur)) return;
    f32x4 acc[2][2][4][2];
#pragma unroll
    for (int a = 0; a < 2; ++a)
#pragma unroll
        for (int b = 0; b < 2; ++b)
#pragma unroll
            for (int m = 0; m < 4; ++m)
#pragma unroll
                for (int n = 0; n < 2; ++n) acc[a][b][m][n] = (f32x4){0.f, 0.f, 0.f, 0.f};
    bf16x8 At[4][2], B0[2][2], B1[2][2];
    const char* cA = (const char*)(g.A + (size_t)cur.pm * BM * g.lda + (size_t)cur.z * g.za);
    const char* cB = (const char*)(g.Bt + (size_t)cur.pn * BM * g.ldb + (size_t)cur.z * g.zb);
    PG8_STAGE(PG8_SB(0, 0), cB, voffB); PG8_STAGE(PG8_SA(0, 0), cA, voffA); PG8_STAGE(PG8_SB(0, 1), cB + hstepB, voffB); PG8_STAGE(PG8_SA(0, 1), cA + hstepA, voffA);
    if (wr == 1) PG8_BAR;
    PG8_WAIT_V(4); PG8_BAR;
    PG8_STAGE(PG8_SB(1, 0), cB + kstep, voffB); PG8_STAGE(PG8_SA(1, 0), cA + kstep, voffA); PG8_STAGE(PG8_SB(1, 1), cB + hstepB + kstep, voffB);
    PG8_WAIT_V(6); PG8_BAR;
    for (;;) {
        const bool has_next = S.next(ui + 1, nxt);
        const char* nA = has_next ? (const char*)(g.A + (size_t)nxt.pm * BM * g.lda + (size_t)nxt.z * g.za) : cA;
        const char* nB = has_next ? (const char*)(g.Bt + (size_t)nxt.pn * BM * g.ldb + (size_t)nxt.z * g.zb) : cB;
        for (int t = 0; t < nt; t += 2) {
            const bool last = (t == nt - 2);
            const char* a1 = cA + (size_t)(t + 1) * kstep;
            const char* a2 = last ? nA : cA + (size_t)(t + 2) * kstep; const char* b2 = last ? nB : cB + (size_t)(t + 2) * kstep;
            const char* a3 = a2 + kstep; const char* b3 = b2 + kstep;
            PG8_LDB(B0, 0, 0); PG8_SCHED; PG8_LDA(At, 0, 0); PG8_STAGE(PG8_SA(1, 1), a1 + hstepA, voffA);
            PG8_WAIT_L(8); PG8_BAR; PG8_WAIT_L(0); PG8_MMA(0, 0, At, B0); PG8_BAR; PG8_SCHED;
            PG8_LDB(B1, 0, 1); PG8_STAGE(PG8_SB(0, 0), b2, voffB);
            PG8_BAR; PG8_WAIT_L(0); PG8_MMA(0, 1, At, B1); PG8_BAR;
            PG8_LDA(At, 0, 1); PG8_STAGE(PG8_SA(0, 0), a2, voffA);
            PG8_BAR; PG8_WAIT_L(0); PG8_MMA(1, 0, At, B0); PG8_BAR; PG8_SCHED;
            PG8_STAGE(PG8_SB(0, 1), b2 + hstepB, voffB);
            PG8_WAIT_V(6); PG8_BAR; PG8_MMA(1, 1, At, B1); PG8_BAR;
            PG8_LDB(B0, 1, 0); PG8_SCHED; PG8_LDA(At, 1, 0); PG8_STAGE(PG8_SA(0, 1), a2 + hstepA, voffA);
            PG8_WAIT_L(8); PG8_BAR; PG8_WAIT_L(0); PG8_MMA(0, 0, At, B0); PG8_BAR; PG8_SCHED;
            PG8_LDB(B1, 1, 1); PG8_STAGE(PG8_SB(1, 0), b3, voffB);
            PG8_BAR; PG8_WAIT_L(0); PG8_MMA(0, 1, At, B1); PG8_BAR;
            PG8_LDA(At, 1, 1); PG8_STAGE(PG8_SA(1, 0), a3, voffA);
            PG8_BAR; PG8_WAIT_L(0); PG8_MMA(1, 0, At, B0); PG8_BAR; PG8_SCHED;
            PG8_STAGE(PG8_SB(1, 1), b3 + hstepB, voffB);
            PG8_WAIT_V(6); PG8_BAR; PG8_MMA(1, 1, At, B1); PG8_BAR;
        }
        if constexpr (!Epi::AFTER_DRAIN) E(acc, cur, wr, wc, fr, fq);
        if (!has_next) break;
        if (!(Epi::KEEP_ACC && nxt.z != 0)) {
#pragma unroll
        for (int a = 0; a < 2; ++a)
#pragma unroll
            for (int b = 0; b < 2; ++b)
#pragma unroll
                for (int m = 0; m < 4; ++m)
#pragma unroll
                    for (int n = 0; n < 2; ++n) acc[a][b][m][n] = (f32x4){0.f, 0.f, 0.f, 0.f};
        }
        cur = nxt; cA = nA; cB = nB; ++ui;
    }
    PG8_WAIT_V(0);
    if (wr == 0) PG8_BAR;
    PG8_BAR;
    if constexpr (Epi::AFTER_DRAIN) E.fused(acc, cur, wr, wc, fr, fq, lds, wid, lane);
#undef PG8_SA
#undef PG8_SB
#undef PG8_STAGE
#undef PG8_LDA
#undef PG8_LDB
#undef PG8_MMA
#undef PG8_WAIT_V
#undef PG8_WAIT_L
#undef PG8_BAR
#undef PG8_SCHED
}

struct EpiSwiglu {
    static constexpr bool PERM = true, AFTER_DRAIN = false, KEEP_ACC = false;
    bf16_t* O; int ldc;
    __device__ __forceinline__ void operator()(const f32x4 (&acc)[2][2][4][2], const Unit& u, int wr, int wc, int fr, int fq) const {
        const int row0 = u.pm * BM + wr * 64 + fr, col0 = u.pn * HALF + wc * 32 + 8 * fq;
#pragma unroll
        for (int ai = 0; ai < 2; ++ai)
#pragma unroll
            for (int m = 0; m < 4; ++m) {
                bf16_t* rowp = O + (size_t)(row0 + ai * HALF + m * 16) * ldc + col0;
                float r[8];
#pragma unroll
                for (int n = 0; n < 2; ++n)
#pragma unroll
                    for (int j = 0; j < 4; ++j) { const float gv = acc[ai][0][m][n][j], uv = acc[ai][1][m][n][j]; r[n * 4 + j] = gv * sigmoidf_fast(gv) * uv; }
                u32x4 w; w.x = cvt_pk_bf16(r[0], r[1]); w.y = cvt_pk_bf16(r[2], r[3]); w.z = cvt_pk_bf16(r[4], r[5]); w.w = cvt_pk_bf16(r[6], r[7]);
                *(u32x4*)rowp = w;
            }
    }
};
struct EpiResidLN {
    static constexpr bool PERM = true, AFTER_DRAIN = true, KEEP_ACC = false;
    float* xout; bf16_t* X16; bf16_t* XB; const float* gam; const float* bet; float beta;
    unsigned long long* xbuf; unsigned* cnt; unsigned want;
    __device__ __forceinline__ void fused(f32x4 (&acc)[2][2][4][2], const Unit& u, int wr, int wc, int fr, int fq, LAS unsigned char* lds, int wid, int lane) const {
        LAS f32x2* P = (LAS f32x2*)lds;
        LAS f32x2* S = (LAS f32x2*)(lds + 8192);
        const int row0 = u.pm * BM + wr * 64 + fr, col0 = u.pn * BM + wc * 32 + 8 * fq;
        {
            u32x4 hw[2][2];
#pragma unroll
            for (int bj = 0; bj < 2; ++bj) hw[0][bj] = *(const u32x4*)(X16 + (size_t)row0 * D + col0 + bj * HALF);
#pragma unroll
            for (int gi = 0; gi < 8; ++gi) {
                const int ai = gi >> 2, m = gi & 3;
                if (gi + 1 < 8) { const int ai1 = (gi + 1) >> 2, m1 = (gi + 1) & 3;
#pragma unroll
                    for (int bj = 0; bj < 2; ++bj) hw[(gi + 1) & 1][bj] = *(const u32x4*)(X16 + (size_t)(row0 + ai1 * HALF + m1 * 16) * D + col0 + bj * HALF); }
                asm volatile("" ::: "memory");
#pragma unroll
                for (int bj = 0; bj < 2; ++bj) { const u32x4 h = hw[gi & 1][bj];
                    const f32x4 x0 = (f32x4){h_lo(h.x), h_hi(h.x), h_lo(h.y), h_hi(h.y)}, x1 = (f32x4){h_lo(h.z), h_hi(h.z), h_lo(h.w), h_hi(h.w)};
                    acc[ai][bj][m][0] = x0 * ALPHA + acc[ai][bj][m][0] * beta; acc[ai][bj][m][1] = x1 * ALPHA + acc[ai][bj][m][1] * beta; }
                asm volatile("" : "+v"(acc[ai][0][m][0]), "+v"(acc[ai][0][m][1]), "+v"(acc[ai][1][m][0]), "+v"(acc[ai][1][m][1]));
            }
        }
#pragma unroll
        for (int ai = 0; ai < 2; ++ai)
#pragma unroll
            for (int m = 0; m < 4; ++m) {
                float s = 0.f;
#pragma unroll
                for (int bj = 0; bj < 2; ++bj)
#pragma unroll
                    for (int n = 0; n < 2; ++n) { const f32x4 x = acc[ai][bj][m][n]; s += (x[0] + x[1]) + (x[2] + x[3]); }
                s += __shfl_xor(s, 16); s += __shfl_xor(s, 32);
                const float mw = s * (1.0f / 64.0f); float q = 0.f;
#pragma unroll
                for (int bj = 0; bj < 2; ++bj)
#pragma unroll
                    for (int n = 0; n < 2; ++n) { const f32x4 d = acc[ai][bj][m][n] - mw; q += (d[0] * d[0] + d[1] * d[1]) + (d[2] * d[2] + d[3] * d[3]); }
                q += __shfl_xor(q, 16); q += __shfl_xor(q, 32);
                if (fq == 0) P[(ai * HALF + wr * 64 + m * 16 + fr) * 4 + wc] = (f32x2){mw, q};
            }
        asm volatile("s_waitcnt lgkmcnt(0)" ::: "memory"); __builtin_amdgcn_s_barrier(); asm volatile("" ::: "memory");
        const int row = wid * 32 + (lane & 31);
        if (lane < 32) {
            const f32x2 a = P[row * 4 + 0], b = P[row * 4 + 1], c = P[row * 4 + 2], d = P[row * 4 + 3];
            const float mt = (a.x + b.x + c.x + d.x) * 0.25f;
            const float da = a.x - mt, db = b.x - mt, dc = c.x - mt, dd = d.x - mt;
            const float m2 = (a.y + b.y) + (c.y + d.y) + 64.0f * ((da * da + db * db) + (dc * dc + dd * dd));
            unsigned long long* slot = xbuf + ((size_t)((u.pm & 63) * BM + row) * 4 + u.pn);
            __hip_atomic_store(slot, ((unsigned long long)__float_as_uint(m2) << 32) | __float_as_uint(mt), __ATOMIC_RELAXED, __HIP_MEMORY_SCOPE_AGENT);
        }
        asm volatile("s_waitcnt vmcnt(0)" ::: "memory");
        if (lane == 0) __hip_atomic_fetch_add(cnt + 64 * (u.pm & 63), 1u, __ATOMIC_RELAXED, __HIP_MEMORY_SCOPE_AGENT);
        if (wid == 0) {
            unsigned spins = 0;
            while ((unsigned)__builtin_amdgcn_readfirstlane(__hip_atomic_load(cnt + 64 * (u.pm & 63), __ATOMIC_RELAXED, __HIP_MEMORY_SCOPE_AGENT)) < want) { __builtin_amdgcn_s_sleep(2); if (++spins > (1u << 22)) break; }
            __builtin_amdgcn_fence(__ATOMIC_ACQUIRE, "agent");
        }
        asm volatile("s_waitcnt vmcnt(0) lgkmcnt(0)" ::: "memory"); __builtin_amdgcn_s_barrier(); asm volatile("" ::: "memory");
        if (lane < 32) {
            const unsigned long long* slot = xbuf + (size_t)((u.pm & 63) * BM + row) * 4; float mt[4], m2[4]; float ms = 0.f;
#pragma unroll
            for (int t = 0; t < 4; ++t) { const unsigned long long w = __hip_atomic_load(slot + t, __ATOMIC_RELAXED, __HIP_MEMORY_SCOPE_AGENT); mt[t] = __uint_as_float((unsigned)w); m2[t] = __uint_as_float((unsigned)(w >> 32)); ms += mt[t]; }
            const float mean = ms * 0.25f; float q = 0.f;
#pragma unroll
            for (int t = 0; t < 4; ++t) { const float dm = mt[t] - mean; q += m2[t] + 256.0f * dm * dm; }
            S[row] = (f32x2){mean, 1.0f / sqrtf(q * (1.0f / 1024.0f) + LN_EPS)};
        }
        asm volatile("s_waitcnt lgkmcnt(0)" ::: "memory"); __builtin_amdgcn_s_barrier(); asm volatile("" ::: "memory");
        f32x4 gv[2][2], bv[2][2];
#pragma unroll
        for (int bj = 0; bj < 2; ++bj)
#pragma unroll
            for (int n = 0; n < 2; ++n) { gv[bj][n] = *(const f32x4*)(gam + col0 + bj * HALF + 4 * n); bv[bj][n] = *(const f32x4*)(bet + col0 + bj * HALF + 4 * n); }
#pragma unroll
        for (int ai = 0; ai < 2; ++ai)
#pragma unroll
            for (int m = 0; m < 4; ++m) { const int r = ai * HALF + wr * 64 + m * 16 + fr; const f32x2 sr = S[r]; const size_t off = (size_t)(u.pm * BM + r) * D + col0;
#pragma unroll
                for (int bj = 0; bj < 2; ++bj) {
                    const f32x4 y0 = (acc[ai][bj][m][0] - sr.x) * sr.y * gv[bj][0] + bv[bj][0], y1 = (acc[ai][bj][m][1] - sr.x) * sr.y * gv[bj][1] + bv[bj][1];
                    if (xout) { *(f32x4*)(xout + off + bj * HALF) = y0; *(f32x4*)(xout + off + bj * HALF + 4) = y1; }
                    else { u32x4 hw; hw.x = cvt_pk_h(y0[0], y0[1]); hw.y = cvt_pk_h(y0[2], y0[3]); hw.z = cvt_pk_h(y1[0], y1[1]); hw.w = cvt_pk_h(y1[2], y1[3]); *(u32x4*)(X16 + off + bj * HALF) = hw;
                        u32x4 w; w.x = cvt_pk_bf16(y0[0], y0[1]); w.y = cvt_pk_bf16(y0[2], y0[3]); w.z = cvt_pk_bf16(y1[0], y1[1]); w.w = cvt_pk_bf16(y1[2], y1[3]); *(u32x4*)(XB + off + bj * HALF) = w; } }
                asm volatile("" ::: "memory"); }
    }
};
struct EpiInproj {
    static constexpr bool PERM = true, AFTER_DRAIN = false, KEEP_ACC = false;
    bf16_t* P; bf16_t* G;
    __device__ __forceinline__ void operator()(const f32x4 (&acc)[2][2][4][2], const Unit& u, int wr, int wc, int fr, int fq) const {
        const bool isg = u.pn >= 11;
        bf16_t* base = isg ? G : P; const int ldc = isg ? GATEC : PROJC; const int colt = isg ? (u.pn - 11) * BM : u.pn * BM;
        const int row0 = u.pm * BM + wr * 64 + fr, col0 = colt + wc * 32 + 8 * fq;
#pragma unroll
        for (int ai = 0; ai < 2; ++ai)
#pragma unroll
            for (int m = 0; m < 4; ++m) { bf16_t* rowp = base + (size_t)(row0 + ai * HALF + m * 16) * ldc + col0;
#pragma unroll
                for (int bj = 0; bj < 2; ++bj) { f32x4 v0 = acc[ai][bj][m][0], v1 = acc[ai][bj][m][1];
                    if (isg) {
#pragma unroll
                        for (int j = 0; j < 4; ++j) { v0[j] = fmaxf(sigmoidf_fast(v0[j]), 1e-30f); v1[j] = fmaxf(sigmoidf_fast(v1[j]), 1e-30f); } }
                    u32x4 w; w.x = cvt_pk_bf16(v0[0], v0[1]); w.y = cvt_pk_bf16(v0[2], v0[3]); w.z = cvt_pk_bf16(v1[0], v1[1]); w.w = cvt_pk_bf16(v1[2], v1[3]);
                    *(u32x4*)(rowp + bj * HALF) = w; } }
    }
};
struct EpiBf16Plain {
    static constexpr bool PERM = true, AFTER_DRAIN = false, KEEP_ACC = false;
    bf16_t* O; int ldc;
    __device__ __forceinline__ void operator()(const f32x4 (&acc)[2][2][4][2], const Unit& u, int wr, int wc, int fr, int fq) const {
        const int row0 = u.pm * BM + wr * 64 + fr, col0 = u.pn * BM + wc * 32 + 8 * fq;
#pragma unroll
        for (int ai = 0; ai < 2; ++ai)
#pragma unroll
            for (int m = 0; m < 4; ++m) { bf16_t* rowp = O + (size_t)(row0 + ai * HALF + m * 16) * ldc + col0;
#pragma unroll
                for (int bj = 0; bj < 2; ++bj) { const f32x4 v0 = acc[ai][bj][m][0], v1 = acc[ai][bj][m][1];
                    u32x4 w; w.x = cvt_pk_bf16(v0[0], v0[1]); w.y = cvt_pk_bf16(v0[2], v0[3]); w.z = cvt_pk_bf16(v1[0], v1[1]); w.w = cvt_pk_bf16(v1[2], v1[3]);
                    *(u32x4*)(rowp + bj * HALF) = w; } }
    }
};
struct EpiBranch {
    static constexpr bool PERM = true, AFTER_DRAIN = false, KEEP_ACC = true;
    const bf16_t* G; bf16_t* O;
    __device__ __forceinline__ void operator()(f32x4 (&acc)[2][2][4][2], const Unit& u, int wr, int wc, int fr, int fq) const {
        const int row0 = u.pm * BM + wr * 64 + fr, col0 = u.pn * BM + wc * 32 + 8 * fq;
        const bool mid = u.z < 2;
        const bf16_t* g0p = G + (size_t)u.z * D + col0; const bf16_t* g1p = G + (size_t)(mid ? u.z + 1 : u.z) * D + col0;
        u32x4 gq[2][2][2];
#pragma unroll
        for (int bj = 0; bj < 2; ++bj) { gq[0][bj][0] = *(const u32x4*)(g0p + (size_t)row0 * GATEC + bj * HALF); gq[0][bj][1] = *(const u32x4*)(g1p + (size_t)row0 * GATEC + bj * HALF); }
#pragma unroll
        for (int gi = 0; gi < 8; ++gi) {
            const int ai = gi >> 2, m = gi & 3; const size_t row = (size_t)(row0 + ai * HALF + m * 16);
            if (gi + 1 < 8) { const size_t row1 = (size_t)(row0 + ((gi + 1) >> 2) * HALF + ((gi + 1) & 3) * 16);
#pragma unroll
                for (int bj = 0; bj < 2; ++bj) { gq[(gi + 1) & 1][bj][0] = *(const u32x4*)(g0p + row1 * GATEC + bj * HALF); gq[(gi + 1) & 1][bj][1] = *(const u32x4*)(g1p + row1 * GATEC + bj * HALF); } }
            asm volatile("" ::: "memory");
#pragma unroll
            for (int bj = 0; bj < 2; ++bj) {
                const int col = col0 + bj * HALF;
                const u32x4 gw = gq[gi & 1][bj][0];
                f32x4 g0 = (f32x4){bf_lo(gw.x), bf_hi(gw.x), bf_lo(gw.y), bf_hi(gw.y)}, g1 = (f32x4){bf_lo(gw.z), bf_hi(gw.z), bf_lo(gw.w), bf_hi(gw.w)};
                if (mid) {
                    const u32x4 nw = gq[gi & 1][bj][1];
#pragma unroll
                    for (int j = 0; j < 2; ++j) { const unsigned a = j == 0 ? nw.x : nw.y, b = j == 0 ? nw.z : nw.w;
                        g0[2 * j] *= fast_rcp(bf_lo(a)); g0[2 * j + 1] *= fast_rcp(bf_hi(a)); g1[2 * j] *= fast_rcp(bf_lo(b)); g1[2 * j + 1] *= fast_rcp(bf_hi(b)); }
                    acc[ai][bj][m][0] *= g0; acc[ai][bj][m][1] *= g1;
                } else {
                    const f32x4 v0 = g0 * acc[ai][bj][m][0], v1 = g1 * acc[ai][bj][m][1];
                    u32x4 w; w.x = cvt_pk_bf16(v0[0], v0[1]); w.y = cvt_pk_bf16(v0[2], v0[3]); w.z = cvt_pk_bf16(v1[0], v1[1]); w.w = cvt_pk_bf16(v1[2], v1[3]);
                    *(u32x4*)(O + row * D + col) = w; }
            }
            asm volatile("" : "+v"(acc[ai][0][m][0]), "+v"(acc[ai][0][m][1]), "+v"(acc[ai][1][m][0]), "+v"(acc[ai][1][m][1]));
        }
    }
};
}

__device__ __forceinline__ void tr_item(const float* W, int ldw, bf16_t* WT, int ldt, int k0, int n0, int c0, float scale, LAS float* scr, int lane) {
    float wv[32];
#pragma unroll
    for (int i = 0; i < 32; ++i) wv[i] = W[(size_t)(k0 + 2 * i + (lane >> 5)) * ldw + c0 + (lane & 31)];
#pragma unroll
    for (int i = 0; i < 32; ++i) scr[(2 * i + (lane >> 5)) * 33 + (lane & 31)] = wv[i];
    asm volatile("s_waitcnt lgkmcnt(0)" ::: "memory");
    const int c = lane & 7;
#pragma unroll
    for (int j = 0; j < 4; ++j) { const int n = (lane >> 3) + 8 * j; const LAS float* sp = scr + (8 * c) * 33 + n;
        u32x4 o; o.x = cvt_pk_bf16(sp[0 * 33] * scale, sp[1 * 33] * scale); o.y = cvt_pk_bf16(sp[2 * 33] * scale, sp[3 * 33] * scale);
        o.z = cvt_pk_bf16(sp[4 * 33] * scale, sp[5 * 33] * scale); o.w = cvt_pk_bf16(sp[6 * 33] * scale, sp[7 * 33] * scale);
        *(u32x4*)(WT + (size_t)(n0 + n) * ldt + k0 + 8 * c) = o; }
    asm volatile("s_waitcnt lgkmcnt(0)" ::: "memory");
}
template <int MODE>
__device__ __forceinline__ void tr_matrix(const float* W, int K, int N, int ldw, bf16_t* WT, int ldt, LAS float* scr, int gw, int ngw, int lane) {
    const int nblk = N / 32, nitems = (K / 64) * nblk;
    for (int it = gw; it < nitems; it += ngw) {
        const int kb = it / nblk, nb = it - kb * nblk, n0 = nb * 32; int c0 = n0; float scale = 1.f;
        if (MODE == 1) { const int tile = n0 >> 8, bj = (n0 >> 7) & 1, c = n0 & 127; c0 = bj * DFF + tile * 128 + c; }
        if (MODE == 2) { if (n0 < 512 || (n0 >= 768 && n0 < 1280)) scale = 0.125f * LOG2E; else if (n0 >= 2304 && n0 < 2816) scale = 0.08838834764831845f * LOG2E; }
        tr_item(W, ldw, WT, ldt, kb * 64, n0, c0, scale, scr, lane);
    }
}

struct AttnP {
    const bf16_t *q, *k, *v; bf16_t* o; float* lse;
    int q_rs, q_toff, kv_rs, o_rs, o_toff, lse_rs, lse_toff;
    int qpos0, qpos_tstep, k_lo, nsteps, sub_len, radius;
    float slope2, slope_tmul;
    float sink2[4];
};
__device__ __forceinline__ s16x4 vtr(const LAS unsigned char* p) {
    typedef short v4i16_t __attribute__((ext_vector_type(4)));
    return __builtin_bit_cast(s16x4, __builtin_amdgcn_ds_read_tr16_b64_v4i16((LAS v4i16_t*)p));
}
__device__ __forceinline__ float rowgrp_max(float m) {
    const auto r = __builtin_amdgcn_permlane16_swap(__float_as_uint(m), __float_as_uint(m), false, false);
    const float a = fmaxf(__uint_as_float(r[0]), __uint_as_float(r[1]));
    const auto r2 = __builtin_amdgcn_permlane32_swap(__float_as_uint(a), __float_as_uint(a), false, false);
    return fmaxf(__uint_as_float(r2[0]), __uint_as_float(r2[1]));
}
__device__ __forceinline__ float rowgrp_sum(float m) {
    const auto r = __builtin_amdgcn_permlane16_swap(__float_as_uint(m), __float_as_uint(m), false, false);
    const float a = __uint_as_float(r[0]) + __uint_as_float(r[1]);
    const auto r2 = __builtin_amdgcn_permlane32_swap(__float_as_uint(a), __float_as_uint(a), false, false);
    return __uint_as_float(r2[0]) + __uint_as_float(r2[1]);
}
template <int DH, int NT, int MODE>
__device__ __forceinline__ void attn_item(const AttnP& P, LAS unsigned char* vl, int lane_in, const LAS unsigned char* kl = nullptr) {
    int lane = lane_in; asm volatile("" : "+v"(lane));
    constexpr bool MASK = MODE < 2, SINK = MODE == 0, LSE = MODE == 1, INLDS = MODE == 3;
    constexpr int NSTEPS = MODE == 0 ? 9 : (MODE == 1 ? 6 : 8), QTSTEP = MODE == 1 ? 16 : 0;
    constexpr float RADF = MODE == 0 ? 128.f : 64.f, SLOPE_TMUL = MODE == 0 ? 0.5f : 1.0f;
    constexpr int KS = DH / 32, ND = DH / 16, VP = DH * 2 + 32, NVL = DH / 16;
    const int fr = lane & 15, g = lane >> 4;
    bf16x8 qf[NT][KS];
#pragma unroll
    for (int i = 0; i < NT; ++i)
#pragma unroll
        for (int ks = 0; ks < KS; ++ks) qf[i][ks] = *(const bf16x8*)(P.q + (size_t)i * P.q_toff + (size_t)fr * P.q_rs + ks * 32 + g * 8);
    f32x4 o[NT][ND]; float mrun[NT], lrun[NT];
#pragma unroll
    for (int i = 0; i < NT; ++i) {
#pragma unroll
        for (int d = 0; d < ND; ++d) o[i][d] = (f32x4){0.f, 0.f, 0.f, 0.f};
        mrun[i] = SINK ? P.sink2[i] : -1e30f; lrun[i] = (SINK && g == 0) ? 1.f : 0.f; }
    bf16x8 kf[2][KS]; u32x4 vr[NVL];
    constexpr int CPR = DH / 8;
    const int kmax = P.sub_len - 1, klo = P.k_lo, kvrs = P.kv_rs;
    const bf16_t* kbase = P.k + g * 8; const bf16_t* vbase = P.v;
    if (!INLDS) {
#pragma unroll
        for (int a = 0; a < 2; ++a) { int kp = klo + 16 * a + fr; kp = kp < 0 ? 0 : (kp > kmax ? kmax : kp);
#pragma unroll
            for (int ks = 0; ks < KS; ++ks) kf[a][ks] = *(const bf16x8*)(kbase + (size_t)kp * kvrs + ks * 32); }
#pragma unroll
        for (int it = 0; it < NVL; ++it) { const int idx = it * 64 + lane, r = idx / CPR, ch = idx % CPR; int kp = klo + r; kp = kp < 0 ? 0 : (kp > kmax ? kmax : kp);
            vr[it] = *(const u32x4*)(vbase + (size_t)kp * kvrs + ch * 8); }
    }
    const LAS unsigned char* vrd = vl + (4 * g + (fr >> 2)) * VP + 8 * (fr & 3);
    const float qbase = (float)(4 * g - P.qpos0 - fr);
    for (int s = 0; s < NSTEPS; ++s) {
        const int k0 = klo + 32 * s;
        asm volatile("" ::: "memory");
        bf16x8 kc[2][KS];
        if (INLDS) {
#pragma unroll
            for (int a = 0; a < 2; ++a)
#pragma unroll
                for (int ks = 0; ks < KS; ++ks) kc[a][ks] = *(const LAS bf16x8*)(kl + (32 * s + 16 * a + fr) * VP + (ks * 32 + 8 * g) * 2);
        } else {
#pragma unroll
        for (int it = 0; it < NVL; ++it) { const int idx = it * 64 + lane, r = idx / CPR, ch = idx % CPR; *(LAS u32x4*)(vl + r * VP + ch * 16) = vr[it]; }
#pragma unroll
        for (int a = 0; a < 2; ++a)
#pragma unroll
            for (int ks = 0; ks < KS; ++ks) kc[a][ks] = kf[a][ks];
        }
        if (!INLDS && s + 1 < NSTEPS) {
            const int k1 = k0 + 32;
#pragma unroll
            for (int a = 0; a < 2; ++a) { int kp = k1 + 16 * a + fr; kp = kp < 0 ? 0 : (kp > kmax ? kmax : kp);
#pragma unroll
                for (int ks = 0; ks < KS; ++ks) kf[a][ks] = *(const bf16x8*)(kbase + (size_t)kp * kvrs + ks * 32); }
#pragma unroll
            for (int it = 0; it < NVL; ++it) { const int idx = it * 64 + lane, r = idx / CPR, ch = idx % CPR; int kp = k1 + r; kp = kp < 0 ? 0 : (kp > kmax ? kmax : kp);
                vr[it] = *(const u32x4*)(vbase + (size_t)kp * kvrs + ch * 8); }
        }
        asm volatile("s_waitcnt lgkmcnt(0)" ::: "memory");
        const bool edge = (k0 < 0) || (k0 + 31 > kmax);
        const float kf0 = (float)k0 + qbase;
        float koff[2][4];
#pragma unroll
        for (int a = 0; a < 2; ++a)
#pragma unroll
            for (int r = 0; r < 4; ++r) { koff[a][r] = (float)(16 * a + r); if (MASK && edge) { const int kp = k0 + 16 * a + 4 * g + r; if (kp < 0 || kp > kmax) koff[a][r] = INFINITY; } }
        bf16x8 pf[NT]; float alv[NT]; bool act[NT];
#pragma unroll
        for (int i = 0; i < NT; ++i) {
            act[i] = !(MODE == 1) || (s >= (i >> 1) && s <= (i >> 1) + 4);
            if (!act[i]) { alv[i] = 1.0f; continue; }
            f32x4 sc[2];
#pragma unroll
            for (int a = 0; a < 2; ++a) { sc[a] = (f32x4){0.f, 0.f, 0.f, 0.f};
#pragma unroll
                for (int ks = 0; ks < KS; ++ks) sc[a] = __builtin_amdgcn_mfma_f32_16x16x32_bf16(kc[a][ks], qf[i][ks], sc[a], 0, 0, 0); }
            if (MASK) {
                float slope = P.slope2;
#pragma unroll
                for (int t = 0; t < i; ++t) slope *= SLOPE_TMUL;
                const float base = kf0 - (float)(i * QTSTEP);
#pragma unroll
                for (int a = 0; a < 2; ++a)
#pragma unroll
                    for (int r = 0; r < 4; ++r) { const float ad = fabsf(base + koff[a][r]);
                        sc[a][r] = (ad <= RADF) ? fmaf(-slope, ad, sc[a][r]) : -INFINITY; }
            }
            float mx = fmaxf(fmaxf(fmaxf(sc[0][0], sc[0][1]), fmaxf(sc[0][2], sc[0][3])), fmaxf(fmaxf(sc[1][0], sc[1][1]), fmaxf(sc[1][2], sc[1][3])));
            mx = rowgrp_max(mx);
            const float mnew = fmaxf(mrun[i], mx); alv[i] = fast_exp2(mrun[i] - mnew);
            mrun[i] = mnew;
            float ps = 0.f;
#pragma unroll
            for (int a = 0; a < 2; ++a)
#pragma unroll
                for (int r = 0; r < 4; ++r) { const float p = fast_exp2(sc[a][r] - mnew); sc[a][r] = p; ps += p; }
            lrun[i] = lrun[i] * alv[i] + ps;
            union { bf16x8 v; unsigned u[4]; } pk;
            pk.u[0] = cvt_pk_bf16(sc[0][0], sc[0][1]); pk.u[1] = cvt_pk_bf16(sc[0][2], sc[0][3]); pk.u[2] = cvt_pk_bf16(sc[1][0], sc[1][1]); pk.u[3] = cvt_pk_bf16(sc[1][2], sc[1][3]);
            pf[i] = pk.v;
        }
        bool resc[NT];
#pragma unroll
        for (int i = 0; i < NT; ++i) resc[i] = act[i];
#pragma unroll
        for (int d = 0; d < ND; ++d) {
            const LAS unsigned char* vs = INLDS ? vrd + s * 32 * VP : vrd;
            const s16x4 lo = vtr(vs + d * 32), hi = vtr(vs + 16 * VP + d * 32);
            const bf16x8 vt = (bf16x8){lo[0], lo[1], lo[2], lo[3], hi[0], hi[1], hi[2], hi[3]};
#pragma unroll
            for (int i = 0; i < NT; ++i) { if (resc[i]) o[i][d] = o[i][d] * alv[i]; if (act[i]) o[i][d] = __builtin_amdgcn_mfma_f32_16x16x32_bf16(vt, pf[i], o[i][d], 0, 0, 0); }
        }
        asm volatile("" ::: "memory");
    }
#pragma unroll
    for (int i = 0; i < NT; ++i) {
        const float l = rowgrp_sum(lrun[i]);
        const float inv = 1.0f / l;
        bf16_t* orow = P.o + (size_t)i * P.o_toff + (size_t)fr * P.o_rs + 4 * g;
#pragma unroll
        for (int d = 0; d < ND; ++d) { u32x2 w; w.x = cvt_pk_bf16(o[i][d][0] * inv, o[i][d][1] * inv); w.y = cvt_pk_bf16(o[i][d][2] * inv, o[i][d][3] * inv); *(u32x2*)(orow + 16 * d) = w; }
        if (LSE) { if (g == 0) P.lse[(size_t)i * P.lse_toff + (size_t)fr * P.lse_rs] = mrun[i] + __log2f(l); }
    }
}

struct Args {
    const float* in[19];
    float* out; unsigned char* ws;
};

__global__ void __launch_bounds__(512, 2) mega_fwd(Args args) {
    extern __shared__ __attribute__((aligned(16))) unsigned char lds_raw[];
    LAS unsigned char* lds = (LAS unsigned char*)lds_raw;
    cg::grid_group grid = cg::this_grid();
    const int G = gridDim.x, bx = blockIdx.x;
    volatile LAS unsigned* MISC = (volatile LAS unsigned*)(lds + LDS_MISC);
    if (threadIdx.x < 32) MISC[threadIdx.x] = 0u;
    __syncthreads();
    grid.sync();
    const XcdBarrier bar = xcd_barrier_post((unsigned*)(args.ws + WS_CTL), MISC + 8);
    constexpr int PH_PER_CHUNK = NLAYER * 9, NPH = 2 + NCHUNK * PH_PER_CHUNK;
    for (int ph_i = 0; ph_i < NPH; ++ph_i) {
        int ph = ph_i; asm volatile("" : "+s"(ph));
        int lane = threadIdx.x & 63; asm volatile("" : "+v"(lane));
        const int wave = __builtin_amdgcn_readfirstlane(threadIdx.x >> 6);
        const int vcu = (G % 8 == 0) ? (bx % 8) * (G / 8) + bx / 8 : bx;
        const int gw = vcu * 8 + wave, NGW = G * 8;
        unsigned char* ws = args.ws;
        bf16_t* Wb = (bf16_t*)(ws + WS_W); bf16_t* Wmem = (bf16_t*)(ws + WS_WMEM); bf16_t* memb = (bf16_t*)(ws + WS_MEMB); bf16_t* memkv = (bf16_t*)(ws + WS_MEMKV);
        bf16_t* xb = (bf16_t*)(ws + WS_XB);
        bf16_t* hb = (bf16_t*)(ws + WS_U + U_H); bf16_t* proj = (bf16_t*)(ws + WS_U + U_PROJ); bf16_t* gates = (bf16_t*)(ws + WS_U + U_GATES); bf16_t* br = (bf16_t*)(ws + WS_U + U_BR);
        bf16_t* bpart = (bf16_t*)(ws + WS_U + U_BPART); float* lseb = (float*)(ws + WS_U + U_LSE); float* mixf = (float*)(ws + WS_U + U_MIXF); bf16_t* mixb = (bf16_t*)(ws + WS_U + U_MIXB);
        int load_chunk = -1;
        if (ph == 0) { for (int rep = 0; rep < REP_PRO; ++rep) {
            LAS float* scr = (LAS float*)(lds + wave * 16384);
            for (int l = 0; l < NLAYER; ++l) {
                bf16_t* WL = Wb + (size_t)l * W_LAYER_ELEMS;
                tr_matrix<1>(args.in[4] + (size_t)l * D * 2 * DFF, D, 2 * DFF, 2 * DFF, WL + OFF_W1IN, D, scr, gw, NGW, lane);
                tr_matrix<0>(args.in[5] + (size_t)l * DFF * D, DFF, D, D, WL + OFF_W1OUT, DFF, scr, gw, NGW, lane);
                tr_matrix<2>(args.in[8] + (size_t)l * D * INC, D, INC, INC, WL + OFF_WIN, D, scr, gw, NGW, lane);
                tr_matrix<0>(args.in[9] + (size_t)l * D * 1024, D, 1024, 1024, Wmem + (size_t)l * 1024 * D, D, scr, gw, NGW, lane);
                for (int i = 0; i < 3; ++i) tr_matrix<0>(args.in[11] + ((size_t)l * 3 + i) * 512 * D, 512, D, D, WL + OFF_WBR + (size_t)i * D * 512, 512, scr, gw, NGW, lane);
                tr_matrix<0>(args.in[12] + (size_t)l * D * D, D, D, D, WL + OFF_WOUT, D, scr, gw, NGW, lane);
                tr_matrix<1>(args.in[15] + (size_t)l * D * 2 * DFF, D, 2 * DFF, 2 * DFF, WL + OFF_W2IN, D, scr, gw, NGW, lane);
                tr_matrix<0>(args.in[16] + (size_t)l * DFF * D, DFF, D, D, WL + OFF_W2OUT, DFF, scr, gw, NGW, lane);
            }
            for (int m = gw; m < MEMROWS; m += NGW) {
                const float* src = (m < 4096) ? args.in[2] + (size_t)m * D : args.in[3] + (size_t)(m - 4096) * D;
#pragma unroll
                for (int j = 0; j < 4; ++j) { const f32x4 v = *((const f32x4*)src + lane + 64 * j); u32x2 w; w.x = cvt_pk_bf16(v[0], v[1]); w.y = cvt_pk_bf16(v[2], v[3]); *((u32x2*)(memb + (size_t)m * D) + lane + 64 * j) = w; }
            } }
            load_chunk = 0;
        } else if (ph == 1) {
            pg8::Gemm g{memb, Wmem, MEMROWS, 2048, D, D, D, 0, 0}; pg8::Order S; S.init(MEMROWS, 2048, 1, G, bx);
            pg8::EpiBf16Plain E{memkv, 2048};
            pg8::gemm_phase(lds, g, S, E);
        } else {
            const int q = ph - 2, c = q / PH_PER_CHUNK, r = q - c * PH_PER_CHUNK;
            const bool is_prompt = c < 2;
            float* X = args.out + (size_t)c * TC * D;
            const int L = is_prompt ? 2048 : 8192;
            {
                const int l = r / 9, k = r - l * 9;
                const bf16_t* WL = Wb + (size_t)l * W_LAYER_ELEMS;
                if (k == 0 || k == 7) {
                    pg8::Gemm g{xb, WL + (k == 0 ? OFF_W1IN : OFF_W2IN), TC, 2 * DFF, D, D, D, 0, 0}; pg8::Order S; S.init(TC, 2 * DFF, 1, G, bx); pg8::EpiSwiglu E{hb, DFF}; for (int rep = 0; rep < REP_UP; ++rep) pg8::gemm_phase(lds, g, S, E);
                    if (l == 0 && k == 0) {
                        const float* xin = is_prompt ? args.in[0] + (size_t)c * TC * D : args.in[1] + (size_t)(c - 2) * TC * D;
                        for (int m0 = gw; m0 < TC; m0 += 4 * NGW) {
                            f32x4 v[4][4];
#pragma unroll
                            for (int r = 0; r < 4; ++r) { const int mm = m0 + r * NGW; const size_t m = (size_t)(mm < TC ? mm : m0);
#pragma unroll
                                for (int j = 0; j < 4; ++j) v[r][j] = *((const f32x4*)(xin + m * D) + lane + 64 * j); }
#pragma unroll
                            for (int r = 0; r < 4; ++r) { const int mm = m0 + r * NGW; if (mm >= TC) continue;
#pragma unroll
                                for (int j = 0; j < 4; ++j) { u32x2 hw; hw.x = cvt_pk_h(v[r][j][0], v[r][j][1]); hw.y = cvt_pk_h(v[r][j][2], v[r][j][3]); *((u32x2*)((bf16_t*)(ws + WS_X16) + (size_t)mm * D) + lane + 64 * j) = hw; } }
                        }
                    }
                } else if (k == 1 || k == 8 || k == 6) {
                    const bool ffn = (k != 6); const int sidx = (k == 1) ? 0 : (k == 6 ? 1 : 2);
                    const bool last = (l == NLAYER - 1 && k == 8);
                    pg8::Gemm g{ffn ? hb : mixb, WL + (k == 1 ? OFF_W1OUT : (k == 8 ? OFF_W2OUT : OFF_WOUT)), TC, D, ffn ? DFF : D, ffn ? DFF : D, ffn ? DFF : D, 0, 0};
                    pg8::Order S; S.init(TC, D, 1, G, bx);
                    const int nuse = (c * NLAYER + l) * 3 + sidx;
                    pg8::EpiResidLN E{last ? X : nullptr, (bf16_t*)(ws + WS_X16), xb, args.in[sidx == 0 ? 6 : (sidx == 1 ? 13 : 17)] + l * D, args.in[sidx == 0 ? 7 : (sidx == 1 ? 14 : 18)] + l * D, ffn ? 0.5f : 1.0f,
                                      (unsigned long long*)(ws + WS_CTL + CTL_XBUF), (unsigned*)(ws + WS_CTL + 16384), 32u * (unsigned)(nuse + 1)};
                    pg8::gemm_phase(lds, g, S, E);
                    if (last && c + 1 < NCHUNK) load_chunk = c + 1;
                } else if (k == 2) {
                    pg8::Gemm g{xb, WL + OFF_WIN, TC, INC, D, D, D, 0, 0}; pg8::Order S; S.init(TC, INC, 1, G, bx); pg8::EpiInproj E{proj, gates}; for (int rep = 0; rep < REP_INPROJ; ++rep) pg8::gemm_phase(lds, g, S, E);
                } else if (k == 3) {
                    LAS unsigned char* vl = lds + wave * 9216;
                    const float* sink = args.in[10] + l * 8;
                    const int memrow0 = is_prompt ? c * 8 * NMEM : 4096 + (c - 2) * 2 * NMEM;
                    for (int rep = 0; rep < REP_ATT; ++rep) {
                    for (int u = vcu; u < 256; u += G) {
                        const int nqb = L / 256; const int qb = u % nqb, hh = (u / nqb) & 3, sq = u / (nqb * 4);
                        const bf16_t* mb = memkv + (size_t)(memrow0 + sq * NMEM) * 2048 + l * 1024 + hh * 128;
                        __syncthreads();
#pragma unroll 2
                        for (int j = 0; j < 8; ++j) { const int idx = j * 512 + (int)threadIdx.x, rrow = idx >> 4, pc = idx & 15;
                            const u32x4 kv = *(const u32x4*)(mb + (size_t)rrow * 2048 + pc * 8), vv = *(const u32x4*)(mb + 512 + (size_t)rrow * 2048 + pc * 8);
                            *(LAS u32x4*)(lds + rrow * 288 + pc * 16) = kv; *(LAS u32x4*)(lds + 73728 + rrow * 288 + pc * 16) = vv; }
                        __syncthreads();
                        AttnP P;
                        const int tok0 = sq * L + qb * 256 + wave * 32;
                        P.q = proj + (size_t)tok0 * PROJC + 2304 + hh * 128; P.q_rs = PROJC; P.q_toff = 16 * PROJC;
                        P.k = mb; P.v = mb + 512; P.kv_rs = 2048;
                        P.o = br + (size_t)tok0 * BRC + 1024 + hh * 128; P.o_rs = BRC; P.o_toff = 16 * BRC; P.lse = nullptr; P.lse_rs = 0; P.lse_toff = 0;
                        P.qpos0 = 0; P.qpos_tstep = 0; P.k_lo = 0; P.nsteps = 8; P.sub_len = NMEM; P.radius = 1 << 20;
                        P.slope2 = 0.f; P.slope_tmul = 1.f;
#pragma unroll
                        for (int i = 0; i < 4; ++i) P.sink2[i] = 0.f;
                        attn_item<128, 2, 3>(P, lds + 73728, lane, lds);
                    }
                    __syncthreads();
                    for (int it = gw; it < 4 * 2048; it += NGW) {
                        const int type = it >> 11, id = it & 2047;
                        AttnP P;
                        if (type == 0) {
                            const int hk = id & 1, tb = id >> 1; const int tok0 = tb * 16; const int sq = tok0 / L, pos0 = tok0 - sq * L;
                            const bf16_t* base = proj + (size_t)(sq * L) * PROJC;
                            P.q = proj + (size_t)tok0 * PROJC + hk * 256; P.q_rs = PROJC; P.q_toff = 64;
                            P.k = base + 512 + hk * 64; P.v = base + 512 + 128 + hk * 64; P.kv_rs = PROJC;
                            P.o = br + (size_t)tok0 * BRC + hk * 256; P.o_rs = BRC; P.o_toff = 64; P.lse = nullptr; P.lse_rs = 0; P.lse_toff = 0;
                            P.qpos0 = pos0; P.qpos_tstep = 0; P.k_lo = pos0 - 128; P.nsteps = 9; P.sub_len = L; P.radius = 128;
                            P.slope2 = LOG2E * exp2f(-(float)(hk * 4 + 1)); P.slope_tmul = 0.5f;
#pragma unroll
                            for (int i = 0; i < 4; ++i) P.sink2[i] = sink[hk * 4 + i] * LOG2E;
                            attn_item<64, 4, 0>(P, vl, lane);
                        } else {
                            const int cfg = type - 1, dil = cfg == 0 ? 1 : (cfg == 1 ? 4 : 16);
                            const int h = id & 7, blk = id >> 3;
                            const int sub_len = L / dil, bps = sub_len / 64;
                            const int sr = blk / bps, jb = blk - sr * bps; const int sq = sr / dil, rs = sr - sq * dil; const int j0 = jb * 64;
                            const bf16_t* base = proj + (size_t)(sq * L + rs) * PROJC + 768 + h * 64;
                            const size_t tok0 = (size_t)sq * L + rs + (size_t)j0 * dil;
                            P.q = proj + tok0 * PROJC + 768 + h * 64; P.q_rs = PROJC * dil; P.q_toff = 16 * PROJC * dil;
                            P.k = base + 512; P.v = base + 1024; P.kv_rs = PROJC * dil;
                            P.o = bpart + (size_t)cfg * TC * 512 + tok0 * 512 + h * 64; P.o_rs = 512 * dil; P.o_toff = 16 * 512 * dil;
                            P.lse = lseb + (size_t)cfg * TC * 8 + tok0 * 8 + h; P.lse_rs = 8 * dil; P.lse_toff = 16 * 8 * dil;
                            P.qpos0 = j0; P.qpos_tstep = 16; P.k_lo = j0 - 64; P.nsteps = 6; P.sub_len = sub_len; P.radius = 64;
                            P.slope2 = LOG2E * exp2f(-(float)(h + 1)) * (float)dil; P.slope_tmul = 1.0f;
#pragma unroll
                            for (int i = 0; i < 4; ++i) P.sink2[i] = 0.f;
                            attn_item<64, 4, 1>(P, vl, lane);
                        }
                    }
                    }
                } else if (k == 4) {
                    for (int rep = 0; rep < REP_CMB; ++rep) for (int m0 = gw; m0 < TC; m0 += 4 * NGW) {
                        const int h = lane >> 3;
                        float l0[4], l1[4], l2[4]; u32x4 a[4], b[4], cc[4];
#pragma unroll
                        for (int r = 0; r < 4; ++r) { const int mm = m0 + r * NGW; const size_t m = (size_t)(mm < TC ? mm : m0);
                            l0[r] = lseb[m * 8 + h]; l1[r] = lseb[(size_t)TC * 8 + m * 8 + h]; l2[r] = lseb[(size_t)2 * TC * 8 + m * 8 + h];
                            a[r] = *((const u32x4*)(bpart + m * 512) + lane); b[r] = *((const u32x4*)(bpart + (size_t)TC * 512 + m * 512) + lane); cc[r] = *((const u32x4*)(bpart + (size_t)2 * TC * 512 + m * 512) + lane); }
#pragma unroll
                        for (int r = 0; r < 4; ++r) { const int mm = m0 + r * NGW; if (mm >= TC) continue;
                            const float mx = fmaxf(l0[r], fmaxf(l1[r], l2[r])); float w0 = fast_exp2(l0[r] - mx), w1 = fast_exp2(l1[r] - mx), w2 = fast_exp2(l2[r] - mx); const float inv = 1.0f / (w0 + w1 + w2); w0 *= inv; w1 *= inv; w2 *= inv;
                            u32x4 w;
                            w.x = cvt_pk_bf16(w0 * bf_lo(a[r].x) + w1 * bf_lo(b[r].x) + w2 * bf_lo(cc[r].x), w0 * bf_hi(a[r].x) + w1 * bf_hi(b[r].x) + w2 * bf_hi(cc[r].x));
                            w.y = cvt_pk_bf16(w0 * bf_lo(a[r].y) + w1 * bf_lo(b[r].y) + w2 * bf_lo(cc[r].y), w0 * bf_hi(a[r].y) + w1 * bf_hi(b[r].y) + w2 * bf_hi(cc[r].y));
                            w.z = cvt_pk_bf16(w0 * bf_lo(a[r].z) + w1 * bf_lo(b[r].z) + w2 * bf_lo(cc[r].z), w0 * bf_hi(a[r].z) + w1 * bf_hi(b[r].z) + w2 * bf_hi(cc[r].z));
                            w.w = cvt_pk_bf16(w0 * bf_lo(a[r].w) + w1 * bf_lo(b[r].w) + w2 * bf_lo(cc[r].w), w0 * bf_hi(a[r].w) + w1 * bf_hi(b[r].w) + w2 * bf_hi(cc[r].w));
                            *((u32x4*)(br + (size_t)mm * BRC + 512) + lane) = w; }
                    }
                } else {
                    pg8::Gemm g{br, WL + OFF_WBR, TC, D, 512, BRC, 512, 512, (size_t)D * 512}; pg8::Order S; S.init(TC, D, 3, G, bx); pg8::EpiBranch E{gates, mixb}; for (int rep = 0; rep < REP_BR; ++rep) pg8::gemm_phase(lds, g, S, E);
                }
            }
        }
        if (load_chunk >= 0) {
            const float* xin = load_chunk < 2 ? args.in[0] + (size_t)load_chunk * TC * D : args.in[1] + (size_t)(load_chunk - 2) * TC * D;
            for (int m0 = gw; m0 < TC; m0 += 4 * NGW) {
                f32x4 v[4][4];
#pragma unroll
                for (int r = 0; r < 4; ++r) { const int mm = m0 + r * NGW; const size_t m = (size_t)(mm < TC ? mm : m0);
#pragma unroll
                    for (int j = 0; j < 4; ++j) v[r][j] = *((const f32x4*)(xin + m * D) + lane + 64 * j); }
#pragma unroll
                for (int r = 0; r < 4; ++r) { const int mm = m0 + r * NGW; if (mm >= TC) continue;
#pragma unroll
                    for (int j = 0; j < 4; ++j) { u32x2 w; w.x = cvt_pk_bf16(v[r][j][0], v[r][j][1]); w.y = cvt_pk_bf16(v[r][j][2], v[r][j][3]); *((u32x2*)(xb + (size_t)mm * D) + lane + 64 * j) = w; } }
            }
        }
        for (int rep = 0; rep < REP_SYNC; ++rep) xcd_barrier(bar);
    }
}

extern "C" void kernel_launch(void* const* d_in, const int* in_sizes, int n_in, void* d_out, int out_size, void* d_ws, size_t ws_size, hipStream_t stream) {
    static int grid = 0;
    if (grid == 0) {
        if (n_in != 19 || ws_size < WS_END) { fprintf(stderr, "kernel_launch: need 19 inputs and %zu bytes of workspace; got %d, %zu\n", (size_t)WS_END, n_in, ws_size); grid = -1; return; }
        int dev = 0, cus = 0, per_cu = 0;
        hipGetDevice(&dev); hipDeviceGetAttribute(&cus, hipDeviceAttributeMultiprocessorCount, dev);
        if (hipFuncSetAttribute((const void*)mega_fwd, hipFuncAttributeMaxDynamicSharedMemorySize, LDS_BYTES) != hipSuccess) { fprintf(stderr, "kernel_launch: hipFuncSetAttribute failed\n"); grid = -1; return; }
        if (hipOccupancyMaxActiveBlocksPerMultiprocessor(&per_cu, (const void*)mega_fwd, 512, LDS_BYTES) != hipSuccess || per_cu < 1) { fprintf(stderr, "kernel_launch: occupancy query says %d\n", per_cu); per_cu = 1; }
        (void)hipGetLastError();
        grid = cus;
        if (grid != 256) { fprintf(stderr, "kernel_launch: built for a 256-CU device (fused LayerNorm epilogue needs one 256x256 unit per workgroup); got %d CUs\n", cus); grid = -1; return; }
    }
    if (grid < 0) return;
    if (hipMemsetAsync((char*)d_ws + WS_CTL, 0, CTL_BYTES, stream) != hipSuccess) { fprintf(stderr, "kernel_launch: memset failed\n"); return; }
    Args a{};
    for (int i = 0; i < 19; ++i) a.in[i] = (const float*)d_in[i];
    a.out = (float*)d_out; a.ws = (unsigned char*)d_ws;
    void* kargs[] = {&a};
    hipError_t e = hipLaunchCooperativeKernel((const void*)mega_fwd, dim3(grid), dim3(512), kargs, LDS_BYTES, stream);
    if (e != hipSuccess) fprintf(stderr, "cooperative launch failed: %s (grid %d)\n", hipGetErrorString(e), grid);
}
```

```cpp
#include <hip/hip_runtime.h>
#include <hip/hip_cooperative_groups.h>
#include <cstdio>
#include <cstdint>
namespace cg = cooperative_groups;

#define LAS __attribute__((address_space(3)))
typedef unsigned short bf16_t;
typedef short bf16x8 __attribute__((ext_vector_type(8)));
typedef short s16x4 __attribute__((ext_vector_type(4)));
typedef float f32x4 __attribute__((ext_vector_type(4)));
typedef float f32x2 __attribute__((ext_vector_type(2)));
typedef unsigned u32x4 __attribute__((ext_vector_type(4)));
typedef unsigned u32x2 __attribute__((ext_vector_type(2)));

constexpr int D = 1024, DFF = 2816, NLAYER = 2;
constexpr int TC = 16384;
constexpr int NCHUNK = 4;
constexpr int INC = 5888, PROJC = 2816, GATEC = 3072, BRC = 1536;
constexpr int NMEM = 256, MEMROWS = 5120;
constexpr float LN_EPS = 1e-5f;
constexpr float ALPHA = 1.41421356237309515f;
constexpr float LOG2E = 1.44269504088896341f;

constexpr size_t MiB = 1u << 20;
constexpr size_t W_LAYER_ELEMS = (size_t)5632 * 1024 + (size_t)1024 * 2816 + (size_t)5888 * 1024 + (size_t)3 * 1024 * 512 + (size_t)1024 * 1024 + (size_t)5632 * 1024 + (size_t)1024 * 2816;
constexpr size_t OFF_W1IN = 0, OFF_W1OUT = OFF_W1IN + (size_t)5632 * 1024, OFF_WIN = OFF_W1OUT + (size_t)1024 * 2816, OFF_WBR = OFF_WIN + (size_t)5888 * 1024,
                 OFF_WOUT = OFF_WBR + (size_t)3 * 1024 * 512, OFF_W2IN = OFF_WOUT + (size_t)1024 * 1024, OFF_W2OUT = OFF_W2IN + (size_t)5632 * 1024;
constexpr size_t WS_W = 0;
constexpr size_t WS_WMEM = 100 * MiB;
constexpr size_t WS_MEMB = 108 * MiB;
constexpr size_t WS_MEMKV = 118 * MiB;
constexpr size_t WS_XB = 158 * MiB;
constexpr size_t WS_U = 190 * MiB;
constexpr size_t U_H = 0;
constexpr size_t U_PROJ = 0;
constexpr size_t U_GATES = 88 * MiB;
constexpr size_t U_BR = 184 * MiB;
constexpr size_t U_BPART = 232 * MiB;
constexpr size_t U_LSE = 280 * MiB;
constexpr size_t U_MIXF = 0;
constexpr size_t U_MIXB = 232 * MiB;
constexpr size_t WS_X16 = WS_U + 282 * MiB;
constexpr size_t WS_CTL = WS_X16 + 32 * MiB;
constexpr size_t CTL_BYTES = 32768;
constexpr size_t CTL_XBUF = 65536;
constexpr size_t WS_END = WS_CTL + 1 * MiB;
static_assert(W_LAYER_ELEMS * 2 * 2 <= 100 * MiB, "weights fit");

constexpr int REP_ATT = 1, REP_UP = 1, REP_INPROJ = 1, REP_BR = 1, REP_PRO = 1, REP_SYNC = 1, REP_CMB = 1;
constexpr int LDS_BYTES = 147456 + 256;
constexpr int LDS_MISC = 147456;

__device__ __forceinline__ unsigned cvt_pk_bf16(float lo, float hi) { unsigned r; asm("v_cvt_pk_bf16_f32 %0, %1, %2" : "=v"(r) : "v"(lo), "v"(hi)); return r; }
__device__ __forceinline__ float bf_lo(unsigned u) { return __uint_as_float(u << 16); }
__device__ __forceinline__ float bf_hi(unsigned u) { return __uint_as_float(u & 0xffff0000u); }
typedef _Float16 f16x2 __attribute__((ext_vector_type(2)));
__device__ __forceinline__ unsigned cvt_pk_h(float lo, float hi) { const f16x2 v = {(_Float16)lo, (_Float16)hi}; return __builtin_bit_cast(unsigned, v); }
__device__ __forceinline__ float h_lo(unsigned u) { return (float)__builtin_bit_cast(f16x2, u)[0]; }
__device__ __forceinline__ float h_hi(unsigned u) { return (float)__builtin_bit_cast(f16x2, u)[1]; }
__device__ __forceinline__ float fast_exp2(float x) { return __builtin_amdgcn_exp2f(x); }
__device__ __forceinline__ float fast_rcp(float x) { return __builtin_amdgcn_rcpf(x); }
__device__ __forceinline__ float sigmoidf_fast(float v) { return fast_rcp(1.0f + fast_exp2(-LOG2E * v)); }
__device__ __forceinline__ float rowgrp_max(float m) {
    const auto r = __builtin_amdgcn_permlane16_swap(__float_as_uint(m), __float_as_uint(m), false, false);
    const float a = fmaxf(__uint_as_float(r[0]), __uint_as_float(r[1]));
    const auto r2 = __builtin_amdgcn_permlane32_swap(__float_as_uint(a), __float_as_uint(a), false, false);
    return fmaxf(__uint_as_float(r2[0]), __uint_as_float(r2[1]));
}
__device__ __forceinline__ float rowgrp_sum(float m) {
    const auto r = __builtin_amdgcn_permlane16_swap(__float_as_uint(m), __float_as_uint(m), false, false);
    const float a = __uint_as_float(r[0]) + __uint_as_float(r[1]);
    const auto r2 = __builtin_amdgcn_permlane32_swap(__float_as_uint(a), __float_as_uint(a), false, false);
    return __uint_as_float(r2[0]) + __uint_as_float(r2[1]);
}
__device__ __forceinline__ float wave_sum(float v) {
#pragma unroll
    for (int o = 1; o < 64; o <<= 1) v += __shfl_xor(v, o);
    return v;
}

#define XB_TMO      128
#define XB_XCNT(j)  (256  + 64 * (j))
#define XB_XSUB(j)  (1280 + 64 * (j))
#define XB_XGEN(j)  (2304 + 64 * (j))
#define XB_TOP      3328
#define XB_TOPGEN   3392
#define XCD_BAR_WORDS 3456
#define XB_SPIN_CAP (1u << 18)

__device__ __forceinline__ unsigned xb_ld(unsigned* p)              { return __hip_atomic_load(p, __ATOMIC_RELAXED, __HIP_MEMORY_SCOPE_AGENT); }
__device__ __forceinline__ unsigned xb_add(unsigned* p, unsigned v) { return __hip_atomic_fetch_add(p, v, __ATOMIC_RELAXED, __HIP_MEMORY_SCOPE_AGENT); }
__device__ __forceinline__ unsigned xb_xcc_id() { return (unsigned)__builtin_amdgcn_s_getreg((3 << 11) | 20) & 0xFu; }
#define XB_SPIN(cond, bar) do { unsigned _sp = 0; while (cond) { __builtin_amdgcn_s_sleep(1); \
    if ((++_sp & 255u) == 0u) { if (xb_ld(&(bar)[XB_TMO])) break; if (_sp > XB_SPIN_CAP) { atomicAdd(&(bar)[XB_TMO], 1u); break; } } } } while (0)

struct XcdBarrier {
    unsigned* bar; unsigned x;
    volatile LAS unsigned* st;
};

__device__ __forceinline__ XcdBarrier xcd_barrier_post(unsigned* bar, volatile LAS unsigned* st) {
    XcdBarrier b; b.bar = bar; b.x = xb_xcc_id(); b.st = st;
    if (threadIdx.x == 0) (void)xb_add(&bar[XB_XCNT(b.x)], 1u);
    return b;
}
__device__ __forceinline__ void xcd_barrier_complete(unsigned* bar, unsigned x, unsigned& nloc, unsigned& nx) {
    const unsigned G = gridDim.x * gridDim.y * gridDim.z;
    unsigned sum, cnt, mine, sp = 0u;
    for (;;) {
        sum = 0u; cnt = 0u; mine = 0u;
#pragma unroll
        for (unsigned j = 0; j < 16; ++j) { const unsigned c = xb_ld(&bar[XB_XCNT(j)]); sum += c; cnt += (c > 0u) ? 1u : 0u; mine = (j == x) ? c : mine; }
        if (sum == G) break;
        __builtin_amdgcn_s_sleep(1);
        if ((++sp & 255u) == 0u) { if (xb_ld(&bar[XB_TMO])) break; if (sp > XB_SPIN_CAP) { atomicAdd(&bar[XB_TMO], 1u); break; } }
    }
    nloc = mine > 0u ? mine : 1u; nx = cnt > 0u ? cnt : 1u;
}

__device__ __forceinline__ void xcd_barrier(const XcdBarrier& b) {
    asm volatile("s_waitcnt vmcnt(0)" ::: "memory");
    __syncthreads();
    if (threadIdx.x == 0) {
        unsigned* bar = b.bar;
        __builtin_amdgcn_s_waitcnt(0);
        unsigned nloc = b.st[0], nx = b.st[1];
        if (nloc == 0u) { xcd_barrier_complete(bar, b.x, nloc, nx); b.st[0] = nloc; b.st[1] = nx; }
        const unsigned old = xb_add(&bar[XB_XSUB(b.x)], 1u);
        const unsigned gen = old / nloc;
        if (old + 1u == (gen + 1u) * nloc) {
            __builtin_amdgcn_fence(__ATOMIC_RELEASE, "agent");
            asm volatile("s_waitcnt vmcnt(0)" ::: "memory");
            const unsigned og = xb_add(&bar[XB_TOP], 1u);
            const unsigned tg = og / nx;
            if (og + 1u == (tg + 1u) * nx) xb_add(&bar[XB_TOPGEN], 1u);
            else XB_SPIN(xb_ld(&bar[XB_TOPGEN]) == tg, bar);
            __builtin_amdgcn_fence(__ATOMIC_ACQUIRE, "agent");
            xb_add(&bar[XB_XGEN(b.x)], 1u);
            asm volatile("s_waitcnt vmcnt(0)" ::: "memory");
        } else {
            XB_SPIN(xb_ld(&bar[XB_XGEN(b.x)]) == gen, bar);
            __builtin_amdgcn_fence(__ATOMIC_ACQUIRE, "agent");
            asm volatile("s_waitcnt vmcnt(0)" ::: "memory");
        }
    }
    __syncthreads();
}


namespace pg8 {
constexpr int BM = 256, BK = 64, HALF = 128, HTB = HALF * BK * 2, STAGE_BYTES = 8 * HTB, NXCD = 8, WGM = 4;
__host__ __device__ __forceinline__ int lds_byte(int r, int c) { const int st = (r >> 4) * 2 + (c >> 5), rr = r & 15, cc = c & 31, ob = rr * 64 + cc * 2; return st * 1024 + (ob ^ (((ob >> 9) & 1) << 5)); }
__host__ __device__ __forceinline__ void stage_rc(int b, int& R, int& C) { const int st = b / 1024, sb = b % 1024, swz = sb ^ (((sb >> 9) & 1) << 5); R = (st >> 1) * 16 + swz / 64; C = (st & 1) * 32 + (swz % 64) / 2; }
__host__ __device__ __forceinline__ int perm32(int rho) { const int n = rho >> 4, i = rho & 15; return 8 * (i >> 2) + 4 * n + (i & 3); }

struct Unit { int pm, pn, z; };
struct Gemm { const bf16_t* A; const bf16_t* Bt; int M, N, K, lda, ldb; size_t za, zb; };

struct Order {
    int nM, nN, nZ, nwg, G, c;
    __device__ void init(int M, int N, int nZ_, int G_, int c_) { nM = M / BM; nN = N / BM; nZ = nZ_; nwg = nM * nN; G = G_; c = c_; }
    __device__ bool next(int i, Unit& u) const {
        const int ti = i / nZ; u.z = i - ti * nZ;
        const long L = (long)ti * G + c; if (L >= nwg) return false;
        int wgid = (int)L; { const int q = nwg / NXCD, r = nwg % NXCD, xcd = wgid % NXCD, off = wgid / NXCD; wgid = (xcd < r ? xcd * (q + 1) : r * (q + 1) + (xcd - r) * q) + off; }
        const int nig = WGM * nN, gid = wgid / nig, fm = gid * WGM, gsz = (nM - fm) < WGM ? (nM - fm) : WGM;
        u.pm = fm + ((wgid % nig) % gsz); u.pn = (wgid % nig) / gsz; return true;
    }
};

template <class Epi>
__device__ __forceinline__ void gemm_phase(LAS unsigned char* lds, const Gemm g, const Order& S, const Epi& E) {
    int tid = threadIdx.x; asm volatile("" : "+v"(tid));
    const int wid = __builtin_amdgcn_readfirstlane(tid >> 6), lane = tid & 63, wr = wid >> 2, wc = wid & 3, fr = lane & 15, fq = lane >> 4;
    const int K = g.K, nt = K / BK;
    unsigned voffA[2], voffB[2];
#pragma unroll
    for (int i = 0; i < 2; ++i) { int R, C; stage_rc(tid * 16 + i * 8192, R, C); const int Rb = Epi::PERM ? ((R & ~31) + perm32(R & 31)) : R;
        voffA[i] = (unsigned)(R * g.lda + C) * 2u; voffB[i] = (unsigned)(Rb * g.ldb + C) * 2u; }
    const size_t kstep = (size_t)(BK * 2);
    const size_t hstepA = (size_t)HALF * g.lda * 2, hstepB = (size_t)HALF * g.ldb * 2;
    const unsigned ldsw = (unsigned)wid * 1024u;
    const int aoff = lds_byte(wr * 64 + fr, fq * 8), boff = lds_byte(wc * 32 + fr, fq * 8);
#define PG8_SA(b, h) (((b) * 2 + (h)) * HTB)
#define PG8_SB(b, h) ((4 + (b) * 2 + (h)) * HTB)
#define PG8_STAGE(bufoff, gbase, voff) do { _Pragma("unroll") for (int _i = 0; _i < 2; ++_i) \
        __builtin_amdgcn_global_load_lds((const unsigned*)((const char*)(gbase) + (voff)[_i]), (LAS unsigned*)(lds + (bufoff) + ldsw + _i * 8192), 16, 0, 0); } while (0)
#define PG8_LDA(dst, b, h) do { _Pragma("unroll") for (int m = 0; m < 4; ++m) _Pragma("unroll") for (int k = 0; k < 2; ++k) dst[m][k] = *(const LAS bf16x8*)(lds + PG8_SA(b, h) + aoff + m * 2048 + k * 1024); } while (0)
#define PG8_LDB(dst, b, h) do { _Pragma("unroll") for (int n = 0; n < 2; ++n) _Pragma("unroll") for (int k = 0; k < 2; ++k) dst[n][k] = *(const LAS bf16x8*)(lds + PG8_SB(b, h) + boff + n * 2048 + k * 1024); } while (0)
#define PG8_MMA(ai, bj, At, Bt) do { __builtin_amdgcn_s_setprio(1); _Pragma("unroll") for (int m = 0; m < 4; ++m) _Pragma("unroll") for (int n = 0; n < 2; ++n) _Pragma("unroll") for (int k = 0; k < 2; ++k) \
        acc[ai][bj][m][n] = __builtin_amdgcn_mfma_f32_16x16x32_bf16(Bt[n][k], At[m][k], acc[ai][bj][m][n], 0, 0, 0); __builtin_amdgcn_s_setprio(0); } while (0)
#define PG8_WAIT_V(n) asm volatile("s_waitcnt vmcnt(" #n ")" ::: "memory")
#define PG8_WAIT_L(n) asm volatile("s_waitcnt lgkmcnt(" #n ")" ::: "memory")
#define PG8_BAR __builtin_amdgcn_s_barrier()
#define PG8_SCHED __builtin_amdgcn_sched_barrier(0)
    Unit cur, nxt; int ui = 0;
    if (!S.next(0, cur)) return;
    f32x4 acc[2][2][4][2];
#pragma unroll
    for (int a = 0; a < 2; ++a)
#pragma unroll
        for (int b = 0; b < 2; ++b)
#pragma unroll
            for (int m = 0; m < 4; ++m)
#pragma unroll
                for (int n = 0; n < 2; ++n) acc[a][b][m][n] = (f32x4){0.f, 0.f, 0.f, 0.f};
    bf16x8 At[4][2], B0[2][2], B1[2][2];
    const char* cA = (const char*)(g.A + (size_t)cur.pm * BM * g.lda + (size_t)cur.z * g.za);
    const char* cB = (const char*)(g.Bt + (size_t)cur.pn * BM * g.ldb + (size_t)cur.z * g.zb);
    PG8_STAGE(PG8_SB(0, 0), cB, voffB); PG8_STAGE(PG8_SA(0, 0), cA, voffA); PG8_STAGE(PG8_SB(0, 1), cB + hstepB, voffB); PG8_STAGE(PG8_SA(0, 1), cA + hstepA, voffA);
    if (wr == 1) PG8_BAR;
    PG8_WAIT_V(4); PG8_BAR;
    PG8_STAGE(PG8_SB(1, 0), cB + kstep, voffB); PG8_STAGE(PG8_SA(1, 0), cA + kstep, voffA); PG8_STAGE(PG8_SB(1, 1), cB + hstepB + kstep, voffB);
    PG8_WAIT_V(6); PG8_BAR;
    for (;;) {
        const bool has_next = S.next(ui + 1, nxt);
        const char* nA = has_next ? (const char*)(g.A + (size_t)nxt.pm * BM * g.lda + (size_t)nxt.z * g.za) : cA;
        const char* nB = has_next ? (const char*)(g.Bt + (size_t)nxt.pn * BM * g.ldb + (size_t)nxt.z * g.zb) : cB;
        for (int t = 0; t < nt; t += 2) {
            const bool last = (t == nt - 2);
            const char* a1 = cA + (size_t)(t + 1) * kstep;
            const char* a2 = last ? nA : cA + (size_t)(t + 2) * kstep; const char* b2 = last ? nB : cB + (size_t)(t + 2) * kstep;
            const char* a3 = a2 + kstep; const char* b3 = b2 + kstep;
            PG8_LDB(B0, 0, 0); PG8_SCHED; PG8_LDA(At, 0, 0); PG8_STAGE(PG8_SA(1, 1), a1 + hstepA, voffA);
            PG8_WAIT_L(8); PG8_BAR; PG8_WAIT_L(0); PG8_MMA(0, 0, At, B0); PG8_BAR; PG8_SCHED;
            PG8_LDB(B1, 0, 1); PG8_STAGE(PG8_SB(0, 0), b2, voffB);
            PG8_BAR; PG8_WAIT_L(0); PG8_MMA(0, 1, At, B1); PG8_BAR;
            PG8_LDA(At, 0, 1); PG8_STAGE(PG8_SA(0, 0), a2, voffA);
            PG8_BAR; PG8_WAIT_L(0); PG8_MMA(1, 0, At, B0); PG8_BAR; PG8_SCHED;
            PG8_STAGE(PG8_SB(0, 1), b2 + hstepB, voffB);
            PG8_WAIT_V(6); PG8_BAR; PG8_MMA(1, 1, At, B1); PG8_BAR;
            PG8_LDB(B0, 1, 0); PG8_SCHED; PG8_LDA(At, 1, 0); PG8_STAGE(PG8_SA(0, 1), a2 + hstepA, voffA);
            PG8_WAIT_L(8); PG8_BAR; PG8_WAIT_L(0); PG8_MMA(0, 0, At, B0); PG8_BAR; PG8_SCHED;
            PG8_LDB(B1, 1, 1); PG8_STAGE(PG8_SB(1, 0), b3, voffB);
            PG8_BAR; PG8_WAIT_L(0); PG8_MMA(0, 1, At, B1); PG8_BAR;
            PG8_LDA(At, 1, 1); PG8_STAGE(PG8_SA(1, 0), a3, voffA);
            PG8_BAR; PG8_WAIT_L(0); PG8_MMA(1, 0, At, B0); PG8_BAR; PG8_SCHED;
            PG8_STAGE(PG8_SB(1, 1), b3 + hstepB, voffB);
            PG8_WAIT_V(6); PG8_BAR; PG8_MMA(1, 1, At, B1); PG8_BAR;
        }
        if constexpr (!Epi::AFTER_DRAIN) E(acc, cur, wr, wc, fr, fq);
        if (!has_next) break;
        if (!(Epi::KEEP_ACC && nxt.z != 0)) {
#pragma unroll
        for (int a = 0; a < 2; ++a)
#pragma unroll
            for (int b = 0; b < 2; ++b)
#pragma unroll
                for (int m = 0; m < 4; ++m)
#pragma unroll
                    for (int n = 0; n < 2; ++n) acc[a][b][m][n] = (f32x4){0.f, 0.f, 0.f, 0.f};
        }
        cur = nxt; cA = nA; cB = nB; ++ui;
    }
    PG8_WAIT_V(0);
    if (wr == 0) PG8_BAR;
    PG8_BAR;
    if constexpr (Epi::AFTER_DRAIN) E.fused(acc, cur, wr, wc, fr, fq, lds, wid, lane);
#undef PG8_SA
#undef PG8_SB
#undef PG8_STAGE
#undef PG8_LDA
#undef PG8_LDB
#undef PG8_MMA
#undef PG8_WAIT_V
#undef PG8_WAIT_L
#undef PG8_BAR
#undef PG8_SCHED
}

struct EpiSwiglu {
    static constexpr bool PERM = true, AFTER_DRAIN = false, KEEP_ACC = false;
    bf16_t* O; int ldc;
    __device__ __forceinline__ void operator()(const f32x4 (&acc)[2][2][4][2], const Unit& u, int wr, int wc, int fr, int fq) const {
        const int row0 = u.pm * BM + wr * 64 + fr, col0 = u.pn * HALF + wc * 32 + 8 * fq;
#pragma unroll
        for (int ai = 0; ai < 2; ++ai)
#pragma unroll
            for (int m = 0; m < 4; ++m) {
                bf16_t* rowp = O + (size_t)(row0 + ai * HALF + m * 16) * ldc + col0;
                float r[8];
#pragma unroll
                for (int n = 0; n < 2; ++n)
#pragma unroll
                    for (int j = 0; j < 4; ++j) { const float gv = acc[ai][0][m][n][j], uv = acc[ai][1][m][n][j]; r[n * 4 + j] = gv * uv * fast_rcp(1.0f + fast_exp2(-gv)); }
                u32x4 w; w.x = cvt_pk_bf16(r[0], r[1]); w.y = cvt_pk_bf16(r[2], r[3]); w.z = cvt_pk_bf16(r[4], r[5]); w.w = cvt_pk_bf16(r[6], r[7]);
                *(u32x4*)rowp = w;
            }
    }
};
struct EpiResidLN {
    static constexpr bool PERM = true, AFTER_DRAIN = true, KEEP_ACC = false;
    float* xout; bf16_t* X16; bf16_t* XB; const float* gam; const float* bet; float beta;
    unsigned long long* xbuf; unsigned* cnt; unsigned want;
    __device__ __forceinline__ void fused(f32x4 (&acc)[2][2][4][2], const Unit& u, int wr, int wc, int fr, int fq, LAS unsigned char* lds, int wid, int lane) const {
        LAS f32x2* P = (LAS f32x2*)lds;
        LAS f32x2* S = (LAS f32x2*)(lds + 8192);
        const int row0 = u.pm * BM + wr * 64 + fr, col0 = u.pn * BM + wc * 32 + 8 * fq;
        {
            u32x4 hw[2][2];
#pragma unroll
            for (int bj = 0; bj < 2; ++bj) hw[0][bj] = *(const u32x4*)(X16 + (size_t)row0 * D + col0 + bj * HALF);
#pragma unroll
            for (int gi = 0; gi < 8; ++gi) {
                const int ai = gi >> 2, m = gi & 3;
                if (gi + 1 < 8) { const int ai1 = (gi + 1) >> 2, m1 = (gi + 1) & 3;
#pragma unroll
                    for (int bj = 0; bj < 2; ++bj) hw[(gi + 1) & 1][bj] = *(const u32x4*)(X16 + (size_t)(row0 + ai1 * HALF + m1 * 16) * D + col0 + bj * HALF); }
                asm volatile("" ::: "memory");
#pragma unroll
                for (int bj = 0; bj < 2; ++bj) { const u32x4 h = hw[gi & 1][bj];
                    const f32x4 x0 = (f32x4){h_lo(h.x), h_hi(h.x), h_lo(h.y), h_hi(h.y)}, x1 = (f32x4){h_lo(h.z), h_hi(h.z), h_lo(h.w), h_hi(h.w)};
                    acc[ai][bj][m][0] = x0 * ALPHA + acc[ai][bj][m][0] * beta; acc[ai][bj][m][1] = x1 * ALPHA + acc[ai][bj][m][1] * beta; }
                asm volatile("" : "+v"(acc[ai][0][m][0]), "+v"(acc[ai][0][m][1]), "+v"(acc[ai][1][m][0]), "+v"(acc[ai][1][m][1]));
            }
        }
#pragma unroll
        for (int ai = 0; ai < 2; ++ai)
#pragma unroll
            for (int m = 0; m < 4; ++m) {
                float s = 0.f;
#pragma unroll
                for (int bj = 0; bj < 2; ++bj)
#pragma unroll
                    for (int n = 0; n < 2; ++n) { const f32x4 x = acc[ai][bj][m][n]; s += (x[0] + x[1]) + (x[2] + x[3]); }
                s = rowgrp_sum(s);
                const float mw = s * (1.0f / 64.0f); float q = 0.f;
#pragma unroll
                for (int bj = 0; bj < 2; ++bj)
#pragma unroll
                    for (int n = 0; n < 2; ++n) { const f32x4 d = acc[ai][bj][m][n] - mw; q += (d[0] * d[0] + d[1] * d[1]) + (d[2] * d[2] + d[3] * d[3]); }
                q = rowgrp_sum(q);
                if (fq == 0) P[(ai * HALF + wr * 64 + m * 16 + fr) * 4 + wc] = (f32x2){mw, q};
            }
        asm volatile("s_waitcnt lgkmcnt(0)" ::: "memory"); __builtin_amdgcn_s_barrier(); asm volatile("" ::: "memory");
        const int row = wid * 32 + (lane & 31);
        if (lane < 32) {
            const f32x2 a = P[row * 4 + 0], b = P[row * 4 + 1], c = P[row * 4 + 2], d = P[row * 4 + 3];
            const float mt = (a.x + b.x + c.x + d.x) * 0.25f;
            const float da = a.x - mt, db = b.x - mt, dc = c.x - mt, dd = d.x - mt;
            const float m2 = (a.y + b.y) + (c.y + d.y) + 64.0f * ((da * da + db * db) + (dc * dc + dd * dd));
            unsigned long long* slot = xbuf + ((size_t)((u.pm & 63) * BM + row) * 4 + u.pn);
            __hip_atomic_store(slot, ((unsigned long long)__float_as_uint(m2) << 32) | __float_as_uint(mt), __ATOMIC_RELAXED, __HIP_MEMORY_SCOPE_AGENT);
        }
        asm volatile("s_waitcnt vmcnt(0)" ::: "memory");
        if (lane == 0) __hip_atomic_fetch_add(cnt + 64 * (u.pm & 63), 1u, __ATOMIC_RELAXED, __HIP_MEMORY_SCOPE_AGENT);
        if (wid == 0) {
            unsigned spins = 0;
            while ((unsigned)__builtin_amdgcn_readfirstlane(__hip_atomic_load(cnt + 64 * (u.pm & 63), __ATOMIC_RELAXED, __HIP_MEMORY_SCOPE_AGENT)) < want) { __builtin_amdgcn_s_sleep(2); if (++spins > (1u << 22)) break; }
            __builtin_amdgcn_fence(__ATOMIC_ACQUIRE, "agent");
        }
        asm volatile("s_waitcnt vmcnt(0) lgkmcnt(0)" ::: "memory"); __builtin_amdgcn_s_barrier(); asm volatile("" ::: "memory");
        if (lane < 32) {
            const unsigned long long* slot = xbuf + (size_t)((u.pm & 63) * BM + row) * 4; float mt[4], m2[4]; float ms = 0.f;
#pragma unroll
            for (int t = 0; t < 4; ++t) { const unsigned long long w = __hip_atomic_load(slot + t, __ATOMIC_RELAXED, __HIP_MEMORY_SCOPE_AGENT); mt[t] = __uint_as_float((unsigned)w); m2[t] = __uint_as_float((unsigned)(w >> 32)); ms += mt[t]; }
            const float mean = ms * 0.25f; float q = 0.f;
#pragma unroll
            for (int t = 0; t < 4; ++t) { const float dm = mt[t] - mean; q += m2[t] + 256.0f * dm * dm; }
            S[row] = (f32x2){mean, 1.0f / sqrtf(q * (1.0f / 1024.0f) + LN_EPS)};
        }
        asm volatile("s_waitcnt lgkmcnt(0)" ::: "memory"); __builtin_amdgcn_s_barrier(); asm volatile("" ::: "memory");
        f32x4 gv[2][2], bv[2][2];
#pragma unroll
        for (int bj = 0; bj < 2; ++bj)
#pragma unroll
            for (int n = 0; n < 2; ++n) { gv[bj][n] = *(const f32x4*)(gam + col0 + bj * HALF + 4 * n); bv[bj][n] = *(const f32x4*)(bet + col0 + bj * HALF + 4 * n); }
#pragma unroll
        for (int ai = 0; ai < 2; ++ai)
#pragma unroll
            for (int m = 0; m < 4; ++m) { const int r = ai * HALF + wr * 64 + m * 16 + fr; const f32x2 sr = S[r]; const size_t off = (size_t)(u.pm * BM + r) * D + col0;
#pragma unroll
                for (int bj = 0; bj < 2; ++bj) {
                    const f32x4 y0 = (acc[ai][bj][m][0] - sr.x) * sr.y * gv[bj][0] + bv[bj][0], y1 = (acc[ai][bj][m][1] - sr.x) * sr.y * gv[bj][1] + bv[bj][1];
                    if (xout) { *(f32x4*)(xout + off + bj * HALF) = y0; *(f32x4*)(xout + off + bj * HALF + 4) = y1; }
                    else { u32x4 hw; hw.x = cvt_pk_h(y0[0], y0[1]); hw.y = cvt_pk_h(y0[2], y0[3]); hw.z = cvt_pk_h(y1[0], y1[1]); hw.w = cvt_pk_h(y1[2], y1[3]); *(u32x4*)(X16 + off + bj * HALF) = hw;
                        u32x4 w; w.x = cvt_pk_bf16(y0[0], y0[1]); w.y = cvt_pk_bf16(y0[2], y0[3]); w.z = cvt_pk_bf16(y1[0], y1[1]); w.w = cvt_pk_bf16(y1[2], y1[3]); *(u32x4*)(XB + off + bj * HALF) = w; } }
                asm volatile("" ::: "memory"); }
    }
};
struct EpiInproj {
    static constexpr bool PERM = true, AFTER_DRAIN = false, KEEP_ACC = false;
    bf16_t* P; bf16_t* G;
    __device__ __forceinline__ void operator()(const f32x4 (&acc)[2][2][4][2], const Unit& u, int wr, int wc, int fr, int fq) const {
        const bool isg = u.pn >= 11;
        bf16_t* base = isg ? G : P; const int ldc = isg ? GATEC : PROJC; const int colt = isg ? (u.pn - 11) * BM : u.pn * BM;
        const int row0 = u.pm * BM + wr * 64 + fr, col0 = colt + wc * 32 + 8 * fq;
#pragma unroll
        for (int ai = 0; ai < 2; ++ai)
#pragma unroll
            for (int m = 0; m < 4; ++m) { bf16_t* rowp = base + (size_t)(row0 + ai * HALF + m * 16) * ldc + col0;
#pragma unroll
                for (int bj = 0; bj < 2; ++bj) { f32x4 v0 = acc[ai][bj][m][0], v1 = acc[ai][bj][m][1];
                    if (isg) {
#pragma unroll
                        for (int j = 0; j < 4; ++j) { v0[j] = fmaxf(sigmoidf_fast(v0[j]), 1e-30f); v1[j] = fmaxf(sigmoidf_fast(v1[j]), 1e-30f); } }
                    u32x4 w; w.x = cvt_pk_bf16(v0[0], v0[1]); w.y = cvt_pk_bf16(v0[2], v0[3]); w.z = cvt_pk_bf16(v1[0], v1[1]); w.w = cvt_pk_bf16(v1[2], v1[3]);
                    *(u32x4*)(rowp + bj * HALF) = w; } }
    }
};
struct EpiBf16Plain {
    static constexpr bool PERM = true, AFTER_DRAIN = false, KEEP_ACC = false;
    bf16_t* O; int ldc;
    __device__ __forceinline__ void operator()(const f32x4 (&acc)[2][2][4][2], const Unit& u, int wr, int wc, int fr, int fq) const {
        const int row0 = u.pm * BM + wr * 64 + fr, col0 = u.pn * BM + wc * 32 + 8 * fq;
#pragma unroll
        for (int ai = 0; ai < 2; ++ai)
#pragma unroll
            for (int m = 0; m < 4; ++m) { bf16_t* rowp = O + (size_t)(row0 + ai * HALF + m * 16) * ldc + col0;
#pragma unroll
                for (int bj = 0; bj < 2; ++bj) { const f32x4 v0 = acc[ai][bj][m][0], v1 = acc[ai][bj][m][1];
                    u32x4 w; w.x = cvt_pk_bf16(v0[0], v0[1]); w.y = cvt_pk_bf16(v0[2], v0[3]); w.z = cvt_pk_bf16(v1[0], v1[1]); w.w = cvt_pk_bf16(v1[2], v1[3]);
                    *(u32x4*)(rowp + bj * HALF) = w; } }
    }
};
struct EpiBranch {
    static constexpr bool PERM = true, AFTER_DRAIN = false, KEEP_ACC = true;
    const bf16_t* G; bf16_t* O;
    __device__ __forceinline__ void operator()(f32x4 (&acc)[2][2][4][2], const Unit& u, int wr, int wc, int fr, int fq) const {
        const int row0 = u.pm * BM + wr * 64 + fr, col0 = u.pn * BM + wc * 32 + 8 * fq;
        const bool mid = u.z < 2;
        const bf16_t* g0p = G + (size_t)u.z * D + col0; const bf16_t* g1p = G + (size_t)(mid ? u.z + 1 : u.z) * D + col0;
        u32x4 gq[2][2][2];
#pragma unroll
        for (int bj = 0; bj < 2; ++bj) { gq[0][bj][0] = *(const u32x4*)(g0p + (size_t)row0 * GATEC + bj * HALF); gq[0][bj][1] = *(const u32x4*)(g1p + (size_t)row0 * GATEC + bj * HALF); }
#pragma unroll
        for (int gi = 0; gi < 8; ++gi) {
            const int ai = gi >> 2, m = gi & 3; const size_t row = (size_t)(row0 + ai * HALF + m * 16);
            if (gi + 1 < 8) { const size_t row1 = (size_t)(row0 + ((gi + 1) >> 2) * HALF + ((gi + 1) & 3) * 16);
#pragma unroll
                for (int bj = 0; bj < 2; ++bj) { gq[(gi + 1) & 1][bj][0] = *(const u32x4*)(g0p + row1 * GATEC + bj * HALF); gq[(gi + 1) & 1][bj][1] = *(const u32x4*)(g1p + row1 * GATEC + bj * HALF); } }
            asm volatile("" ::: "memory");
#pragma unroll
            for (int bj = 0; bj < 2; ++bj) {
                const int col = col0 + bj * HALF;
                const u32x4 gw = gq[gi & 1][bj][0];
                f32x4 g0 = (f32x4){bf_lo(gw.x), bf_hi(gw.x), bf_lo(gw.y), bf_hi(gw.y)}, g1 = (f32x4){bf_lo(gw.z), bf_hi(gw.z), bf_lo(gw.w), bf_hi(gw.w)};
                if (mid) {
                    const u32x4 nw = gq[gi & 1][bj][1];
#pragma unroll
                    for (int j = 0; j < 2; ++j) { const unsigned a = j == 0 ? nw.x : nw.y, b = j == 0 ? nw.z : nw.w;
                        g0[2 * j] *= fast_rcp(bf_lo(a)); g0[2 * j + 1] *= fast_rcp(bf_hi(a)); g1[2 * j] *= fast_rcp(bf_lo(b)); g1[2 * j + 1] *= fast_rcp(bf_hi(b)); }
                    acc[ai][bj][m][0] *= g0; acc[ai][bj][m][1] *= g1;
                } else {
                    const f32x4 v0 = g0 * acc[ai][bj][m][0], v1 = g1 * acc[ai][bj][m][1];
                    u32x4 w; w.x = cvt_pk_bf16(v0[0], v0[1]); w.y = cvt_pk_bf16(v0[2], v0[3]); w.z = cvt_pk_bf16(v1[0], v1[1]); w.w = cvt_pk_bf16(v1[2], v1[3]);
                    *(u32x4*)(O + row * D + col) = w; }
            }
            asm volatile("" : "+v"(acc[ai][0][m][0]), "+v"(acc[ai][0][m][1]), "+v"(acc[ai][1][m][0]), "+v"(acc[ai][1][m][1]));
        }
    }
};
}

__device__ __forceinline__ void tr_item(const float* W, int ldw, bf16_t* WT, int ldt, int k0, int n0, int c0, float scale, LAS float* scr, int lane) {
    float wv[32];
#pragma unroll
    for (int i = 0; i < 32; ++i) wv[i] = W[(size_t)(k0 + 2 * i + (lane >> 5)) * ldw + c0 + (lane & 31)];
#pragma unroll
    for (int i = 0; i < 32; ++i) scr[(2 * i + (lane >> 5)) * 33 + (lane & 31)] = wv[i];
    asm volatile("s_waitcnt lgkmcnt(0)" ::: "memory");
    const int c = lane & 7;
#pragma unroll
    for (int j = 0; j < 4; ++j) { const int n = (lane >> 3) + 8 * j; const LAS float* sp = scr + (8 * c) * 33 + n;
        u32x4 o; o.x = cvt_pk_bf16(sp[0 * 33] * scale, sp[1 * 33] * scale); o.y = cvt_pk_bf16(sp[2 * 33] * scale, sp[3 * 33] * scale);
        o.z = cvt_pk_bf16(sp[4 * 33] * scale, sp[5 * 33] * scale); o.w = cvt_pk_bf16(sp[6 * 33] * scale, sp[7 * 33] * scale);
        *(u32x4*)(WT + (size_t)(n0 + n) * ldt + k0 + 8 * c) = o; }
    asm volatile("s_waitcnt lgkmcnt(0)" ::: "memory");
}
template <int MODE>
__device__ __forceinline__ void tr_matrix(const float* W, int K, int N, int ldw, bf16_t* WT, int ldt, LAS float* scr, int gw, int ngw, int lane) {
    const int nblk = N / 32, nitems = (K / 64) * nblk;
    for (int it = gw; it < nitems; it += ngw) {
        const int kb = it / nblk, nb = it - kb * nblk, n0 = nb * 32; int c0 = n0; float scale = 1.f;
        if (MODE == 1) { const int tile = n0 >> 8, bj = (n0 >> 7) & 1, c = n0 & 127; c0 = bj * DFF + tile * 128 + c; scale = bj ? 0.6931471805599453f : LOG2E; }
        if (MODE == 2) { if (n0 < 512 || (n0 >= 768 && n0 < 1280)) scale = 0.125f * LOG2E; else if (n0 >= 2304 && n0 < 2816) scale = 0.08838834764831845f * LOG2E; }
        tr_item(W, ldw, WT, ldt, kb * 64, n0, c0, scale, scr, lane);
    }
}

struct AttnP {
    const bf16_t *q, *k, *v; bf16_t* o; float* lse;
    int q_rs, q_toff, kv_rs, o_rs, o_toff, lse_rs, lse_toff;
    int qpos0, qpos_tstep, k_lo, nsteps, sub_len, radius;
    float slope2, slope_tmul;
    float sink2[4];
};
__device__ __forceinline__ s16x4 vtr(const LAS unsigned char* p) {
    typedef short v4i16_t __attribute__((ext_vector_type(4)));
    return __builtin_bit_cast(s16x4, __builtin_amdgcn_ds_read_tr16_b64_v4i16((LAS v4i16_t*)p));
}
template <int DH, int NT, int MODE>
__device__ __forceinline__ void attn_item(const AttnP& P, LAS unsigned char* vl, int lane_in, const LAS unsigned char* kl = nullptr) {
    int lane = lane_in; asm volatile("" : "+v"(lane));
    constexpr bool MASK = MODE < 2, SINK = MODE == 0, LSE = MODE == 1, INLDS = MODE == 3;
    constexpr int NSTEPS = MODE == 0 ? 9 : (MODE == 1 ? 6 : 8), QTSTEP = MODE == 1 ? 16 : 0;
    constexpr float RADF = MODE == 0 ? 128.f : 64.f, SLOPE_TMUL = MODE == 0 ? 0.5f : 1.0f;
    constexpr int KS = DH / 32, ND = DH / 16, VP = DH * 2 + 32, NVL = DH / 16;
    const int fr = lane & 15, g = lane >> 4;
    bf16x8 qf[NT][KS];
#pragma unroll
    for (int i = 0; i < NT; ++i)
#pragma unroll
        for (int ks = 0; ks < KS; ++ks) qf[i][ks] = *(const bf16x8*)(P.q + (size_t)i * P.q_toff + (size_t)fr * P.q_rs + ks * 32 + g * 8);
    f32x4 o[NT][ND]; float mrun[NT], lrun[NT];
#pragma unroll
    for (int i = 0; i < NT; ++i) {
#pragma unroll
        for (int d = 0; d < ND; ++d) o[i][d] = (f32x4){0.f, 0.f, 0.f, 0.f};
        mrun[i] = SINK ? P.sink2[i] : -1e30f; lrun[i] = (SINK && g == 0) ? 1.f : 0.f; }
    bf16x8 kf[2][KS]; u32x4 vr[NVL];
    constexpr int CPR = DH / 8;
    const int kmax = P.sub_len - 1, klo = P.k_lo, kvrs = P.kv_rs;
    const bf16_t* kbase = P.k + g * 8; const bf16_t* vbase = P.v;
    if (!INLDS) {
#pragma unroll
        for (int a = 0; a < 2; ++a) { int kp = klo + 16 * a + fr; kp = kp < 0 ? 0 : (kp > kmax ? kmax : kp);
#pragma unroll
            for (int ks = 0; ks < KS; ++ks) kf[a][ks] = *(const bf16x8*)(kbase + (size_t)kp * kvrs + ks * 32); }
#pragma unroll
        for (int it = 0; it < NVL; ++it) { const int idx = it * 64 + lane, r = idx / CPR, ch = idx % CPR; int kp = klo + r; kp = kp < 0 ? 0 : (kp > kmax ? kmax : kp);
            vr[it] = *(const u32x4*)(vbase + (size_t)kp * kvrs + ch * 8); }
    }
    const LAS unsigned char* vrd = vl + (4 * g + (fr >> 2)) * VP + 8 * (fr & 3);
    const float qbase = (float)(4 * g - P.qpos0 - fr);
    for (int s = 0; s < NSTEPS; ++s) {
        const int k0 = klo + 32 * s;
        asm volatile("" ::: "memory");
        bf16x8 kc[2][KS];
        if (INLDS) {
#pragma unroll
            for (int a = 0; a < 2; ++a)
#pragma unroll
                for (int ks = 0; ks < KS; ++ks) kc[a][ks] = *(const LAS bf16x8*)(kl + (32 * s + 16 * a + fr) * VP + (ks * 32 + 8 * g) * 2);
        } else {
#pragma unroll
        for (int it = 0; it < NVL; ++it) { const int idx = it * 64 + lane, r = idx / CPR, ch = idx % CPR; *(LAS u32x4*)(vl + r * VP + ch * 16) = vr[it]; }
#pragma unroll
        for (int a = 0; a < 2; ++a)
#pragma unroll
            for (int ks = 0; ks < KS; ++ks) kc[a][ks] = kf[a][ks];
        }
        if (!INLDS && s + 1 < NSTEPS) {
            const int k1 = k0 + 32;
#pragma unroll
            for (int a = 0; a < 2; ++a) { int kp = k1 + 16 * a + fr; kp = kp < 0 ? 0 : (kp > kmax ? kmax : kp);
#pragma unroll
                for (int ks = 0; ks < KS; ++ks) kf[a][ks] = *(const bf16x8*)(kbase + (size_t)kp * kvrs + ks * 32); }
#pragma unroll
            for (int it = 0; it < NVL; ++it) { const int idx = it * 64 + lane, r = idx / CPR, ch = idx % CPR; int kp = k1 + r; kp = kp < 0 ? 0 : (kp > kmax ? kmax : kp);
                vr[it] = *(const u32x4*)(vbase + (size_t)kp * kvrs + ch * 8); }
        }
        asm volatile("s_waitcnt lgkmcnt(0)" ::: "memory");
        const bool edge = (k0 < 0) || (k0 + 31 > kmax);
        const float kf0 = (float)k0 + qbase;
        float koff[2][4];
#pragma unroll
        for (int a = 0; a < 2; ++a)
#pragma unroll
            for (int r = 0; r < 4; ++r) { koff[a][r] = (float)(16 * a + r); if (MASK && edge) { const int kp = k0 + 16 * a + 4 * g + r; if (kp < 0 || kp > kmax) koff[a][r] = INFINITY; } }
        bf16x8 pf[NT]; float alv[NT]; bool act[NT];
#pragma unroll
        for (int i = 0; i < NT; ++i) {
            act[i] = !(MODE == 1) || (s >= (i >> 1) && s <= (i >> 1) + 4);
            if (!act[i]) { alv[i] = 1.0f; continue; }
            f32x4 sc[2];
#pragma unroll
            for (int a = 0; a < 2; ++a) { sc[a] = (f32x4){0.f, 0.f, 0.f, 0.f};
#pragma unroll
                for (int ks = 0; ks < KS; ++ks) sc[a] = __builtin_amdgcn_mfma_f32_16x16x32_bf16(kc[a][ks], qf[i][ks], sc[a], 0, 0, 0); }
            if (MASK) {
                float slope = P.slope2;
#pragma unroll
                for (int t = 0; t < i; ++t) slope *= SLOPE_TMUL;
                const float base = kf0 - (float)(i * QTSTEP);
#pragma unroll
                for (int a = 0; a < 2; ++a)
#pragma unroll
                    for (int r = 0; r < 4; ++r) { const float ad = fabsf(base + koff[a][r]);
                        sc[a][r] = (ad <= RADF) ? fmaf(-slope, ad, sc[a][r]) : -INFINITY; }
            }
            float mx = fmaxf(fmaxf(fmaxf(sc[0][0], sc[0][1]), fmaxf(sc[0][2], sc[0][3])), fmaxf(fmaxf(sc[1][0], sc[1][1]), fmaxf(sc[1][2], sc[1][3])));
            mx = rowgrp_max(mx);
            const float mnew = fmaxf(mrun[i], mx); alv[i] = fast_exp2(mrun[i] - mnew);
            mrun[i] = mnew;
            float ps = 0.f;
#pragma unroll
            for (int a = 0; a < 2; ++a)
#pragma unroll
                for (int r = 0; r < 4; ++r) { const float p = fast_exp2(sc[a][r] - mnew); sc[a][r] = p; ps += p; }
            lrun[i] = lrun[i] * alv[i] + ps;
            union { bf16x8 v; unsigned u[4]; } pk;
            pk.u[0] = cvt_pk_bf16(sc[0][0], sc[0][1]); pk.u[1] = cvt_pk_bf16(sc[0][2], sc[0][3]); pk.u[2] = cvt_pk_bf16(sc[1][0], sc[1][1]); pk.u[3] = cvt_pk_bf16(sc[1][2], sc[1][3]);
            pf[i] = pk.v;
        }
        bool resc[NT];
#pragma unroll
        for (int i = 0; i < NT; ++i) resc[i] = act[i];
#pragma unroll
        for (int d = 0; d < ND; ++d) {
            const LAS unsigned char* vs = INLDS ? vrd + s * 32 * VP : vrd;
            const s16x4 lo = vtr(vs + d * 32), hi = vtr(vs + 16 * VP + d * 32);
            const bf16x8 vt = (bf16x8){lo[0], lo[1], lo[2], lo[3], hi[0], hi[1], hi[2], hi[3]};
#pragma unroll
            for (int i = 0; i < NT; ++i) { if (resc[i]) o[i][d] = o[i][d] * alv[i]; if (act[i]) o[i][d] = __builtin_amdgcn_mfma_f32_16x16x32_bf16(vt, pf[i], o[i][d], 0, 0, 0); }
        }
        asm volatile("" ::: "memory");
    }
#pragma unroll
    for (int i = 0; i < NT; ++i) {
        const float l = rowgrp_sum(lrun[i]);
        const float inv = 1.0f / l;
        bf16_t* orow = P.o + (size_t)i * P.o_toff + (size_t)fr * P.o_rs + 4 * g;
#pragma unroll
        for (int d = 0; d < ND; ++d) { u32x2 w; w.x = cvt_pk_bf16(o[i][d][0] * inv, o[i][d][1] * inv); w.y = cvt_pk_bf16(o[i][d][2] * inv, o[i][d][3] * inv); *(u32x2*)(orow + 16 * d) = w; }
        if (LSE) { if (g == 0) P.lse[(size_t)i * P.lse_toff + (size_t)fr * P.lse_rs] = mrun[i] + __log2f(l); }
    }
}

struct Args {
    const float* in[19];
    float* out; unsigned char* ws;
};

__global__ void __launch_bounds__(512, 2) mega_fwd(Args args) {
    extern __shared__ __attribute__((aligned(16))) unsigned char lds_raw[];
    LAS unsigned char* lds = (LAS unsigned char*)lds_raw;
    cg::grid_group grid = cg::this_grid();
    const int G = gridDim.x, bx = blockIdx.x;
    volatile LAS unsigned* MISC = (volatile LAS unsigned*)(lds + LDS_MISC);
    if (threadIdx.x < 32) MISC[threadIdx.x] = 0u;
    __syncthreads();
    grid.sync();
    const XcdBarrier bar = xcd_barrier_post((unsigned*)(args.ws + WS_CTL), MISC + 8);
    constexpr int PH_PER_CHUNK = NLAYER * 9, NPH = 2 + NCHUNK * PH_PER_CHUNK;
    for (int ph_i = 0; ph_i < NPH; ++ph_i) {
        int ph = ph_i; asm volatile("" : "+s"(ph));
        int lane = threadIdx.x & 63; asm volatile("" : "+v"(lane));
        const int wave = __builtin_amdgcn_readfirstlane(threadIdx.x >> 6);
        const int vcu = (G % 8 == 0) ? (bx % 8) * (G / 8) + bx / 8 : bx;
        const int gw = vcu * 8 + wave, NGW = G * 8;
        unsigned char* ws = args.ws;
        bf16_t* Wb = (bf16_t*)(ws + WS_W); bf16_t* Wmem = (bf16_t*)(ws + WS_WMEM); bf16_t* memb = (bf16_t*)(ws + WS_MEMB); bf16_t* memkv = (bf16_t*)(ws + WS_MEMKV);
        bf16_t* xb = (bf16_t*)(ws + WS_XB);
        bf16_t* hb = (bf16_t*)(ws + WS_U + U_H); bf16_t* proj = (bf16_t*)(ws + WS_U + U_PROJ); bf16_t* gates = (bf16_t*)(ws + WS_U + U_GATES); bf16_t* br = (bf16_t*)(ws + WS_U + U_BR);
        bf16_t* bpart = (bf16_t*)(ws + WS_U + U_BPART); float* lseb = (float*)(ws + WS_U + U_LSE); float* mixf = (float*)(ws + WS_U + U_MIXF); bf16_t* mixb = (bf16_t*)(ws + WS_U + U_MIXB);
        int load_chunk = -1;
        if (ph == 0) { for (int rep = 0; rep < REP_PRO; ++rep) {
            LAS float* scr = (LAS float*)(lds + wave * 16384);
            for (int l = 0; l < NLAYER; ++l) {
                bf16_t* WL = Wb + (size_t)l * W_LAYER_ELEMS;
                tr_matrix<1>(args.in[4] + (size_t)l * D * 2 * DFF, D, 2 * DFF, 2 * DFF, WL + OFF_W1IN, D, scr, gw, NGW, lane);
                tr_matrix<0>(args.in[5] + (size_t)l * DFF * D, DFF, D, D, WL + OFF_W1OUT, DFF, scr, gw, NGW, lane);
                tr_matrix<2>(args.in[8] + (size_t)l * D * INC, D, INC, INC, WL + OFF_WIN, D, scr, gw, NGW, lane);
                tr_matrix<0>(args.in[9] + (size_t)l * D * 1024, D, 1024, 1024, Wmem + (size_t)l * 1024 * D, D, scr, gw, NGW, lane);
                for (int i = 0; i < 3; ++i) tr_matrix<0>(args.in[11] + ((size_t)l * 3 + i) * 512 * D, 512, D, D, WL + OFF_WBR + (size_t)i * D * 512, 512, scr, gw, NGW, lane);
                tr_matrix<0>(args.in[12] + (size_t)l * D * D, D, D, D, WL + OFF_WOUT, D, scr, gw, NGW, lane);
                tr_matrix<1>(args.in[15] + (size_t)l * D * 2 * DFF, D, 2 * DFF, 2 * DFF, WL + OFF_W2IN, D, scr, gw, NGW, lane);
                tr_matrix<0>(args.in[16] + (size_t)l * DFF * D, DFF, D, D, WL + OFF_W2OUT, DFF, scr, gw, NGW, lane);
            }
            for (int m = gw; m < MEMROWS; m += NGW) {
                const float* src = (m < 4096) ? args.in[2] + (size_t)m * D : args.in[3] + (size_t)(m - 4096) * D;
#pragma unroll
                for (int j = 0; j < 4; ++j) { const f32x4 v = *((const f32x4*)src + lane + 64 * j); u32x2 w; w.x = cvt_pk_bf16(v[0], v[1]); w.y = cvt_pk_bf16(v[2], v[3]); *((u32x2*)(memb + (size_t)m * D) + lane + 64 * j) = w; }
            } }
            load_chunk = 0;
        } else if (ph == 1) {
            pg8::Gemm g{memb, Wmem, MEMROWS, 2048, D, D, D, 0, 0}; pg8::Order S; S.init(MEMROWS, 2048, 1, G, bx);
            pg8::EpiBf16Plain E{memkv, 2048};
            pg8::gemm_phase(lds, g, S, E);
        } else {
            const int q = ph - 2, c = q / PH_PER_CHUNK, r = q - c * PH_PER_CHUNK;
            const bool is_prompt = c < 2;
            float* X = args.out + (size_t)c * TC * D;
            const int L = is_prompt ? 2048 : 8192;
            {
                const int l = r / 9, k = r - l * 9;
                const bf16_t* WL = Wb + (size_t)l * W_LAYER_ELEMS;
                if (k == 0 || k == 7) {
                    pg8::Gemm g{xb, WL + (k == 0 ? OFF_W1IN : OFF_W2IN), TC, 2 * DFF, D, D, D, 0, 0}; pg8::Order S; S.init(TC, 2 * DFF, 1, G, bx); pg8::EpiSwiglu E{hb, DFF}; for (int rep = 0; rep < REP_UP; ++rep) pg8::gemm_phase(lds, g, S, E);
                    if (l == 0 && k == 0) {
                        const float* xin = is_prompt ? args.in[0] + (size_t)c * TC * D : args.in[1] + (size_t)(c - 2) * TC * D;
                        for (int m0 = gw; m0 < TC; m0 += 4 * NGW) {
                            f32x4 v[4][4];
#pragma unroll
                            for (int r = 0; r < 4; ++r) { const int mm = m0 + r * NGW; const size_t m = (size_t)(mm < TC ? mm : m0);
#pragma unroll
                                for (int j = 0; j < 4; ++j) v[r][j] = *((const f32x4*)(xin + m * D) + lane + 64 * j); }
#pragma unroll
                            for (int r = 0; r < 4; ++r) { const int mm = m0 + r * NGW; if (mm >= TC) continue;
#pragma unroll
                                for (int j = 0; j < 4; ++j) { u32x2 hw; hw.x = cvt_pk_h(v[r][j][0], v[r][j][1]); hw.y = cvt_pk_h(v[r][j][2], v[r][j][3]); *((u32x2*)((bf16_t*)(ws + WS_X16) + (size_t)mm * D) + lane + 64 * j) = hw; } }
                        }
                    }
                } else if (k == 1 || k == 8 || k == 6) {
                    const bool ffn = (k != 6); const int sidx = (k == 1) ? 0 : (k == 6 ? 1 : 2);
                    const bool last = (l == NLAYER - 1 && k == 8);
                    pg8::Gemm g{ffn ? hb : mixb, WL + (k == 1 ? OFF_W1OUT : (k == 8 ? OFF_W2OUT : OFF_WOUT)), TC, D, ffn ? DFF : D, ffn ? DFF : D, ffn ? DFF : D, 0, 0};
                    pg8::Order S; S.init(TC, D, 1, G, bx);
                    const int nuse = (c * NLAYER + l) * 3 + sidx;
                    pg8::EpiResidLN E{last ? X : nullptr, (bf16_t*)(ws + WS_X16), xb, args.in[sidx == 0 ? 6 : (sidx == 1 ? 13 : 17)] + l * D, args.in[sidx == 0 ? 7 : (sidx == 1 ? 14 : 18)] + l * D, ffn ? 0.5f : 1.0f,
                                      (unsigned long long*)(ws + WS_CTL + CTL_XBUF), (unsigned*)(ws + WS_CTL + 16384), 32u * (unsigned)(nuse + 1)};
                    pg8::gemm_phase(lds, g, S, E);
                    if (last && c + 1 < NCHUNK) load_chunk = c + 1;
                } else if (k == 2) {
                    pg8::Gemm g{xb, WL + OFF_WIN, TC, INC, D, D, D, 0, 0}; pg8::Order S; S.init(TC, INC, 1, G, bx); pg8::EpiInproj E{proj, gates}; for (int rep = 0; rep < REP_INPROJ; ++rep) pg8::gemm_phase(lds, g, S, E);
                } else if (k == 3) {
                    LAS unsigned char* vl = lds + wave * 9216;
                    const float* sink = args.in[10] + l * 8;
                    const int memrow0 = is_prompt ? c * 8 * NMEM : 4096 + (c - 2) * 2 * NMEM;
                    for (int rep = 0; rep < REP_ATT; ++rep) {
                    for (int u = vcu; u < 256; u += G) {
                        const int nqb = L / 256; const int qb = u % nqb, hh = (u / nqb) & 3, sq = u / (nqb * 4);
                        const bf16_t* mb = memkv + (size_t)(memrow0 + sq * NMEM) * 2048 + l * 1024 + hh * 128;
                        __syncthreads();
#pragma unroll 2
                        for (int j = 0; j < 8; ++j) { const int idx = j * 512 + (int)threadIdx.x, rrow = idx >> 4, pc = idx & 15;
                            const u32x4 kv = *(const u32x4*)(mb + (size_t)rrow * 2048 + pc * 8), vv = *(const u32x4*)(mb + 512 + (size_t)rrow * 2048 + pc * 8);
                            *(LAS u32x4*)(lds + rrow * 288 + pc * 16) = kv; *(LAS u32x4*)(lds + 73728 + rrow * 288 + pc * 16) = vv; }
                        __syncthreads();
                        AttnP P;
                        const int tok0 = sq * L + qb * 256 + wave * 32;
                        P.q = proj + (size_t)tok0 * PROJC + 2304 + hh * 128; P.q_rs = PROJC; P.q_toff = 16 * PROJC;
                        P.k = mb; P.v = mb + 512; P.kv_rs = 2048;
                        P.o = br + (size_t)tok0 * BRC + 1024 + hh * 128; P.o_rs = BRC; P.o_toff = 16 * BRC; P.lse = nullptr; P.lse_rs = 0; P.lse_toff = 0;
                        P.qpos0 = 0; P.qpos_tstep = 0; P.k_lo = 0; P.nsteps = 8; P.sub_len = NMEM; P.radius = 1 << 20;
                        P.slope2 = 0.f; P.slope_tmul = 1.f;
#pragma unroll
                        for (int i = 0; i < 4; ++i) P.sink2[i] = 0.f;
                        attn_item<128, 2, 3>(P, lds + 73728, lane, lds);
                    }
                    __syncthreads();
                    for (int it = gw; it < 4 * 2048; it += NGW) {
                        const int type = it >> 11, id = it & 2047;
                        AttnP P;
                        if (type == 0) {
                            const int hk = id & 1, tb = id >> 1; const int tok0 = tb * 16; const int sq = tok0 / L, pos0 = tok0 - sq * L;
                            const bf16_t* base = proj + (size_t)(sq * L) * PROJC;
                            P.q = proj + (size_t)tok0 * PROJC + hk * 256; P.q_rs = PROJC; P.q_toff = 64;
                            P.k = base + 512 + hk * 64; P.v = base + 512 + 128 + hk * 64; P.kv_rs = PROJC;
                            P.o = br + (size_t)tok0 * BRC + hk * 256; P.o_rs = BRC; P.o_toff = 64; P.lse = nullptr; P.lse_rs = 0; P.lse_toff = 0;
                            P.qpos0 = pos0; P.qpos_tstep = 0; P.k_lo = pos0 - 128; P.nsteps = 9; P.sub_len = L; P.radius = 128;
                            P.slope2 = LOG2E * exp2f(-(float)(hk * 4 + 1)); P.slope_tmul = 0.5f;
#pragma unroll
                            for (int i = 0; i < 4; ++i) P.sink2[i] = sink[hk * 4 + i] * LOG2E;
                            attn_item<64, 4, 0>(P, vl, lane);
                        } else {
                            const int cfg = type - 1, dil = cfg == 0 ? 1 : (cfg == 1 ? 4 : 16);
                            const int h = id & 7, blk = id >> 3;
                            const int sub_len = L / dil, bps = sub_len / 64;
                            const int sr = blk / bps, jb = blk - sr * bps; const int sq = sr / dil, rs = sr - sq * dil; const int j0 = jb * 64;
                            const bf16_t* base = proj + (size_t)(sq * L + rs) * PROJC + 768 + h * 64;
                            const size_t tok0 = (size_t)sq * L + rs + (size_t)j0 * dil;
                            P.q = proj + tok0 * PROJC + 768 + h * 64; P.q_rs = PROJC * dil; P.q_toff = 16 * PROJC * dil;
                            P.k = base + 512; P.v = base + 1024; P.kv_rs = PROJC * dil;
                            P.o = bpart + (size_t)cfg * TC * 512 + tok0 * 512 + h * 64; P.o_rs = 512 * dil; P.o_toff = 16 * 512 * dil;
                            P.lse = lseb + (size_t)cfg * TC * 8 + tok0 * 8 + h; P.lse_rs = 8 * dil; P.lse_toff = 16 * 8 * dil;
                            P.qpos0 = j0; P.qpos_tstep = 16; P.k_lo = j0 - 64; P.nsteps = 6; P.sub_len = sub_len; P.radius = 64;
                            P.slope2 = LOG2E * exp2f(-(float)(h + 1)) * (float)dil; P.slope_tmul = 1.0f;
#pragma unroll
                            for (int i = 0; i < 4; ++i) P.sink2[i] = 0.f;
                            attn_item<64, 4, 1>(P, vl, lane);
                        }
                    }
                    }
                } else if (k == 4) {
                    for (int rep = 0; rep < REP_CMB; ++rep) for (int m0 = gw; m0 < TC; m0 += 4 * NGW) {
                        const int h = lane >> 3;
                        float l0[4], l1[4], l2[4]; u32x4 a[4], b[4], cc[4];
#pragma unroll
                        for (int r = 0; r < 4; ++r) { const int mm = m0 + r * NGW; const size_t m = (size_t)(mm < TC ? mm : m0);
                            l0[r] = lseb[m * 8 + h]; l1[r] = lseb[(size_t)TC * 8 + m * 8 + h]; l2[r] = lseb[(size_t)2 * TC * 8 + m * 8 + h];
                            a[r] = *((const u32x4*)(bpart + m * 512) + lane); b[r] = *((const u32x4*)(bpart + (size_t)TC * 512 + m * 512) + lane); cc[r] = *((const u32x4*)(bpart + (size_t)2 * TC * 512 + m * 512) + lane); }
#pragma unroll
                        for (int r = 0; r < 4; ++r) { const int mm = m0 + r * NGW; if (mm >= TC) continue;
                            const float mx = fmaxf(l0[r], fmaxf(l1[r], l2[r])); float w0 = fast_exp2(l0[r] - mx), w1 = fast_exp2(l1[r] - mx), w2 = fast_exp2(l2[r] - mx); const float inv = 1.0f / (w0 + w1 + w2); w0 *= inv; w1 *= inv; w2 *= inv;
                            u32x4 w;
                            w.x = cvt_pk_bf16(w0 * bf_lo(a[r].x) + w1 * bf_lo(b[r].x) + w2 * bf_lo(cc[r].x), w0 * bf_hi(a[r].x) + w1 * bf_hi(b[r].x) + w2 * bf_hi(cc[r].x));
                            w.y = cvt_pk_bf16(w0 * bf_lo(a[r].y) + w1 * bf_lo(b[r].y) + w2 * bf_lo(cc[r].y), w0 * bf_hi(a[r].y) + w1 * bf_hi(b[r].y) + w2 * bf_hi(cc[r].y));
                            w.z = cvt_pk_bf16(w0 * bf_lo(a[r].z) + w1 * bf_lo(b[r].z) + w2 * bf_lo(cc[r].z), w0 * bf_hi(a[r].z) + w1 * bf_hi(b[r].z) + w2 * bf_hi(cc[r].z));
                            w.w = cvt_pk_bf16(w0 * bf_lo(a[r].w) + w1 * bf_lo(b[r].w) + w2 * bf_lo(cc[r].w), w0 * bf_hi(a[r].w) + w1 * bf_hi(b[r].w) + w2 * bf_hi(cc[r].w));
                            *((u32x4*)(br + (size_t)mm * BRC + 512) + lane) = w; }
                    }
                } else {
                    pg8::Gemm g{br, WL + OFF_WBR, TC, D, 512, BRC, 512, 512, (size_t)D * 512}; pg8::Order S; S.init(TC, D, 3, G, bx); pg8::EpiBranch E{gates, mixb}; for (int rep = 0; rep < REP_BR; ++rep) pg8::gemm_phase(lds, g, S, E);
                }
            }
        }
        if (load_chunk >= 0) {
            const float* xin = load_chunk < 2 ? args.in[0] + (size_t)load_chunk * TC * D : args.in[1] + (size_t)(load_chunk - 2) * TC * D;
            for (int m0 = gw; m0 < TC; m0 += 4 * NGW) {
                f32x4 v[4][4];
#pragma unroll
                for (int r = 0; r < 4; ++r) { const int mm = m0 + r * NGW; const size_t m = (size_t)(mm < TC ? mm : m0);
#pragma unroll
                    for (int j = 0; j < 4; ++j) v[r][j] = *((const f32x4*)(xin + m * D) + lane + 64 * j); }
#pragma unroll
                for (int r = 0; r < 4; ++r) { const int mm = m0 + r * NGW; if (mm >= TC) continue;
#pragma unroll
                    for (int j = 0; j < 4; ++j) { u32x2 w; w.x = cvt_pk_bf16(v[r][j][0], v[r][j][1]); w.y = cvt_pk_bf16(v[r][j][2], v[r][j][3]); *((u32x2*)(xb + (size_t)mm * D) + lane + 64 * j) = w; } }
            }
        }
        for (int rep = 0; rep < REP_SYNC; ++rep) xcd_barrier(bar);
    }
}

extern "C" void kernel_launch(void* const* d_in, const int* in_sizes, int n_in, void* d_out, int out_size, void* d_ws, size_t ws_size, hipStream_t stream) {
    static int grid = 0;
    if (grid == 0) {
        if (n_in != 19 || ws_size < WS_END) { fprintf(stderr, "kernel_launch: need 19 inputs and %zu bytes of workspace; got %d, %zu\n", (size_t)WS_END, n_in, ws_size); grid = -1; return; }
        int dev = 0, cus = 0, per_cu = 0;
        hipGetDevice(&dev); hipDeviceGetAttribute(&cus, hipDeviceAttributeMultiprocessorCount, dev);
        if (hipFuncSetAttribute((const void*)mega_fwd, hipFuncAttributeMaxDynamicSharedMemorySize, LDS_BYTES) != hipSuccess) { fprintf(stderr, "kernel_launch: hipFuncSetAttribute failed\n"); grid = -1; return; }
        if (hipOccupancyMaxActiveBlocksPerMultiprocessor(&per_cu, (const void*)mega_fwd, 512, LDS_BYTES) != hipSuccess || per_cu < 1) { fprintf(stderr, "kernel_launch: occupancy query says %d\n", per_cu); per_cu = 1; }
        (void)hipGetLastError();
        grid = cus;
        if (grid != 256) { fprintf(stderr, "kernel_launch: built for a 256-CU device (fused LayerNorm epilogue needs one 256x256 unit per workgroup); got %d CUs\n", cus); grid = -1; return; }
    }
    if (grid < 0) return;
    if (hipMemsetAsync((char*)d_ws + WS_CTL, 0, CTL_BYTES, stream) != hipSuccess) { fprintf(stderr, "kernel_launch: memset failed\n"); return; }
    Args a{};
    for (int i = 0; i < 19; ++i) a.in[i] = (const float*)d_in[i];
    a.out = (float*)d_out; a.ws = (unsigned char*)d_ws;
    void* kargs[] = {&a};
    hipError_t e = hipLaunchCooperativeKernel((const void*)mega_fwd, dim3(grid), dim3(512), kargs, LDS_BYTES, stream);
    if (e != hipSuccess) fprintf(stderr, "cooperative launch failed: %s (grid %d)\n", hipGetErrorString(e), grid);
}
```

```cpp
#include <hip/hip_runtime.h>
#include <hip/hip_cooperative_groups.h>
#include <cstdio>
#include <cstdint>
namespace cg = cooperative_groups;

#define LAS __attribute__((address_space(3)))
typedef unsigned short bf16_t;
typedef short bf16x8 __attribute__((ext_vector_type(8)));
typedef short s16x4 __attribute__((ext_vector_type(4)));
typedef float f32x4 __attribute__((ext_vector_type(4)));
typedef float f32x2 __attribute__((ext_vector_type(2)));
typedef unsigned u32x4 __attribute__((ext_vector_type(4)));
typedef unsigned u32x2 __attribute__((ext_vector_type(2)));

constexpr int D = 1024, DFF = 2816, NLAYER = 2;
constexpr int TC = 16384;
constexpr int NCHUNK = 4;
constexpr int INC = 5888, PROJC = 2816, GATEC = 3072, BRC = 1536;
constexpr int NMEM = 256, MEMROWS = 5120;
constexpr float LN_EPS = 1e-5f;
constexpr float ALPHA = 1.41421356237309515f;
constexpr float LOG2E = 1.44269504088896341f;

constexpr size_t MiB = 1u << 20;
constexpr size_t W_LAYER_ELEMS = (size_t)5632 * 1024 + (size_t)1024 * 2816 + (size_t)5888 * 1024 + (size_t)3 * 1024 * 512 + (size_t)1024 * 1024 + (size_t)5632 * 1024 + (size_t)1024 * 2816;
constexpr size_t OFF_W1IN = 0, OFF_W1OUT = OFF_W1IN + (size_t)5632 * 1024, OFF_WIN = OFF_W1OUT + (size_t)1024 * 2816, OFF_WBR = OFF_WIN + (size_t)5888 * 1024,
                 OFF_WOUT = OFF_WBR + (size_t)3 * 1024 * 512, OFF_W2IN = OFF_WOUT + (size_t)1024 * 1024, OFF_W2OUT = OFF_W2IN + (size_t)5632 * 1024;
constexpr size_t WS_W = 0;
constexpr size_t WS_WMEM = 100 * MiB;
constexpr size_t WS_MEMB = 108 * MiB;
constexpr size_t WS_MEMKV = 118 * MiB;
constexpr size_t WS_XB = 158 * MiB;
constexpr size_t WS_U = 190 * MiB;
constexpr size_t U_H = 0;
constexpr size_t U_PROJ = 0;
constexpr size_t U_GATES = 88 * MiB;
constexpr size_t U_BR = 184 * MiB;
constexpr size_t U_BPART = 232 * MiB;
constexpr size_t U_LSE = 280 * MiB;
constexpr size_t U_MIXF = 0;
constexpr size_t U_MIXB = 232 * MiB;
constexpr size_t WS_X16 = WS_U + 282 * MiB;
constexpr size_t WS_CTL = WS_X16 + 32 * MiB;
constexpr size_t CTL_BYTES = 32768;
constexpr size_t CTL_XBUF = 65536;
constexpr size_t WS_END = WS_CTL + 1 * MiB;
static_assert(W_LAYER_ELEMS * 2 * 2 <= 100 * MiB, "weights fit");

constexpr int REP_ATT = 1, REP_UP = 1, REP_INPROJ = 1, REP_BR = 1, REP_PRO = 1, REP_SYNC = 1, REP_CMB = 1;
constexpr int LDS_BYTES = 147456 + 256;
constexpr int LDS_MISC = 147456;

__device__ __forceinline__ unsigned cvt_pk_bf16(float lo, float hi) { unsigned r; asm("v_cvt_pk_bf16_f32 %0, %1, %2" : "=v"(r) : "v"(lo), "v"(hi)); return r; }
__device__ __forceinline__ float bf_lo(unsigned u) { return __uint_as_float(u << 16); }
__device__ __forceinline__ float bf_hi(unsigned u) { return __uint_as_float(u & 0xffff0000u); }
typedef _Float16 f16x2 __attribute__((ext_vector_type(2)));
__device__ __forceinline__ unsigned cvt_pk_h(float lo, float hi) { const f16x2 v = {(_Float16)lo, (_Float16)hi}; return __builtin_bit_cast(unsigned, v); }
__device__ __forceinline__ float h_lo(unsigned u) { return (float)__builtin_bit_cast(f16x2, u)[0]; }
__device__ __forceinline__ float h_hi(unsigned u) { return (float)__builtin_bit_cast(f16x2, u)[1]; }
__device__ __forceinline__ float fast_exp2(float x) { return __builtin_amdgcn_exp2f(x); }
__device__ __forceinline__ float fast_rcp(float x) { return __builtin_amdgcn_rcpf(x); }
__device__ __forceinline__ float sigmoidf_fast(float v) { return fast_rcp(1.0f + fast_exp2(-LOG2E * v)); }
__device__ __forceinline__ float rowgrp_max(float m) {
    const auto r = __builtin_amdgcn_permlane16_swap(__float_as_uint(m), __float_as_uint(m), false, false);
    const float a = fmaxf(__uint_as_float(r[0]), __uint_as_float(r[1]));
    const auto r2 = __builtin_amdgcn_permlane32_swap(__float_as_uint(a), __float_as_uint(a), false, false);
    return fmaxf(__uint_as_float(r2[0]), __uint_as_float(r2[1]));
}
__device__ __forceinline__ float rowgrp_sum(float m) {
    const auto r = __builtin_amdgcn_permlane16_swap(__float_as_uint(m), __float_as_uint(m), false, false);
    const float a = __uint_as_float(r[0]) + __uint_as_float(r[1]);
    const auto r2 = __builtin_amdgcn_permlane32_swap(__float_as_uint(a), __float_as_uint(a), false, false);
    return __uint_as_float(r2[0]) + __uint_as_float(r2[1]);
}
__device__ __forceinline__ float wave_sum(float v) {
#pragma unroll
    for (int o = 1; o < 64; o <<= 1) v += __shfl_xor(v, o);
    return v;
}

#define XB_TMO      128
#define XB_XCNT(j)  (256  + 64 * (j))
#define XB_XSUB(j)  (1280 + 64 * (j))
#define XB_XGEN(j)  (2304 + 64 * (j))
#define XB_TOP      3328
#define XB_TOPGEN   3392
#define XCD_BAR_WORDS 3456
#define XB_SPIN_CAP (1u << 18)

__device__ __forceinline__ unsigned xb_ld(unsigned* p)              { return __hip_atomic_load(p, __ATOMIC_RELAXED, __HIP_MEMORY_SCOPE_AGENT); }
__device__ __forceinline__ unsigned xb_add(unsigned* p, unsigned v) { return __hip_atomic_fetch_add(p, v, __ATOMIC_RELAXED, __HIP_MEMORY_SCOPE_AGENT); }
__device__ __forceinline__ unsigned xb_xcc_id() { return (unsigned)__builtin_amdgcn_s_getreg((3 << 11) | 20) & 0xFu; }
#define XB_SPIN(cond, bar) do { unsigned _sp = 0; while (cond) { __builtin_amdgcn_s_sleep(1); \
    if ((++_sp & 255u) == 0u) { if (xb_ld(&(bar)[XB_TMO])) break; if (_sp > XB_SPIN_CAP) { atomicAdd(&(bar)[XB_TMO], 1u); break; } } } } while (0)

struct XcdBarrier {
    unsigned* bar; unsigned x;
    volatile LAS unsigned* st;
};

__device__ __forceinline__ XcdBarrier xcd_barrier_post(unsigned* bar, volatile LAS unsigned* st) {
    XcdBarrier b; b.bar = bar; b.x = xb_xcc_id(); b.st = st;
    if (threadIdx.x == 0) (void)xb_add(&bar[XB_XCNT(b.x)], 1u);
    return b;
}
__device__ __forceinline__ void xcd_barrier_complete(unsigned* bar, unsigned x, unsigned& nloc, unsigned& nx) {
    const unsigned G = gridDim.x * gridDim.y * gridDim.z;
    unsigned sum, cnt, mine, sp = 0u;
    for (;;) {
        sum = 0u; cnt = 0u; mine = 0u;
#pragma unroll
        for (unsigned j = 0; j < 16; ++j) { const unsigned c = xb_ld(&bar[XB_XCNT(j)]); sum += c; cnt += (c > 0u) ? 1u : 0u; mine = (j == x) ? c : mine; }
        if (sum == G) break;
        __builtin_amdgcn_s_sleep(1);
        if ((++sp & 255u) == 0u) { if (xb_ld(&bar[XB_TMO])) break; if (sp > XB_SPIN_CAP) { atomicAdd(&bar[XB_TMO], 1u); break; } }
    }
    nloc = mine > 0u ? mine : 1u; nx = cnt > 0u ? cnt : 1u;
}

__device__ __forceinline__ void xcd_barrier(const XcdBarrier& b) {
    asm volatile("s_waitcnt vmcnt(0)" ::: "memory");
    __syncthreads();
    if (threadIdx.x == 0) {
        unsigned* bar = b.bar;
        __builtin_amdgcn_s_waitcnt(0);
        unsigned nloc = b.st[0], nx = b.st[1];
        if (nloc == 0u) { xcd_barrier_complete(bar, b.x, nloc, nx); b.st[0] = nloc; b.st[1] = nx; }
        const unsigned old = xb_add(&bar[XB_XSUB(b.x)], 1u);
        const unsigned gen = old / nloc;
        if (old + 1u == (gen + 1u) * nloc) {
            __builtin_amdgcn_fence(__ATOMIC_RELEASE, "agent");
            asm volatile("s_waitcnt vmcnt(0)" ::: "memory");
            const unsigned og = xb_add(&bar[XB_TOP], 1u);
            const unsigned tg = og / nx;
            if (og + 1u == (tg + 1u) * nx) xb_add(&bar[XB_TOPGEN], 1u);
            else XB_SPIN(xb_ld(&bar[XB_TOPGEN]) == tg, bar);
            __builtin_amdgcn_fence(__ATOMIC_ACQUIRE, "agent");
            xb_add(&bar[XB_XGEN(b.x)], 1u);
            asm volatile("s_waitcnt vmcnt(0)" ::: "memory");
        } else {
            XB_SPIN(xb_ld(&bar[XB_XGEN(b.x)]) == gen, bar);
            __builtin_amdgcn_fence(__ATOMIC_ACQUIRE, "agent");
            asm volatile("s_waitcnt vmcnt(0)" ::: "memory");
        }
    }
    __syncthreads();
}


namespace pg8 {
constexpr int BM = 256, BK = 64, HALF = 128, HTB = HALF * BK * 2, STAGE_BYTES = 8 * HTB, NXCD = 8, WGM = 4;
__host__ __device__ __forceinline__ int lds_byte(int r, int c) { const int st = (r >> 4) * 2 + (c >> 5), rr = r & 15, cc = c & 31, ob = rr * 64 + cc * 2; return st * 1024 + (ob ^ (((ob >> 9) & 1) << 5)); }
__host__ __device__ __forceinline__ void stage_rc(int b, int& R, int& C) { const int st = b / 1024, sb = b % 1024, swz = sb ^ (((sb >> 9) & 1) << 5); R = (st >> 1) * 16 + swz / 64; C = (st & 1) * 32 + (swz % 64) / 2; }
__host__ __device__ __forceinline__ int perm32(int rho) { const int n = rho >> 4, i = rho & 15; return 8 * (i >> 2) + 4 * n + (i & 3); }

struct Unit { int pm, pn, z; };
struct Gemm { const bf16_t* A; const bf16_t* Bt; int M, N, K, lda, ldb; size_t za, zb; };

struct Order {
    int nM, nN, nZ, nwg, G, c;
    __device__ void init(int M, int N, int nZ_, int G_, int c_) { nM = M / BM; nN = N / BM; nZ = nZ_; nwg = nM * nN; G = G_; c = c_; }
    __device__ bool next(int i, Unit& u) const {
        const int ti = i / nZ; u.z = i - ti * nZ;
        const long L = (long)ti * G + c; if (L >= nwg) return false;
        int wgid = (int)L; { const int q = nwg / NXCD, r = nwg % NXCD, xcd = wgid % NXCD, off = wgid / NXCD; wgid = (xcd < r ? xcd * (q + 1) : r * (q + 1) + (xcd - r) * q) + off; }
        const int nig = WGM * nN, gid = wgid / nig, fm = gid * WGM, gsz = (nM - fm) < WGM ? (nM - fm) : WGM;
        u.pm = fm + ((wgid % nig) % gsz); u.pn = (wgid % nig) / gsz; return true;
    }
};

template <class Epi>
__device__ __forceinline__ void gemm_phase(LAS unsigned char* lds, const Gemm g, const Order& S, const Epi& E) {
    int tid = threadIdx.x; asm volatile("" : "+v"(tid));
    const int wid = __builtin_amdgcn_readfirstlane(tid >> 6), lane = tid & 63, wr = wid >> 2, wc = wid & 3, fr = lane & 15, fq = lane >> 4;
    const int K = g.K, nt = K / BK;
    unsigned voffA[2], voffB[2];
#pragma unroll
    for (int i = 0; i < 2; ++i) { int R, C; stage_rc(tid * 16 + i * 8192, R, C); const int Rb = Epi::PERM ? ((R & ~31) + perm32(R & 31)) : R;
        voffA[i] = (unsigned)(R * g.lda + C) * 2u; voffB[i] = (unsigned)(Rb * g.ldb + C) * 2u; }
    const size_t kstep = (size_t)(BK * 2);
    const size_t hstepA = (size_t)HALF * g.lda * 2, hstepB = (size_t)HALF * g.ldb * 2;
    const unsigned ldsw = (unsigned)wid * 1024u;
    const int aoff = lds_byte(wr * 64 + fr, fq * 8), boff = lds_byte(wc * 32 + fr, fq * 8);
#define PG8_SA(b, h) (((b) * 2 + (h)) * HTB)
#define PG8_SB(b, h) ((4 + (b) * 2 + (h)) * HTB)
#define PG8_STAGE(bufoff, gbase, voff) do { _Pragma("unroll") for (int _i = 0; _i < 2; ++_i) \
        __builtin_amdgcn_global_load_lds((const unsigned*)((const char*)(gbase) + (voff)[_i]), (LAS unsigned*)(lds + (bufoff) + ldsw + _i * 8192), 16, 0, 0); } while (0)
#define PG8_LDA(dst, b, h) do { _Pragma("unroll") for (int m = 0; m < 4; ++m) _Pragma("unroll") for (int k = 0; k < 2; ++k) dst[m][k] = *(const LAS bf16x8*)(lds + PG8_SA(b, h) + aoff + m * 2048 + k * 1024); } while (0)
#define PG8_LDB(dst, b, h) do { _Pragma("unroll") for (int n = 0; n < 2; ++n) _Pragma("unroll") for (int k = 0; k < 2; ++k) dst[n][k] = *(const LAS bf16x8*)(lds + PG8_SB(b, h) + boff + n * 2048 + k * 1024); } while (0)
#define PG8_MMA(ai, bj, At, Bt) do { __builtin_amdgcn_s_setprio(1); _Pragma("unroll") for (int m = 0; m < 4; ++m) _Pragma("unroll") for (int n = 0; n < 2; ++n) _Pragma("unroll") for (int k = 0; k < 2; ++k) \
        acc[ai][bj][m][n] = __builtin_amdgcn_mfma_f32_16x16x32_bf16(Bt[n][k], At[m][k], acc[ai][bj][m][n], 0, 0, 0); __builtin_amdgcn_s_setprio(0); } while (0)
#define PG8_WAIT_V(n) asm volatile("s_waitcnt vmcnt(" #n ")" ::: "memory")
#define PG8_WAIT_L(n) asm volatile("s_waitcnt lgkmcnt(" #n ")" ::: "memory")
#define PG8_BAR __builtin_amdgcn_s_barrier()
#define PG8_SCHED __builtin_amdgcn_sched_barrier(0)
    Unit cur, nxt; int ui = 0;
    if (!S.next(0, cur)) return;
    f32x4 acc[2][2][4][2];
#pragma unroll
    for (int a = 0; a < 2; ++a)
#pragma unroll
        for (int b = 0; b < 2; ++b)
#pragma unroll
            for (int m = 0; m < 4; ++m)
#pragma unroll
                for (int n = 0; n < 2; ++n) acc[a][b][m][n] = (f32x4){0.f, 0.f, 0.f, 0.f};
    bf16x8 At[4][2], B0[2][2], B1[2][2];
    const char* cA = (const char*)(g.A + (size_t)cur.pm * BM * g.lda + (size_t)cur.z * g.za);
    const char* cB = (const char*)(g.Bt + (size_t)cur.pn * BM * g.ldb + (size_t)cur.z * g.zb);
    constexpr bool ALIGN_EPI = Epi::ALIGN && !Epi::AFTER_DRAIN;
    PG8_STAGE(PG8_SB(0, 0), cB, voffB); PG8_STAGE(PG8_SB(0, 1), cB + hstepB, voffB); PG8_STAGE(PG8_SA(0, 0), cA, voffA); PG8_STAGE(PG8_SA(0, 1), cA + hstepA, voffA);
    if (wr == 1) PG8_BAR;
    PG8_WAIT_V(2); PG8_BAR;
    PG8_STAGE(PG8_SB(1, 0), cB + kstep, voffB); PG8_STAGE(PG8_SA(1, 0), cA + kstep, voffA); PG8_STAGE(PG8_SB(1, 1), cB + hstepB + kstep, voffB);
    PG8_WAIT_V(6); PG8_BAR;
    for (;;) {
        const bool has_next = S.next(ui + 1, nxt);
        const char* nA = has_next ? (const char*)(g.A + (size_t)nxt.pm * BM * g.lda + (size_t)nxt.z * g.za) : cA;
        const char* nB = has_next ? (const char*)(g.Bt + (size_t)nxt.pn * BM * g.ldb + (size_t)nxt.z * g.zb) : cB;
        for (int t = 0; t < nt; t += 2) {
            const bool last = (t == nt - 2);
            const char* a1 = cA + (size_t)(t + 1) * kstep;
            const char* a2 = last ? nA : cA + (size_t)(t + 2) * kstep; const char* b2 = last ? nB : cB + (size_t)(t + 2) * kstep;
            const char* a3 = a2 + kstep; const char* b3 = b2 + kstep;
            PG8_LDB(B0, 0, 0); PG8_LDB(B1, 0, 1); PG8_SCHED; PG8_LDA(At, 0, 0); PG8_STAGE(PG8_SA(1, 1), a1 + hstepA, voffA);
            PG8_WAIT_V(8); PG8_WAIT_L(0); PG8_BAR; PG8_MMA(0, 0, At, B0); PG8_MMA(0, 1, At, B1); PG8_BAR; PG8_SCHED;
            PG8_LDA(At, 0, 1); PG8_STAGE(PG8_SB(0, 0), b2, voffB); PG8_STAGE(PG8_SB(0, 1), b2 + hstepB, voffB); PG8_STAGE(PG8_SA(0, 0), a2, voffA);
            PG8_WAIT_V(8); PG8_WAIT_L(0); PG8_BAR; PG8_MMA(1, 0, At, B0); PG8_MMA(1, 1, At, B1); PG8_BAR; PG8_SCHED;
            PG8_LDB(B0, 1, 0); PG8_LDB(B1, 1, 1); PG8_SCHED; PG8_LDA(At, 1, 0); PG8_STAGE(PG8_SA(0, 1), a2 + hstepA, voffA);
            PG8_WAIT_V(8); PG8_WAIT_L(0); PG8_BAR; PG8_MMA(0, 0, At, B0); PG8_MMA(0, 1, At, B1); PG8_BAR; PG8_SCHED;
            PG8_LDA(At, 1, 1); PG8_STAGE(PG8_SB(1, 0), b3, voffB); PG8_STAGE(PG8_SB(1, 1), b3 + hstepB, voffB); PG8_STAGE(PG8_SA(1, 0), a3, voffA);
            PG8_WAIT_V(8); PG8_WAIT_L(0); PG8_BAR; PG8_MMA(1, 0, At, B0); PG8_MMA(1, 1, At, B1); PG8_BAR; PG8_SCHED;
        }
        if constexpr (ALIGN_EPI) { if (wr == 0) PG8_BAR; }
        if constexpr (!Epi::AFTER_DRAIN) E(acc, cur, wr, wc, fr, fq);
        if (!has_next) break;
        if (!(Epi::KEEP_ACC && nxt.z != 0)) {
#pragma unroll
        for (int a = 0; a < 2; ++a)
#pragma unroll
            for (int b = 0; b < 2; ++b)
#pragma unroll
                for (int m = 0; m < 4; ++m)
#pragma unroll
                    for (int n = 0; n < 2; ++n) acc[a][b][m][n] = (f32x4){0.f, 0.f, 0.f, 0.f};
        }
        cur = nxt; cA = nA; cB = nB; ++ui;
        if constexpr (ALIGN_EPI) { if (wr == 1) PG8_BAR; }
    }
    PG8_WAIT_V(0);
    if constexpr (!ALIGN_EPI) { if (wr == 0) PG8_BAR; }
    PG8_BAR;
    if constexpr (Epi::AFTER_DRAIN) E.fused(acc, cur, wr, wc, fr, fq, lds, wid, lane);
#undef PG8_SA
#undef PG8_SB
#undef PG8_STAGE
#undef PG8_LDA
#undef PG8_LDB
#undef PG8_MMA
#undef PG8_WAIT_V
#undef PG8_WAIT_L
#undef PG8_BAR
#undef PG8_SCHED
}

struct EpiSwiglu {
    static constexpr bool PERM = true, AFTER_DRAIN = false, KEEP_ACC = false, ALIGN = true;
    bf16_t* O; int ldc;
    __device__ __forceinline__ void operator()(const f32x4 (&acc)[2][2][4][2], const Unit& u, int wr, int wc, int fr, int fq) const {
        const int row0 = u.pm * BM + wr * 64 + fr, col0 = u.pn * HALF + wc * 32 + 8 * fq;
#pragma unroll
        for (int ai = 0; ai < 2; ++ai)
#pragma unroll
            for (int m = 0; m < 4; ++m) {
                bf16_t* rowp = O + (size_t)(row0 + ai * HALF + m * 16) * ldc + col0;
                float r[8];
#pragma unroll
                for (int n = 0; n < 2; ++n)
#pragma unroll
                    for (int j = 0; j < 4; ++j) { const float gv = acc[ai][0][m][n][j], uv = acc[ai][1][m][n][j]; r[n * 4 + j] = gv * uv * fast_rcp(1.0f + fast_exp2(-gv)); }
                u32x4 w; w.x = cvt_pk_bf16(r[0], r[1]); w.y = cvt_pk_bf16(r[2], r[3]); w.z = cvt_pk_bf16(r[4], r[5]); w.w = cvt_pk_bf16(r[6], r[7]);
                *(u32x4*)rowp = w;
            }
    }
};
struct EpiResidLN {
    static constexpr bool PERM = true, AFTER_DRAIN = true, KEEP_ACC = false, ALIGN = false;
    float* xout; bf16_t* X16; bf16_t* XB; const float* gam; const float* bet; float beta;
    unsigned long long* xbuf; unsigned* cnt; unsigned want;
    __device__ __forceinline__ void fused(f32x4 (&acc)[2][2][4][2], const Unit& u, int wr, int wc, int fr, int fq, LAS unsigned char* lds, int wid, int lane) const {
        LAS f32x2* P = (LAS f32x2*)lds;
        LAS f32x2* S = (LAS f32x2*)(lds + 8192);
        const int row0 = u.pm * BM + wr * 64 + fr, col0 = u.pn * BM + wc * 32 + 8 * fq;
        {
            u32x4 hw[2][2];
#pragma unroll
            for (int bj = 0; bj < 2; ++bj) hw[0][bj] = *(const u32x4*)(X16 + (size_t)row0 * D + col0 + bj * HALF);
#pragma unroll
            for (int gi = 0; gi < 8; ++gi) {
                const int ai = gi >> 2, m = gi & 3;
                if (gi + 1 < 8) { const int ai1 = (gi + 1) >> 2, m1 = (gi + 1) & 3;
#pragma unroll
                    for (int bj = 0; bj < 2; ++bj) hw[(gi + 1) & 1][bj] = *(const u32x4*)(X16 + (size_t)(row0 + ai1 * HALF + m1 * 16) * D + col0 + bj * HALF); }
                asm volatile("" ::: "memory");
#pragma unroll
                for (int bj = 0; bj < 2; ++bj) { const u32x4 h = hw[gi & 1][bj];
                    const f32x4 x0 = (f32x4){h_lo(h.x), h_hi(h.x), h_lo(h.y), h_hi(h.y)}, x1 = (f32x4){h_lo(h.z), h_hi(h.z), h_lo(h.w), h_hi(h.w)};
                    acc[ai][bj][m][0] = x0 * ALPHA + acc[ai][bj][m][0] * beta; acc[ai][bj][m][1] = x1 * ALPHA + acc[ai][bj][m][1] * beta; }
                asm volatile("" : "+v"(acc[ai][0][m][0]), "+v"(acc[ai][0][m][1]), "+v"(acc[ai][1][m][0]), "+v"(acc[ai][1][m][1]));
            }
        }
#pragma unroll
        for (int ai = 0; ai < 2; ++ai)
#pragma unroll
            for (int m = 0; m < 4; ++m) {
                float s = 0.f;
#pragma unroll
                for (int bj = 0; bj < 2; ++bj)
#pragma unroll
                    for (int n = 0; n < 2; ++n) { const f32x4 x = acc[ai][bj][m][n]; s += (x[0] + x[1]) + (x[2] + x[3]); }
                s = rowgrp_sum(s);
                const float mw = s * (1.0f / 64.0f); float q = 0.f;
#pragma unroll
                for (int bj = 0; bj < 2; ++bj)
#pragma unroll
                    for (int n = 0; n < 2; ++n) { const f32x4 d = acc[ai][bj][m][n] - mw; q += (d[0] * d[0] + d[1] * d[1]) + (d[2] * d[2] + d[3] * d[3]); }
                q = rowgrp_sum(q);
                if (fq == 0) P[(ai * HALF + wr * 64 + m * 16 + fr) * 4 + wc] = (f32x2){mw, q};
            }
        asm volatile("s_waitcnt lgkmcnt(0)" ::: "memory"); __builtin_amdgcn_s_barrier(); asm volatile("" ::: "memory");
        const int row = wid * 32 + (lane & 31);
        if (lane < 32) {
            const f32x2 a = P[row * 4 + 0], b = P[row * 4 + 1], c = P[row * 4 + 2], d = P[row * 4 + 3];
            const float mt = (a.x + b.x + c.x + d.x) * 0.25f;
            const float da = a.x - mt, db = b.x - mt, dc = c.x - mt, dd = d.x - mt;
            const float m2 = (a.y + b.y) + (c.y + d.y) + 64.0f * ((da * da + db * db) + (dc * dc + dd * dd));
            unsigned long long* slot = xbuf + ((size_t)((u.pm & 63) * BM + row) * 4 + u.pn);
            __hip_atomic_store(slot, ((unsigned long long)__float_as_uint(m2) << 32) | __float_as_uint(mt), __ATOMIC_RELAXED, __HIP_MEMORY_SCOPE_AGENT);
        }
        asm volatile("s_waitcnt vmcnt(0)" ::: "memory");
        if (lane == 0) __hip_atomic_fetch_add(cnt + 64 * (u.pm & 63), 1u, __ATOMIC_RELAXED, __HIP_MEMORY_SCOPE_AGENT);
        if (wid == 0) {
            unsigned spins = 0;
            while ((unsigned)__builtin_amdgcn_readfirstlane(__hip_atomic_load(cnt + 64 * (u.pm & 63), __ATOMIC_RELAXED, __HIP_MEMORY_SCOPE_AGENT)) < want) { __builtin_amdgcn_s_sleep(2); if (++spins > (1u << 22)) break; }
            __builtin_amdgcn_fence(__ATOMIC_ACQUIRE, "agent");
        }
        asm volatile("s_waitcnt vmcnt(0) lgkmcnt(0)" ::: "memory"); __builtin_amdgcn_s_barrier(); asm volatile("" ::: "memory");
        if (lane < 32) {
            const unsigned long long* slot = xbuf + (size_t)((u.pm & 63) * BM + row) * 4; float mt[4], m2[4]; float ms = 0.f;
#pragma unroll
            for (int t = 0; t < 4; ++t) { const unsigned long long w = __hip_atomic_load(slot + t, __ATOMIC_RELAXED, __HIP_MEMORY_SCOPE_AGENT); mt[t] = __uint_as_float((unsigned)w); m2[t] = __uint_as_float((unsigned)(w >> 32)); ms += mt[t]; }
            const float mean = ms * 0.25f; float q = 0.f;
#pragma unroll
            for (int t = 0; t < 4; ++t) { const float dm = mt[t] - mean; q += m2[t] + 256.0f * dm * dm; }
            S[row] = (f32x2){mean, 1.0f / sqrtf(q * (1.0f / 1024.0f) + LN_EPS)};
        }
        asm volatile("s_waitcnt lgkmcnt(0)" ::: "memory"); __builtin_amdgcn_s_barrier(); asm volatile("" ::: "memory");
        f32x4 gv[2][2], bv[2][2];
#pragma unroll
        for (int bj = 0; bj < 2; ++bj)
#pragma unroll
            for (int n = 0; n < 2; ++n) { gv[bj][n] = *(const f32x4*)(gam + col0 + bj * HALF + 4 * n); bv[bj][n] = *(const f32x4*)(bet + col0 + bj * HALF + 4 * n); }
#pragma unroll
        for (int ai = 0; ai < 2; ++ai)
#pragma unroll
            for (int m = 0; m < 4; ++m) { const int r = ai * HALF + wr * 64 + m * 16 + fr; const f32x2 sr = S[r]; const size_t off = (size_t)(u.pm * BM + r) * D + col0;
#pragma unroll
                for (int bj = 0; bj < 2; ++bj) {
                    const f32x4 y0 = (acc[ai][bj][m][0] - sr.x) * sr.y * gv[bj][0] + bv[bj][0], y1 = (acc[ai][bj][m][1] - sr.x) * sr.y * gv[bj][1] + bv[bj][1];
                    if (xout) { *(f32x4*)(xout + off + bj * HALF) = y0; *(f32x4*)(xout + off + bj * HALF + 4) = y1; }
                    else { u32x4 hw; hw.x = cvt_pk_h(y0[0], y0[1]); hw.y = cvt_pk_h(y0[2], y0[3]); hw.z = cvt_pk_h(y1[0], y1[1]); hw.w = cvt_pk_h(y1[2], y1[3]); *(u32x4*)(X16 + off + bj * HALF) = hw;
                        u32x4 w; w.x = cvt_pk_bf16(y0[0], y0[1]); w.y = cvt_pk_bf16(y0[2], y0[3]); w.z = cvt_pk_bf16(y1[0], y1[1]); w.w = cvt_pk_bf16(y1[2], y1[3]); *(u32x4*)(XB + off + bj * HALF) = w; } }
                asm volatile("" ::: "memory"); }
    }
};
struct EpiInproj {
    static constexpr bool PERM = true, AFTER_DRAIN = false, KEEP_ACC = false, ALIGN = true;
    bf16_t* P; bf16_t* G;
    __device__ __forceinline__ void operator()(const f32x4 (&acc)[2][2][4][2], const Unit& u, int wr, int wc, int fr, int fq) const {
        const bool isg = u.pn >= 11;
        bf16_t* base = isg ? G : P; const int ldc = isg ? GATEC : PROJC; const int colt = isg ? (u.pn - 11) * BM : u.pn * BM;
        const int row0 = u.pm * BM + wr * 64 + fr, col0 = colt + wc * 32 + 8 * fq;
#pragma unroll
        for (int ai = 0; ai < 2; ++ai)
#pragma unroll
            for (int m = 0; m < 4; ++m) { bf16_t* rowp = base + (size_t)(row0 + ai * HALF + m * 16) * ldc + col0;
#pragma unroll
                for (int bj = 0; bj < 2; ++bj) { f32x4 v0 = acc[ai][bj][m][0], v1 = acc[ai][bj][m][1];
                    if (isg) {
#pragma unroll
                        for (int j = 0; j < 4; ++j) { v0[j] = fmaxf(sigmoidf_fast(v0[j]), 1e-30f); v1[j] = fmaxf(sigmoidf_fast(v1[j]), 1e-30f); } }
                    u32x4 w; w.x = cvt_pk_bf16(v0[0], v0[1]); w.y = cvt_pk_bf16(v0[2], v0[3]); w.z = cvt_pk_bf16(v1[0], v1[1]); w.w = cvt_pk_bf16(v1[2], v1[3]);
                    *(u32x4*)(rowp + bj * HALF) = w; } }
    }
};
struct EpiBf16Plain {
    static constexpr bool PERM = true, AFTER_DRAIN = false, KEEP_ACC = false, ALIGN = true;
    bf16_t* O; int ldc;
    __device__ __forceinline__ void operator()(const f32x4 (&acc)[2][2][4][2], const Unit& u, int wr, int wc, int fr, int fq) const {
        const int row0 = u.pm * BM + wr * 64 + fr, col0 = u.pn * BM + wc * 32 + 8 * fq;
#pragma unroll
        for (int ai = 0; ai < 2; ++ai)
#pragma unroll
            for (int m = 0; m < 4; ++m) { bf16_t* rowp = O + (size_t)(row0 + ai * HALF + m * 16) * ldc + col0;
#pragma unroll
                for (int bj = 0; bj < 2; ++bj) { const f32x4 v0 = acc[ai][bj][m][0], v1 = acc[ai][bj][m][1];
                    u32x4 w; w.x = cvt_pk_bf16(v0[0], v0[1]); w.y = cvt_pk_bf16(v0[2], v0[3]); w.z = cvt_pk_bf16(v1[0], v1[1]); w.w = cvt_pk_bf16(v1[2], v1[3]);
                    *(u32x4*)(rowp + bj * HALF) = w; } }
    }
};
struct EpiBranch {
    static constexpr bool PERM = true, AFTER_DRAIN = false, KEEP_ACC = true, ALIGN = true;
    const bf16_t* G; bf16_t* O;
    __device__ __forceinline__ void operator()(f32x4 (&acc)[2][2][4][2], const Unit& u, int wr, int wc, int fr, int fq) const {
        const int row0 = u.pm * BM + wr * 64 + fr, col0 = u.pn * BM + wc * 32 + 8 * fq;
        const bool mid = u.z < 2;
        const bf16_t* g0p = G + (size_t)u.z * D + col0; const bf16_t* g1p = G + (size_t)(mid ? u.z + 1 : u.z) * D + col0;
        u32x4 gq[2][2][2];
#pragma unroll
        for (int bj = 0; bj < 2; ++bj) { gq[0][bj][0] = *(const u32x4*)(g0p + (size_t)row0 * GATEC + bj * HALF); gq[0][bj][1] = *(const u32x4*)(g1p + (size_t)row0 * GATEC + bj * HALF); }
#pragma unroll
        for (int gi = 0; gi < 8; ++gi) {
            const int ai = gi >> 2, m = gi & 3; const size_t row = (size_t)(row0 + ai * HALF + m * 16);
            if (gi + 1 < 8) { const size_t row1 = (size_t)(row0 + ((gi + 1) >> 2) * HALF + ((gi + 1) & 3) * 16);
#pragma unroll
                for (int bj = 0; bj < 2; ++bj) { gq[(gi + 1) & 1][bj][0] = *(const u32x4*)(g0p + row1 * GATEC + bj * HALF); gq[(gi + 1) & 1][bj][1] = *(const u32x4*)(g1p + row1 * GATEC + bj * HALF); } }
            asm volatile("" ::: "memory");
#pragma unroll
            for (int bj = 0; bj < 2; ++bj) {
                const int col = col0 + bj * HALF;
                const u32x4 gw = gq[gi & 1][bj][0];
                f32x4 g0 = (f32x4){bf_lo(gw.x), bf_hi(gw.x), bf_lo(gw.y), bf_hi(gw.y)}, g1 = (f32x4){bf_lo(gw.z), bf_hi(gw.z), bf_lo(gw.w), bf_hi(gw.w)};
                if (mid) {
                    const u32x4 nw = gq[gi & 1][bj][1];
#pragma unroll
                    for (int j = 0; j < 2; ++j) { const unsigned a = j == 0 ? nw.x : nw.y, b = j == 0 ? nw.z : nw.w;
                        g0[2 * j] *= fast_rcp(bf_lo(a)); g0[2 * j + 1] *= fast_rcp(bf_hi(a)); g1[2 * j] *= fast_rcp(bf_lo(b)); g1[2 * j + 1] *= fast_rcp(bf_hi(b)); }
                    acc[ai][bj][m][0] *= g0; acc[ai][bj][m][1] *= g1;
                } else {
                    const f32x4 v0 = g0 * acc[ai][bj][m][0], v1 = g1 * acc[ai][bj][m][1];
                    u32x4 w; w.x = cvt_pk_bf16(v0[0], v0[1]); w.y = cvt_pk_bf16(v0[2], v0[3]); w.z = cvt_pk_bf16(v1[0], v1[1]); w.w = cvt_pk_bf16(v1[2], v1[3]);
                    *(u32x4*)(O + row * D + col) = w; }
            }
            asm volatile("" : "+v"(acc[ai][0][m][0]), "+v"(acc[ai][0][m][1]), "+v"(acc[ai][1][m][0]), "+v"(acc[ai][1][m][1]));
        }
    }
};
}

__device__ __forceinline__ void tr_item(const float* W, int ldw, bf16_t* WT, int ldt, int k0, int n0, int c0, float scale, LAS float* scr, int lane) {
    float wv[32];
#pragma unroll
    for (int i = 0; i < 32; ++i) wv[i] = W[(size_t)(k0 + 2 * i + (lane >> 5)) * ldw + c0 + (lane & 31)];
#pragma unroll
    for (int i = 0; i < 32; ++i) scr[(2 * i + (lane >> 5)) * 33 + (lane & 31)] = wv[i];
    asm volatile("s_waitcnt lgkmcnt(0)" ::: "memory");
    const int c = lane & 7;
#pragma unroll
    for (int j = 0; j < 4; ++j) { const int n = (lane >> 3) + 8 * j; const LAS float* sp = scr + (8 * c) * 33 + n;
        u32x4 o; o.x = cvt_pk_bf16(sp[0 * 33] * scale, sp[1 * 33] * scale); o.y = cvt_pk_bf16(sp[2 * 33] * scale, sp[3 * 33] * scale);
        o.z = cvt_pk_bf16(sp[4 * 33] * scale, sp[5 * 33] * scale); o.w = cvt_pk_bf16(sp[6 * 33] * scale, sp[7 * 33] * scale);
        *(u32x4*)(WT + (size_t)(n0 + n) * ldt + k0 + 8 * c) = o; }
    asm volatile("s_waitcnt lgkmcnt(0)" ::: "memory");
}
template <int MODE>
__device__ __forceinline__ void tr_matrix(const float* W, int K, int N, int ldw, bf16_t* WT, int ldt, LAS float* scr, int gw, int ngw, int lane) {
    const int nblk = N / 32, nitems = (K / 64) * nblk;
    for (int it = gw; it < nitems; it += ngw) {
        const int kb = it / nblk, nb = it - kb * nblk, n0 = nb * 32; int c0 = n0; float scale = 1.f;
        if (MODE == 1) { const int tile = n0 >> 8, bj = (n0 >> 7) & 1, c = n0 & 127; c0 = bj * DFF + tile * 128 + c; scale = bj ? 0.6931471805599453f : LOG2E; }
        if (MODE == 2) { if (n0 < 512 || (n0 >= 768 && n0 < 1280)) scale = 0.125f * LOG2E; else if (n0 >= 2304 && n0 < 2816) scale = 0.08838834764831845f * LOG2E; }
        tr_item(W, ldw, WT, ldt, kb * 64, n0, c0, scale, scr, lane);
    }
}

struct AttnP {
    const bf16_t *q, *k, *v; bf16_t* o; float* lse;
    int q_rs, q_toff, kv_rs, o_rs, o_toff, lse_rs, lse_toff;
    int qpos0, qpos_tstep, k_lo, nsteps, sub_len, radius;
    float slope2, slope_tmul;
    float sink2[4];
};
__device__ __forceinline__ s16x4 vtr(const LAS unsigned char* p) {
    typedef short v4i16_t __attribute__((ext_vector_type(4)));
    return __builtin_bit_cast(s16x4, __builtin_amdgcn_ds_read_tr16_b64_v4i16((LAS v4i16_t*)p));
}
template <int DH, int NT, int MODE>
__device__ __forceinline__ void attn_item(const AttnP& P, LAS unsigned char* vl, int lane_in, const LAS unsigned char* kl = nullptr) {
    int lane = lane_in; asm volatile("" : "+v"(lane));
    constexpr bool MASK = MODE < 2, SINK = MODE == 0, LSE = MODE == 1, INLDS = MODE == 3;
    constexpr int NSTEPS = MODE == 0 ? 9 : (MODE == 1 ? 6 : 8), QTSTEP = MODE == 1 ? 16 : 0;
    constexpr float RADF = MODE == 0 ? 128.f : 64.f, SLOPE_TMUL = MODE == 0 ? 0.5f : 1.0f;
    constexpr int KS = DH / 32, ND = DH / 16, VP = DH * 2 + 32, NVL = DH / 16;
    const int fr = lane & 15, g = lane >> 4;
    bf16x8 qf[NT][KS];
#pragma unroll
    for (int i = 0; i < NT; ++i)
#pragma unroll
        for (int ks = 0; ks < KS; ++ks) qf[i][ks] = *(const bf16x8*)(P.q + (size_t)i * P.q_toff + (size_t)fr * P.q_rs + ks * 32 + g * 8);
    f32x4 o[NT][ND]; float mrun[NT], lrun[NT];
#pragma unroll
    for (int i = 0; i < NT; ++i) {
#pragma unroll
        for (int d = 0; d < ND; ++d) o[i][d] = (f32x4){0.f, 0.f, 0.f, 0.f};
        mrun[i] = SINK ? P.sink2[i] : -1e30f; lrun[i] = (SINK && g == 0) ? 1.f : 0.f; }
    bf16x8 kf[2][KS]; u32x4 vr[NVL];
    constexpr int CPR = DH / 8;
    const int kmax = P.sub_len - 1, klo = P.k_lo, kvrs = P.kv_rs;
    const bf16_t* kbase = P.k + g * 8; const bf16_t* vbase = P.v;
    if (!INLDS) {
#pragma unroll
        for (int a = 0; a < 2; ++a) { int kp = klo + 16 * a + fr; kp = kp < 0 ? 0 : (kp > kmax ? kmax : kp);
#pragma unroll
            for (int ks = 0; ks < KS; ++ks) kf[a][ks] = *(const bf16x8*)(kbase + (size_t)kp * kvrs + ks * 32); }
#pragma unroll
        for (int it = 0; it < NVL; ++it) { const int idx = it * 64 + lane, r = idx / CPR, ch = idx % CPR; int kp = klo + r; kp = kp < 0 ? 0 : (kp > kmax ? kmax : kp);
            vr[it] = *(const u32x4*)(vbase + (size_t)kp * kvrs + ch * 8); }
    }
    const LAS unsigned char* vrd = vl + (4 * g + (fr >> 2)) * VP + 8 * (fr & 3);
    const float qbase = (float)(4 * g - P.qpos0 - fr);
    for (int s = 0; s < NSTEPS; ++s) {
        const int k0 = klo + 32 * s;
        asm volatile("" ::: "memory");
        bf16x8 kc[2][KS];
        if (INLDS) {
#pragma unroll
            for (int a = 0; a < 2; ++a)
#pragma unroll
                for (int ks = 0; ks < KS; ++ks) kc[a][ks] = *(const LAS bf16x8*)(kl + (32 * s + 16 * a + fr) * VP + (ks * 32 + 8 * g) * 2);
        } else {
#pragma unroll
        for (int it = 0; it < NVL; ++it) { const int idx = it * 64 + lane, r = idx / CPR, ch = idx % CPR; *(LAS u32x4*)(vl + r * VP + ch * 16) = vr[it]; }
#pragma unroll
        for (int a = 0; a < 2; ++a)
#pragma unroll
            for (int ks = 0; ks < KS; ++ks) kc[a][ks] = kf[a][ks];
        }
        if (!INLDS && s + 1 < NSTEPS) {
            const int k1 = k0 + 32;
#pragma unroll
            for (int a = 0; a < 2; ++a) { int kp = k1 + 16 * a + fr; kp = kp < 0 ? 0 : (kp > kmax ? kmax : kp);
#pragma unroll
                for (int ks = 0; ks < KS; ++ks) kf[a][ks] = *(const bf16x8*)(kbase + (size_t)kp * kvrs + ks * 32); }
#pragma unroll
            for (int it = 0; it < NVL; ++it) { const int idx = it * 64 + lane, r = idx / CPR, ch = idx % CPR; int kp = k1 + r; kp = kp < 0 ? 0 : (kp > kmax ? kmax : kp);
                vr[it] = *(const u32x4*)(vbase + (size_t)kp * kvrs + ch * 8); }
        }
        asm volatile("s_waitcnt lgkmcnt(0)" ::: "memory");
        const bool edge = (k0 < 0) || (k0 + 31 > kmax);
        const float kf0 = (float)k0 + qbase;
        float koff[2][4];
#pragma unroll
        for (int a = 0; a < 2; ++a)
#pragma unroll
            for (int r = 0; r < 4; ++r) { koff[a][r] = (float)(16 * a + r); if (MASK && edge) { const int kp = k0 + 16 * a + 4 * g + r; if (kp < 0 || kp > kmax) koff[a][r] = INFINITY; } }
        bf16x8 pf[NT]; float alv[NT]; bool act[NT];
#pragma unroll
        for (int i = 0; i < NT; ++i) {
            act[i] = !(MODE == 1) || (s >= (i >> 1) && s <= (i >> 1) + 4);
            if (!act[i]) { alv[i] = 1.0f; continue; }
            f32x4 sc[2];
#pragma unroll
            for (int a = 0; a < 2; ++a) { sc[a] = (f32x4){0.f, 0.f, 0.f, 0.f};
#pragma unroll
                for (int ks = 0; ks < KS; ++ks) sc[a] = __builtin_amdgcn_mfma_f32_16x16x32_bf16(kc[a][ks], qf[i][ks], sc[a], 0, 0, 0); }
            if (MASK) {
                float slope = P.slope2;
#pragma unroll
                for (int t = 0; t < i; ++t) slope *= SLOPE_TMUL;
                const float base = kf0 - (float)(i * QTSTEP);
#pragma unroll
                for (int a = 0; a < 2; ++a)
#pragma unroll
                    for (int r = 0; r < 4; ++r) { const float ad = fabsf(base + koff[a][r]);
                        sc[a][r] = (ad <= RADF) ? fmaf(-slope, ad, sc[a][r]) : -INFINITY; }
            }
            float mx = fmaxf(fmaxf(fmaxf(sc[0][0], sc[0][1]), fmaxf(sc[0][2], sc[0][3])), fmaxf(fmaxf(sc[1][0], sc[1][1]), fmaxf(sc[1][2], sc[1][3])));
            mx = rowgrp_max(mx);
            const float mnew = fmaxf(mrun[i], mx); alv[i] = fast_exp2(mrun[i] - mnew);
            mrun[i] = mnew;
            float ps = 0.f;
#pragma unroll
            for (int a = 0; a < 2; ++a)
#pragma unroll
                for (int r = 0; r < 4; ++r) { const float p = fast_exp2(sc[a][r] - mnew); sc[a][r] = p; ps += p; }
            lrun[i] = lrun[i] * alv[i] + ps;
            union { bf16x8 v; unsigned u[4]; } pk;
            pk.u[0] = cvt_pk_bf16(sc[0][0], sc[0][1]); pk.u[1] = cvt_pk_bf16(sc[0][2], sc[0][3]); pk.u[2] = cvt_pk_bf16(sc[1][0], sc[1][1]); pk.u[3] = cvt_pk_bf16(sc[1][2], sc[1][3]);
            pf[i] = pk.v;
        }
        bool resc[NT];
#pragma unroll
        for (int i = 0; i < NT; ++i) resc[i] = act[i];
#pragma unroll
        for (int d = 0; d < ND; ++d) {
            const LAS unsigned char* vs = INLDS ? vrd + s * 32 * VP : vrd;
            const s16x4 lo = vtr(vs + d * 32), hi = vtr(vs + 16 * VP + d * 32);
            const bf16x8 vt = (bf16x8){lo[0], lo[1], lo[2], lo[3], hi[0], hi[1], hi[2], hi[3]};
#pragma unroll
            for (int i = 0; i < NT; ++i) { if (resc[i]) o[i][d] = o[i][d] * alv[i]; if (act[i]) o[i][d] = __builtin_amdgcn_mfma_f32_16x16x32_bf16(vt, pf[i], o[i][d], 0, 0, 0); }
        }
        asm volatile("" ::: "memory");
    }
#pragma unroll
    for (int i = 0; i < NT; ++i) {
        const float l = rowgrp_sum(lrun[i]);
        const float inv = 1.0f / l;
        bf16_t* orow = P.o + (size_t)i * P.o_toff + (size_t)fr * P.o_rs + 4 * g;
#pragma unroll
        for (int d = 0; d < ND; ++d) { u32x2 w; w.x = cvt_pk_bf16(o[i][d][0] * inv, o[i][d][1] * inv); w.y = cvt_pk_bf16(o[i][d][2] * inv, o[i][d][3] * inv); *(u32x2*)(orow + 16 * d) = w; }
        if (LSE) { if (g == 0) P.lse[(size_t)i * P.lse_toff + (size_t)fr * P.lse_rs] = mrun[i] + __log2f(l); }
    }
}

struct Args {
    const float* in[19];
    float* out; unsigned char* ws;
};

__global__ void __launch_bounds__(512, 2) mega_fwd(Args args) {
    extern __shared__ __attribute__((aligned(16))) unsigned char lds_raw[];
    LAS unsigned char* lds = (LAS unsigned char*)lds_raw;
    cg::grid_group grid = cg::this_grid();
    const int G = gridDim.x, bx = blockIdx.x;
    volatile LAS unsigned* MISC = (volatile LAS unsigned*)(lds + LDS_MISC);
    if (threadIdx.x < 32) MISC[threadIdx.x] = 0u;
    __syncthreads();
    grid.sync();
    const XcdBarrier bar = xcd_barrier_post((unsigned*)(args.ws + WS_CTL), MISC + 8);
    constexpr int PH_PER_CHUNK = NLAYER * 9, NPH = 2 + NCHUNK * PH_PER_CHUNK;
    for (int ph_i = 0; ph_i < NPH; ++ph_i) {
        int ph = ph_i; asm volatile("" : "+s"(ph));
        int lane = threadIdx.x & 63; asm volatile("" : "+v"(lane));
        const int wave = __builtin_amdgcn_readfirstlane(threadIdx.x >> 6);
        const int vcu = (G % 8 == 0) ? (bx % 8) * (G / 8) + bx / 8 : bx;
        const int gw = vcu * 8 + wave, NGW = G * 8;
        unsigned char* ws = args.ws;
        bf16_t* Wb = (bf16_t*)(ws + WS_W); bf16_t* Wmem = (bf16_t*)(ws + WS_WMEM); bf16_t* memb = (bf16_t*)(ws + WS_MEMB); bf16_t* memkv = (bf16_t*)(ws + WS_MEMKV);
        bf16_t* xb = (bf16_t*)(ws + WS_XB);
        bf16_t* hb = (bf16_t*)(ws + WS_U + U_H); bf16_t* proj = (bf16_t*)(ws + WS_U + U_PROJ); bf16_t* gates = (bf16_t*)(ws + WS_U + U_GATES); bf16_t* br = (bf16_t*)(ws + WS_U + U_BR);
        bf16_t* bpart = (bf16_t*)(ws + WS_U + U_BPART); float* lseb = (float*)(ws + WS_U + U_LSE); float* mixf = (float*)(ws + WS_U + U_MIXF); bf16_t* mixb = (bf16_t*)(ws + WS_U + U_MIXB);
        int load_chunk = -1;
        if (ph == 0) { for (int rep = 0; rep < REP_PRO; ++rep) {
            LAS float* scr = (LAS float*)(lds + wave * 16384);
            for (int l = 0; l < NLAYER; ++l) {
                bf16_t* WL = Wb + (size_t)l * W_LAYER_ELEMS;
                tr_matrix<1>(args.in[4] + (size_t)l * D * 2 * DFF, D, 2 * DFF, 2 * DFF, WL + OFF_W1IN, D, scr, gw, NGW, lane);
                tr_matrix<0>(args.in[5] + (size_t)l * DFF * D, DFF, D, D, WL + OFF_W1OUT, DFF, scr, gw, NGW, lane);
                tr_matrix<2>(args.in[8] + (size_t)l * D * INC, D, INC, INC, WL + OFF_WIN, D, scr, gw, NGW, lane);
                tr_matrix<0>(args.in[9] + (size_t)l * D * 1024, D, 1024, 1024, Wmem + (size_t)l * 1024 * D, D, scr, gw, NGW, lane);
                for (int i = 0; i < 3; ++i) tr_matrix<0>(args.in[11] + ((size_t)l * 3 + i) * 512 * D, 512, D, D, WL + OFF_WBR + (size_t)i * D * 512, 512, scr, gw, NGW, lane);
                tr_matrix<0>(args.in[12] + (size_t)l * D * D, D, D, D, WL + OFF_WOUT, D, scr, gw, NGW, lane);
                tr_matrix<1>(args.in[15] + (size_t)l * D * 2 * DFF, D, 2 * DFF, 2 * DFF, WL + OFF_W2IN, D, scr, gw, NGW, lane);
                tr_matrix<0>(args.in[16] + (size_t)l * DFF * D, DFF, D, D, WL + OFF_W2OUT, DFF, scr, gw, NGW, lane);
            }
            for (int m = gw; m < MEMROWS; m += NGW) {
                const float* src = (m < 4096) ? args.in[2] + (size_t)m * D : args.in[3] + (size_t)(m - 4096) * D;
#pragma unroll
                for (int j = 0; j < 4; ++j) { const f32x4 v = *((const f32x4*)src + lane + 64 * j); u32x2 w; w.x = cvt_pk_bf16(v[0], v[1]); w.y = cvt_pk_bf16(v[2], v[3]); *((u32x2*)(memb + (size_t)m * D) + lane + 64 * j) = w; }
            } }
            load_chunk = 0;
        } else if (ph == 1) {
            pg8::Gemm g{memb, Wmem, MEMROWS, 2048, D, D, D, 0, 0}; pg8::Order S; S.init(MEMROWS, 2048, 1, G, bx);
            pg8::EpiBf16Plain E{memkv, 2048};
            pg8::gemm_phase(lds, g, S, E);
        } else {
            const int q = ph - 2, c = q / PH_PER_CHUNK, r = q - c * PH_PER_CHUNK;
            const bool is_prompt = c < 2;
            float* X = args.out + (size_t)c * TC * D;
            const int L = is_prompt ? 2048 : 8192;
            {
                const int l = r / 9, k = r - l * 9;
                const bf16_t* WL = Wb + (size_t)l * W_LAYER_ELEMS;
                if (k == 0 || k == 7) {
                    pg8::Gemm g{xb, WL + (k == 0 ? OFF_W1IN : OFF_W2IN), TC, 2 * DFF, D, D, D, 0, 0}; pg8::Order S; S.init(TC, 2 * DFF, 1, G, bx); pg8::EpiSwiglu E{hb, DFF}; for (int rep = 0; rep < REP_UP; ++rep) pg8::gemm_phase(lds, g, S, E);
                    if (l == 0 && k == 0) {
                        const float* xin = is_prompt ? args.in[0] + (size_t)c * TC * D : args.in[1] + (size_t)(c - 2) * TC * D;
                        for (int m0 = gw; m0 < TC; m0 += 4 * NGW) {
                            f32x4 v[4][4];
#pragma unroll
                            for (int r = 0; r < 4; ++r) { const int mm = m0 + r * NGW; const size_t m = (size_t)(mm < TC ? mm : m0);
#pragma unroll
                                for (int j = 0; j < 4; ++j) v[r][j] = *((const f32x4*)(xin + m * D) + lane + 64 * j); }
#pragma unroll
                            for (int r = 0; r < 4; ++r) { const int mm = m0 + r * NGW; if (mm >= TC) continue;
#pragma unroll
                                for (int j = 0; j < 4; ++j) { u32x2 hw; hw.x = cvt_pk_h(v[r][j][0], v[r][j][1]); hw.y = cvt_pk_h(v[r][j][2], v[r][j][3]); *((u32x2*)((bf16_t*)(ws + WS_X16) + (size_t)mm * D) + lane + 64 * j) = hw; } }
                        }
                    }
                } else if (k == 1 || k == 8 || k == 6) {
                    const bool ffn = (k != 6); const int sidx = (k == 1) ? 0 : (k == 6 ? 1 : 2);
                    const bool last = (l == NLAYER - 1 && k == 8);
                    pg8::Gemm g{ffn ? hb : mixb, WL + (k == 1 ? OFF_W1OUT : (k == 8 ? OFF_W2OUT : OFF_WOUT)), TC, D, ffn ? DFF : D, ffn ? DFF : D, ffn ? DFF : D, 0, 0};
                    pg8::Order S; S.init(TC, D, 1, G, bx);
                    const int nuse = (c * NLAYER + l) * 3 + sidx;
                    pg8::EpiResidLN E{last ? X : nullptr, (bf16_t*)(ws + WS_X16), xb, args.in[sidx == 0 ? 6 : (sidx == 1 ? 13 : 17)] + l * D, args.in[sidx == 0 ? 7 : (sidx == 1 ? 14 : 18)] + l * D, ffn ? 0.5f : 1.0f,
                                      (unsigned long long*)(ws + WS_CTL + CTL_XBUF), (unsigned*)(ws + WS_CTL + 16384), 32u * (unsigned)(nuse + 1)};
                    pg8::gemm_phase(lds, g, S, E);
                    if (last && c + 1 < NCHUNK) load_chunk = c + 1;
                } else if (k == 2) {
                    pg8::Gemm g{xb, WL + OFF_WIN, TC, INC, D, D, D, 0, 0}; pg8::Order S; S.init(TC, INC, 1, G, bx); pg8::EpiInproj E{proj, gates}; for (int rep = 0; rep < REP_INPROJ; ++rep) pg8::gemm_phase(lds, g, S, E);
                } else if (k == 3) {
                    LAS unsigned char* vl = lds + wave * 9216;
                    const float* sink = args.in[10] + l * 8;
                    const int memrow0 = is_prompt ? c * 8 * NMEM : 4096 + (c - 2) * 2 * NMEM;
                    for (int rep = 0; rep < REP_ATT; ++rep) {
                    for (int u = vcu; u < 256; u += G) {
                        const int nqb = L / 256; const int qb = u % nqb, hh = (u / nqb) & 3, sq = u / (nqb * 4);
                        const bf16_t* mb = memkv + (size_t)(memrow0 + sq * NMEM) * 2048 + l * 1024 + hh * 128;
                        __syncthreads();
#pragma unroll 2
                        for (int j = 0; j < 8; ++j) { const int idx = j * 512 + (int)threadIdx.x, rrow = idx >> 4, pc = idx & 15;
                            const u32x4 kv = *(const u32x4*)(mb + (size_t)rrow * 2048 + pc * 8), vv = *(const u32x4*)(mb + 512 + (size_t)rrow * 2048 + pc * 8);
                            *(LAS u32x4*)(lds + rrow * 288 + pc * 16) = kv; *(LAS u32x4*)(lds + 73728 + rrow * 288 + pc * 16) = vv; }
                        __syncthreads();
                        AttnP P;
                        const int tok0 = sq * L + qb * 256 + wave * 32;
                        P.q = proj + (size_t)tok0 * PROJC + 2304 + hh * 128; P.q_rs = PROJC; P.q_toff = 16 * PROJC;
                        P.k = mb; P.v = mb + 512; P.kv_rs = 2048;
                        P.o = br + (size_t)tok0 * BRC + 1024 + hh * 128; P.o_rs = BRC; P.o_toff = 16 * BRC; P.lse = nullptr; P.lse_rs = 0; P.lse_toff = 0;
                        P.qpos0 = 0; P.qpos_tstep = 0; P.k_lo = 0; P.nsteps = 8; P.sub_len = NMEM; P.radius = 1 << 20;
                        P.slope2 = 0.f; P.slope_tmul = 1.f;
#pragma unroll
                        for (int i = 0; i < 4; ++i) P.sink2[i] = 0.f;
                        attn_item<128, 2, 3>(P, lds + 73728, lane, lds);
                    }
                    __syncthreads();
                    for (int it = gw; it < 4 * 2048; it += NGW) {
                        const int type = it >> 11, id = it & 2047;
                        AttnP P;
                        if (type == 0) {
                            const int hk = id & 1, tb = id >> 1; const int tok0 = tb * 16; const int sq = tok0 / L, pos0 = tok0 - sq * L;
                            const bf16_t* base = proj + (size_t)(sq * L) * PROJC;
                            P.q = proj + (size_t)tok0 * PROJC + hk * 256; P.q_rs = PROJC; P.q_toff = 64;
                            P.k = base + 512 + hk * 64; P.v = base + 512 + 128 + hk * 64; P.kv_rs = PROJC;
                            P.o = br + (size_t)tok0 * BRC + hk * 256; P.o_rs = BRC; P.o_toff = 64; P.lse = nullptr; P.lse_rs = 0; P.lse_toff = 0;
                            P.qpos0 = pos0; P.qpos_tstep = 0; P.k_lo = pos0 - 128; P.nsteps = 9; P.sub_len = L; P.radius = 128;
                            P.slope2 = LOG2E * exp2f(-(float)(hk * 4 + 1)); P.slope_tmul = 0.5f;
#pragma unroll
                            for (int i = 0; i < 4; ++i) P.sink2[i] = sink[hk * 4 + i] * LOG2E;
                            attn_item<64, 4, 0>(P, vl, lane);
                        } else {
                            const int cfg = type - 1, dil = cfg == 0 ? 1 : (cfg == 1 ? 4 : 16);
                            const int h = id & 7, blk = id >> 3;
                            const int sub_len = L / dil, bps = sub_len / 64;
                            const int sr = blk / bps, jb = blk - sr * bps; const int sq = sr / dil, rs = sr - sq * dil; const int j0 = jb * 64;
                            const bf16_t* base = proj + (size_t)(sq * L + rs) * PROJC + 768 + h * 64;
                            const size_t tok0 = (size_t)sq * L + rs + (size_t)j0 * dil;
                            P.q = proj + tok0 * PROJC + 768 + h * 64; P.q_rs = PROJC * dil; P.q_toff = 16 * PROJC * dil;
                            P.k = base + 512; P.v = base + 1024; P.kv_rs = PROJC * dil;
                            P.o = bpart + (size_t)cfg * TC * 512 + tok0 * 512 + h * 64; P.o_rs = 512 * dil; P.o_toff = 16 * 512 * dil;
                            P.lse = lseb + (size_t)cfg * TC * 8 + tok0 * 8 + h; P.lse_rs = 8 * dil; P.lse_toff = 16 * 8 * dil;
                            P.qpos0 = j0; P.qpos_tstep = 16; P.k_lo = j0 - 64; P.nsteps = 6; P.sub_len = sub_len; P.radius = 64;
                            P.slope2 = LOG2E * exp2f(-(float)(h + 1)) * (float)dil; P.slope_tmul = 1.0f;
#pragma unroll
                            for (int i = 0; i < 4; ++i) P.sink2[i] = 0.f;
                            attn_item<64, 4, 1>(P, vl, lane);
                        }
                    }
                    }
                } else if (k == 4) {
                    for (int rep = 0; rep < REP_CMB; ++rep) for (int m0 = gw; m0 < TC; m0 += 4 * NGW) {
                        const int h = lane >> 3;
                        float l0[4], l1[4], l2[4]; u32x4 a[4], b[4], cc[4];
#pragma unroll
                        for (int r = 0; r < 4; ++r) { const int mm = m0 + r * NGW; const size_t m = (size_t)(mm < TC ? mm : m0);
                            l0[r] = lseb[m * 8 + h]; l1[r] = lseb[(size_t)TC * 8 + m * 8 + h]; l2[r] = lseb[(size_t)2 * TC * 8 + m * 8 + h];
                            a[r] = *((const u32x4*)(bpart + m * 512) + lane); b[r] = *((const u32x4*)(bpart + (size_t)TC * 512 + m * 512) + lane); cc[r] = *((const u32x4*)(bpart + (size_t)2 * TC * 512 + m * 512) + lane); }
#pragma unroll
                        for (int r = 0; r < 4; ++r) { const int mm = m0 + r * NGW; if (mm >= TC) continue;
                            const float mx = fmaxf(l0[r], fmaxf(l1[r], l2[r])); float w0 = fast_exp2(l0[r] - mx), w1 = fast_exp2(l1[r] - mx), w2 = fast_exp2(l2[r] - mx); const float inv = 1.0f / (w0 + w1 + w2); w0 *= inv; w1 *= inv; w2 *= inv;
                            u32x4 w;
                            w.x = cvt_pk_bf16(w0 * bf_lo(a[r].x) + w1 * bf_lo(b[r].x) + w2 * bf_lo(cc[r].x), w0 * bf_hi(a[r].x) + w1 * bf_hi(b[r].x) + w2 * bf_hi(cc[r].x));
                            w.y = cvt_pk_bf16(w0 * bf_lo(a[r].y) + w1 * bf_lo(b[r].y) + w2 * bf_lo(cc[r].y), w0 * bf_hi(a[r].y) + w1 * bf_hi(b[r].y) + w2 * bf_hi(cc[r].y));
                            w.z = cvt_pk_bf16(w0 * bf_lo(a[r].z) + w1 * bf_lo(b[r].z) + w2 * bf_lo(cc[r].z), w0 * bf_hi(a[r].z) + w1 * bf_hi(b[r].z) + w2 * bf_hi(cc[r].z));
                            w.w = cvt_pk_bf16(w0 * bf_lo(a[r].w) + w1 * bf_lo(b[r].w) + w2 * bf_lo(cc[r].w), w0 * bf_hi(a[r].w) + w1 * bf_hi(b[r].w) + w2 * bf_hi(cc[r].w));
                            *((u32x4*)(br + (size_t)mm * BRC + 512) + lane) = w; }
                    }
                } else {
                    pg8::Gemm g{br, WL + OFF_WBR, TC, D, 512, BRC, 512, 512, (size_t)D * 512}; pg8::Order S; S.init(TC, D, 3, G, bx); pg8::EpiBranch E{gates, mixb}; for (int rep = 0; rep < REP_BR; ++rep) pg8::gemm_phase(lds, g, S, E);
                }
            }
        }
        if (load_chunk >= 0) {
            const float* xin = load_chunk < 2 ? args.in[0] + (size_t)load_chunk * TC * D : args.in[1] + (size_t)(load_chunk - 2) * TC * D;
            for (int m0 = gw; m0 < TC; m0 += 4 * NGW) {
                f32x4 v[4][4];
#pragma unroll
                for (int r = 0; r < 4; ++r) { const int mm = m0 + r * NGW; const size_t m = (size_t)(mm < TC ? mm : m0);
#pragma unroll
                    for (int j = 0; j < 4; ++j) v[r][j] = *((const f32x4*)(xin + m * D) + lane + 64 * j); }
#pragma unroll
                for (int r = 0; r < 4; ++r) { const int mm = m0 + r * NGW; if (mm >= TC) continue;
#pragma unroll
                    for (int j = 0; j < 4; ++j) { u32x2 w; w.x = cvt_pk_bf16(v[r][j][0], v[r][j][1]); w.y = cvt_pk_bf16(v[r][j][2], v[r][j][3]); *((u32x2*)(xb + (size_t)mm * D) + lane + 64 * j) = w; } }
            }
        }
        for (int rep = 0; rep < REP_SYNC; ++rep) xcd_barrier(bar);
    }
}

extern "C" void kernel_launch(void* const* d_in, const int* in_sizes, int n_in, void* d_out, int out_size, void* d_ws, size_t ws_size, hipStream_t stream) {
    static int grid = 0;
    if (grid == 0) {
        if (n_in != 19 || ws_size < WS_END) { fprintf(stderr, "kernel_launch: need 19 inputs and %zu bytes of workspace; got %d, %zu\n", (size_t)WS_END, n_in, ws_size); grid = -1; return; }
        int dev = 0, cus = 0, per_cu = 0;
        hipGetDevice(&dev); hipDeviceGetAttribute(&cus, hipDeviceAttributeMultiprocessorCount, dev);
        if (hipFuncSetAttribute((const void*)mega_fwd, hipFuncAttributeMaxDynamicSharedMemorySize, LDS_BYTES) != hipSuccess) { fprintf(stderr, "kernel_launch: hipFuncSetAttribute failed\n"); grid = -1; return; }
        if (hipOccupancyMaxActiveBlocksPerMultiprocessor(&per_cu, (const void*)mega_fwd, 512, LDS_BYTES) != hipSuccess || per_cu < 1) { fprintf(stderr, "kernel_launch: occupancy query says %d\n", per_cu); per_cu = 1; }
        (void)hipGetLastError();
        grid = cus;
        if (grid != 256) { fprintf(stderr, "kernel_launch: built for a 256-CU device (fused LayerNorm epilogue needs one 256x256 unit per workgroup); got %d CUs\n", cus); grid = -1; return; }
    }
    if (grid < 0) return;
    if (hipMemsetAsync((char*)d_ws + WS_CTL, 0, CTL_BYTES, stream) != hipSuccess) { fprintf(stderr, "kernel_launch: memset failed\n"); return; }
    Args a{};
    for (int i = 0; i < 19; ++i) a.in[i] = (const float*)d_in[i];
    a.out = (float*)d_out; a.ws = (unsigned char*)d_ws;
    void* kargs[] = {&a};
    hipError_t e = hipLaunchCooperativeKernel((const void*)mega_fwd, dim3(grid), dim3(512), kargs, LDS_BYTES, stream);
    if (e != hipSuccess) fprintf(stderr, "cooperative launch failed: %s (grid %d)\n", hipGetErrorString(e), grid);
}
```

```cpp
#include <hip/hip_runtime.h>
#include <hip/hip_cooperative_groups.h>
#include <cstdio>
#include <cstdint>
namespace cg = cooperative_groups;

#define LAS __attribute__((address_space(3)))
typedef unsigned short bf16_t;
typedef short bf16x8 __attribute__((ext_vector_type(8)));
typedef short s16x4 __attribute__((ext_vector_type(4)));
typedef float f32x4 __attribute__((ext_vector_type(4)));
typedef float f32x2 __attribute__((ext_vector_type(2)));
typedef unsigned u32x4 __attribute__((ext_vector_type(4)));
typedef unsigned u32x2 __attribute__((ext_vector_type(2)));

constexpr int D = 1024, DFF = 2816, NLAYER = 2;
constexpr int TC = 16384;
constexpr int NCHUNK = 4;
constexpr int INC = 5888, PROJC = 2816, GATEC = 3072, BRC = 1536;
constexpr int NMEM = 256, MEMROWS = 5120;
constexpr float LN_EPS = 1e-5f;
constexpr float ALPHA = 1.41421356237309515f;
constexpr float LOG2E = 1.44269504088896341f;

constexpr size_t MiB = 1u << 20;
constexpr size_t W_LAYER_ELEMS = (size_t)5632 * 1024 + (size_t)1024 * 2816 + (size_t)5888 * 1024 + (size_t)3 * 1024 * 512 + (size_t)1024 * 1024 + (size_t)5632 * 1024 + (size_t)1024 * 2816;
constexpr size_t OFF_W1IN = 0, OFF_W1OUT = OFF_W1IN + (size_t)5632 * 1024, OFF_WIN = OFF_W1OUT + (size_t)1024 * 2816, OFF_WBR = OFF_WIN + (size_t)5888 * 1024,
                 OFF_WOUT = OFF_WBR + (size_t)3 * 1024 * 512, OFF_W2IN = OFF_WOUT + (size_t)1024 * 1024, OFF_W2OUT = OFF_W2IN + (size_t)5632 * 1024;
constexpr size_t WS_W = 0;
constexpr size_t WS_WMEM = 100 * MiB;
constexpr size_t WS_MEMB = 108 * MiB;
constexpr size_t WS_MEMKV = 118 * MiB;
constexpr size_t WS_XB = 158 * MiB;
constexpr size_t WS_U = 190 * MiB;
constexpr size_t U_H = 0;
constexpr size_t U_PROJ = 0;
constexpr size_t U_GATES = 88 * MiB;
constexpr size_t U_BR = 184 * MiB;
constexpr size_t U_BPART = 232 * MiB;
constexpr size_t U_LSE = 280 * MiB;
constexpr size_t U_MIXF = 0;
constexpr size_t U_MIXB = 232 * MiB;
constexpr size_t WS_X16 = WS_U + 282 * MiB;
constexpr size_t WS_CTL = WS_X16 + 32 * MiB;
constexpr size_t CTL_BYTES = 32768;
constexpr size_t CTL_XBUF = 65536;
constexpr size_t WS_END = WS_CTL + 1 * MiB;
static_assert(W_LAYER_ELEMS * 2 * 2 <= 100 * MiB, "weights fit");

constexpr int REP_ATT = 1, REP_UP = 1, REP_INPROJ = 1, REP_BR = 1, REP_PRO = 1, REP_SYNC = 1, REP_CMB = 1;
constexpr int LDS_BYTES = 147456 + 256;
constexpr int LDS_MISC = 147456;

__device__ __forceinline__ unsigned cvt_pk_bf16(float lo, float hi) { unsigned r; asm("v_cvt_pk_bf16_f32 %0, %1, %2" : "=v"(r) : "v"(lo), "v"(hi)); return r; }
__device__ __forceinline__ float bf_lo(unsigned u) { return __uint_as_float(u << 16); }
__device__ __forceinline__ float bf_hi(unsigned u) { return __uint_as_float(u & 0xffff0000u); }
typedef _Float16 f16x2 __attribute__((ext_vector_type(2)));
typedef _Float16 f16x8 __attribute__((ext_vector_type(8)));
__device__ __forceinline__ unsigned cvt_pk_h(float lo, float hi) { const f16x2 v = {(_Float16)lo, (_Float16)hi}; return __builtin_bit_cast(unsigned, v); }
__device__ __forceinline__ float h_lo(unsigned u) { return (float)__builtin_bit_cast(f16x2, u)[0]; }
__device__ __forceinline__ float h_hi(unsigned u) { return (float)__builtin_bit_cast(f16x2, u)[1]; }
__device__ __forceinline__ float fast_exp2(float x) { return __builtin_amdgcn_exp2f(x); }
__device__ __forceinline__ float fast_rcp(float x) { return __builtin_amdgcn_rcpf(x); }
__device__ __forceinline__ float sigmoidf_fast(float v) { return fast_rcp(1.0f + fast_exp2(-LOG2E * v)); }
__device__ __forceinline__ float rowgrp_max(float m) {
    const auto r = __builtin_amdgcn_permlane16_swap(__float_as_uint(m), __float_as_uint(m), false, false);
    const float a = fmaxf(__uint_as_float(r[0]), __uint_as_float(r[1]));
    const auto r2 = __builtin_amdgcn_permlane32_swap(__float_as_uint(a), __float_as_uint(a), false, false);
    return fmaxf(__uint_as_float(r2[0]), __uint_as_float(r2[1]));
}
__device__ __forceinline__ float rowgrp_sum(float m) {
    const auto r = __builtin_amdgcn_permlane16_swap(__float_as_uint(m), __float_as_uint(m), false, false);
    const float a = __uint_as_float(r[0]) + __uint_as_float(r[1]);
    const auto r2 = __builtin_amdgcn_permlane32_swap(__float_as_uint(a), __float_as_uint(a), false, false);
    return __uint_as_float(r2[0]) + __uint_as_float(r2[1]);
}
__device__ __forceinline__ float wave_sum(float v) {
#pragma unroll
    for (int o = 1; o < 64; o <<= 1) v += __shfl_xor(v, o);
    return v;
}

#define XB_TMO      128
#define XB_XCNT(j)  (256  + 64 * (j))
#define XB_XSUB(j)  (1280 + 64 * (j))
#define XB_XGEN(j)  (2304 + 64 * (j))
#define XB_TOP      3328
#define XB_TOPGEN   3392
#define XCD_BAR_WORDS 3456
#define XB_SPIN_CAP (1u << 18)

__device__ __forceinline__ unsigned xb_ld(unsigned* p)              { return __hip_atomic_load(p, __ATOMIC_RELAXED, __HIP_MEMORY_SCOPE_AGENT); }
__device__ __forceinline__ unsigned xb_add(unsigned* p, unsigned v) { return __hip_atomic_fetch_add(p, v, __ATOMIC_RELAXED, __HIP_MEMORY_SCOPE_AGENT); }
__device__ __forceinline__ unsigned xb_xcc_id() { return (unsigned)__builtin_amdgcn_s_getreg((3 << 11) | 20) & 0xFu; }
#define XB_SPIN(cond, bar) do { unsigned _sp = 0; while (cond) { __builtin_amdgcn_s_sleep(1); \
    if ((++_sp & 255u) == 0u) { if (xb_ld(&(bar)[XB_TMO])) break; if (_sp > XB_SPIN_CAP) { atomicAdd(&(bar)[XB_TMO], 1u); break; } } } } while (0)

struct XcdBarrier {
    unsigned* bar; unsigned x;
    volatile LAS unsigned* st;
};

__device__ __forceinline__ XcdBarrier xcd_barrier_post(unsigned* bar, volatile LAS unsigned* st) {
    XcdBarrier b; b.bar = bar; b.x = xb_xcc_id(); b.st = st;
    if (threadIdx.x == 0) (void)xb_add(&bar[XB_XCNT(b.x)], 1u);
    return b;
}
__device__ __forceinline__ void xcd_barrier_complete(unsigned* bar, unsigned x, unsigned& nloc, unsigned& nx) {
    const unsigned G = gridDim.x * gridDim.y * gridDim.z;
    unsigned sum, cnt, mine, sp = 0u;
    for (;;) {
        sum = 0u; cnt = 0u; mine = 0u;
#pragma unroll
        for (unsigned j = 0; j < 16; ++j) { const unsigned c = xb_ld(&bar[XB_XCNT(j)]); sum += c; cnt += (c > 0u) ? 1u : 0u; mine = (j == x) ? c : mine; }
        if (sum == G) break;
        __builtin_amdgcn_s_sleep(1);
        if ((++sp & 255u) == 0u) { if (xb_ld(&bar[XB_TMO])) break; if (sp > XB_SPIN_CAP) { atomicAdd(&bar[XB_TMO], 1u); break; } }
    }
    nloc = mine > 0u ? mine : 1u; nx = cnt > 0u ? cnt : 1u;
}

__device__ __forceinline__ void xcd_barrier(const XcdBarrier& b) {
    asm volatile("s_waitcnt vmcnt(0)" ::: "memory");
    __syncthreads();
    if (threadIdx.x == 0) {
        unsigned* bar = b.bar;
        __builtin_amdgcn_s_waitcnt(0);
        unsigned nloc = b.st[0], nx = b.st[1];
        if (nloc == 0u) { xcd_barrier_complete(bar, b.x, nloc, nx); b.st[0] = nloc; b.st[1] = nx; }
        const unsigned old = xb_add(&bar[XB_XSUB(b.x)], 1u);
        const unsigned gen = old / nloc;
        if (old + 1u == (gen + 1u) * nloc) {
            __builtin_amdgcn_fence(__ATOMIC_RELEASE, "agent");
            asm volatile("s_waitcnt vmcnt(0)" ::: "memory");
            const unsigned og = xb_add(&bar[XB_TOP], 1u);
            const unsigned tg = og / nx;
            if (og + 1u == (tg + 1u) * nx) xb_add(&bar[XB_TOPGEN], 1u);
            else XB_SPIN(xb_ld(&bar[XB_TOPGEN]) == tg, bar);
            __builtin_amdgcn_fence(__ATOMIC_ACQUIRE, "agent");
            xb_add(&bar[XB_XGEN(b.x)], 1u);
            asm volatile("s_waitcnt vmcnt(0)" ::: "memory");
        } else {
            XB_SPIN(xb_ld(&bar[XB_XGEN(b.x)]) == gen, bar);
            __builtin_amdgcn_fence(__ATOMIC_ACQUIRE, "agent");
            asm volatile("s_waitcnt vmcnt(0)" ::: "memory");
        }
    }
    __syncthreads();
}


namespace pg8 {
constexpr int BM = 256, BK = 64, HALF = 128, HTB = HALF * BK * 2, STAGE_BYTES = 8 * HTB, NXCD = 8, WGM = 4;
__host__ __device__ __forceinline__ int lds_byte(int r, int c) { const int st = (r >> 4) * 2 + (c >> 5), rr = r & 15, cc = c & 31, ob = rr * 64 + cc * 2; return st * 1024 + (ob ^ (((ob >> 9) & 1) << 5)); }
__host__ __device__ __forceinline__ void stage_rc(int b, int& R, int& C) { const int st = b / 1024, sb = b % 1024, swz = sb ^ (((sb >> 9) & 1) << 5); R = (st >> 1) * 16 + swz / 64; C = (st & 1) * 32 + (swz % 64) / 2; }
__host__ __device__ __forceinline__ int perm32(int rho) { const int n = rho >> 4, i = rho & 15; return 8 * (i >> 2) + 4 * n + (i & 3); }

struct Unit { int pm, pn, z; };
struct Gemm { const bf16_t* A; const bf16_t* Bt; int M, N, K, lda, ldb; size_t za, zb; };

struct Order {
    int nM, nN, nZ, nwg, G, c;
    __device__ void init(int M, int N, int nZ_, int G_, int c_) { nM = M / BM; nN = N / BM; nZ = nZ_; nwg = nM * nN; G = G_; c = c_; }
    __device__ bool next(int i, Unit& u) const {
        const int ti = i / nZ; u.z = i - ti * nZ;
        const long L = (long)ti * G + c; if (L >= nwg) return false;
        int wgid = (int)L; { const int q = nwg / NXCD, r = nwg % NXCD, xcd = wgid % NXCD, off = wgid / NXCD; wgid = (xcd < r ? xcd * (q + 1) : r * (q + 1) + (xcd - r) * q) + off; }
        const int nig = WGM * nN, gid = wgid / nig, fm = gid * WGM, gsz = (nM - fm) < WGM ? (nM - fm) : WGM;
        u.pm = fm + ((wgid % nig) % gsz); u.pn = (wgid % nig) / gsz; return true;
    }
};

template <class Epi>
__device__ __forceinline__ void gemm_phase(LAS unsigned char* lds, const Gemm g, const Order& S, const Epi& E) {
    int tid = threadIdx.x; asm volatile("" : "+v"(tid));
    const int wid = __builtin_amdgcn_readfirstlane(tid >> 6), lane = tid & 63, wr = wid >> 2, wc = wid & 3, fr = lane & 15, fq = lane >> 4;
    const int K = g.K, nt = K / BK;
    unsigned voffA[2], voffB[2];
#pragma unroll
    for (int i = 0; i < 2; ++i) { int R, C; stage_rc(tid * 16 + i * 8192, R, C); const int Rb = Epi::PERM ? ((R & ~31) + perm32(R & 31)) : R;
        voffA[i] = (unsigned)(R * g.lda + C) * 2u; voffB[i] = (unsigned)(Rb * g.ldb + C) * 2u; }
    const size_t kstep = (size_t)(BK * 2);
    const size_t hstepA = (size_t)HALF * g.lda * 2, hstepB = (size_t)HALF * g.ldb * 2;
    const unsigned ldsw = (unsigned)wid * 1024u;
    const int aoff = lds_byte(wr * 64 + fr, fq * 8), boff = lds_byte(wc * 32 + fr, fq * 8);
#define PG8_SA(b, h) (((b) * 2 + (h)) * HTB)
#define PG8_SB(b, h) ((4 + (b) * 2 + (h)) * HTB)
#define PG8_STAGE(bufoff, gbase, voff) do { _Pragma("unroll") for (int _i = 0; _i < 2; ++_i) \
        __builtin_amdgcn_global_load_lds((const unsigned*)((const char*)(gbase) + (voff)[_i]), (LAS unsigned*)(lds + (bufoff) + ldsw + _i * 8192), 16, 0, 0); } while (0)
#define PG8_LDA(dst, b, h) do { _Pragma("unroll") for (int m = 0; m < 4; ++m) _Pragma("unroll") for (int k = 0; k < 2; ++k) dst[m][k] = *(const LAS bf16x8*)(lds + PG8_SA(b, h) + aoff + m * 2048 + k * 1024); } while (0)
#define PG8_LDB(dst, b, h) do { _Pragma("unroll") for (int n = 0; n < 2; ++n) _Pragma("unroll") for (int k = 0; k < 2; ++k) dst[n][k] = *(const LAS bf16x8*)(lds + PG8_SB(b, h) + boff + n * 2048 + k * 1024); } while (0)
#define PG8_MMA(ai, bj, At, Bt) do { __builtin_amdgcn_s_setprio(1); _Pragma("unroll") for (int m = 0; m < 4; ++m) _Pragma("unroll") for (int n = 0; n < 2; ++n) _Pragma("unroll") for (int k = 0; k < 2; ++k) \
        acc[ai][bj][m][n] = Epi::F16A ? __builtin_amdgcn_mfma_f32_16x16x32_f16(__builtin_bit_cast(f16x8, Bt[n][k]), __builtin_bit_cast(f16x8, At[m][k]), acc[ai][bj][m][n], 0, 0, 0) \
                                      : __builtin_amdgcn_mfma_f32_16x16x32_bf16(Bt[n][k], At[m][k], acc[ai][bj][m][n], 0, 0, 0); __builtin_amdgcn_s_setprio(0); } while (0)
#define PG8_WAIT_V(n) asm volatile("s_waitcnt vmcnt(" #n ")" ::: "memory")
#define PG8_WAIT_L(n) asm volatile("s_waitcnt lgkmcnt(" #n ")" ::: "memory")
#define PG8_BAR __builtin_amdgcn_s_barrier()
#define PG8_SCHED __builtin_amdgcn_sched_barrier(0)
    Unit cur, nxt; int ui = 0;
    if (!S.next(0, cur)) return;
    f32x4 acc[2][2][4][2];
#pragma unroll
    for (int a = 0; a < 2; ++a)
#pragma unroll
        for (int b = 0; b < 2; ++b)
#pragma unroll
            for (int m = 0; m < 4; ++m)
#pragma unroll
                for (int n = 0; n < 2; ++n) acc[a][b][m][n] = (f32x4){0.f, 0.f, 0.f, 0.f};
    bf16x8 At[4][2], B0[2][2], B1[2][2];
    const char* cA = (const char*)(g.A + (size_t)cur.pm * BM * g.lda + (size_t)cur.z * g.za);
    const char* cB = (const char*)(g.Bt + (size_t)cur.pn * BM * g.ldb + (size_t)cur.z * g.zb);
    constexpr bool ALIGN_EPI = Epi::ALIGN && !Epi::AFTER_DRAIN;
    PG8_STAGE(PG8_SB(0, 0), cB, voffB); PG8_STAGE(PG8_SB(0, 1), cB + hstepB, voffB); PG8_STAGE(PG8_SA(0, 0), cA, voffA); PG8_STAGE(PG8_SA(0, 1), cA + hstepA, voffA);
    if (wr == 1) PG8_BAR;
    PG8_WAIT_V(2); PG8_BAR;
    PG8_STAGE(PG8_SB(1, 0), cB + kstep, voffB); PG8_STAGE(PG8_SA(1, 0), cA + kstep, voffA); PG8_STAGE(PG8_SB(1, 1), cB + hstepB + kstep, voffB);
    PG8_WAIT_V(6); PG8_BAR;
    for (;;) {
        const bool has_next = S.next(ui + 1, nxt);
        const char* nA = has_next ? (const char*)(g.A + (size_t)nxt.pm * BM * g.lda + (size_t)nxt.z * g.za) : cA;
        const char* nB = has_next ? (const char*)(g.Bt + (size_t)nxt.pn * BM * g.ldb + (size_t)nxt.z * g.zb) : cB;
        for (int t = 0; t < nt; t += 2) {
            const bool last = (t == nt - 2);
            const char* a1 = cA + (size_t)(t + 1) * kstep;
            const char* a2 = last ? nA : cA + (size_t)(t + 2) * kstep; const char* b2 = last ? nB : cB + (size_t)(t + 2) * kstep;
            const char* a3 = a2 + kstep; const char* b3 = b2 + kstep;
            PG8_LDB(B0, 0, 0); PG8_LDB(B1, 0, 1); PG8_SCHED; PG8_LDA(At, 0, 0); PG8_STAGE(PG8_SA(1, 1), a1 + hstepA, voffA);
            PG8_WAIT_V(8); PG8_WAIT_L(0); PG8_BAR; PG8_MMA(0, 0, At, B0); PG8_MMA(0, 1, At, B1); PG8_BAR; PG8_SCHED;
            PG8_LDA(At, 0, 1); PG8_STAGE(PG8_SB(0, 0), b2, voffB); PG8_STAGE(PG8_SB(0, 1), b2 + hstepB, voffB); PG8_STAGE(PG8_SA(0, 0), a2, voffA);
            PG8_WAIT_V(8); PG8_WAIT_L(0); PG8_BAR; PG8_MMA(1, 0, At, B0); PG8_MMA(1, 1, At, B1); PG8_BAR; PG8_SCHED;
            PG8_LDB(B0, 1, 0); PG8_LDB(B1, 1, 1); PG8_SCHED; PG8_LDA(At, 1, 0); PG8_STAGE(PG8_SA(0, 1), a2 + hstepA, voffA);
            PG8_WAIT_V(8); PG8_WAIT_L(0); PG8_BAR; PG8_MMA(0, 0, At, B0); PG8_MMA(0, 1, At, B1); PG8_BAR; PG8_SCHED;
            PG8_LDA(At, 1, 1); PG8_STAGE(PG8_SB(1, 0), b3, voffB); PG8_STAGE(PG8_SB(1, 1), b3 + hstepB, voffB); PG8_STAGE(PG8_SA(1, 0), a3, voffA);
            PG8_WAIT_V(8); PG8_WAIT_L(0); PG8_BAR; PG8_MMA(1, 0, At, B0); PG8_MMA(1, 1, At, B1); PG8_BAR; PG8_SCHED;
        }
        if constexpr (ALIGN_EPI) { if (wr == 0) PG8_BAR; }
        if constexpr (!Epi::AFTER_DRAIN) E(acc, cur, wr, wc, fr, fq);
        if (!has_next) break;
        if (!(Epi::KEEP_ACC && nxt.z != 0)) {
#pragma unroll
        for (int a = 0; a < 2; ++a)
#pragma unroll
            for (int b = 0; b < 2; ++b)
#pragma unroll
                for (int m = 0; m < 4; ++m)
#pragma unroll
                    for (int n = 0; n < 2; ++n) acc[a][b][m][n] = (f32x4){0.f, 0.f, 0.f, 0.f};
        }
        cur = nxt; cA = nA; cB = nB; ++ui;
        if constexpr (ALIGN_EPI) { if (wr == 1) PG8_BAR; }
    }
    PG8_WAIT_V(0);
    if constexpr (!ALIGN_EPI) { if (wr == 0) PG8_BAR; }
    PG8_BAR;
    if constexpr (Epi::AFTER_DRAIN) E.fused(acc, cur, wr, wc, fr, fq, lds, wid, lane);
#undef PG8_SA
#undef PG8_SB
#undef PG8_STAGE
#undef PG8_LDA
#undef PG8_LDB
#undef PG8_MMA
#undef PG8_WAIT_V
#undef PG8_WAIT_L
#undef PG8_BAR
#undef PG8_SCHED
}

struct EpiSwiglu {
    static constexpr bool PERM = true, AFTER_DRAIN = false, KEEP_ACC = false, ALIGN = true, F16A = true;
    bf16_t* O; int ldc;
    __device__ __forceinline__ void operator()(const f32x4 (&acc)[2][2][4][2], const Unit& u, int wr, int wc, int fr, int fq) const {
        const int row0 = u.pm * BM + wr * 64 + fr, col0 = u.pn * HALF + wc * 32 + 8 * fq;
#pragma unroll
        for (int ai = 0; ai < 2; ++ai)
#pragma unroll
            for (int m = 0; m < 4; ++m) {
                bf16_t* rowp = O + (size_t)(row0 + ai * HALF + m * 16) * ldc + col0;
                float r[8];
#pragma unroll
                for (int n = 0; n < 2; ++n)
#pragma unroll
                    for (int j = 0; j < 4; ++j) { const float gv = acc[ai][0][m][n][j], uv = acc[ai][1][m][n][j]; r[n * 4 + j] = gv * uv * fast_rcp(1.0f + fast_exp2(-gv)); }
                u32x4 w; w.x = cvt_pk_bf16(r[0], r[1]); w.y = cvt_pk_bf16(r[2], r[3]); w.z = cvt_pk_bf16(r[4], r[5]); w.w = cvt_pk_bf16(r[6], r[7]);
                *(u32x4*)rowp = w;
            }
    }
};
struct EpiResidLN {
    static constexpr bool PERM = true, AFTER_DRAIN = true, KEEP_ACC = false, ALIGN = false, F16A = false;
    float* xout; bf16_t* X16; const float* gam; const float* bet; float beta;
    unsigned long long* xbuf; unsigned* cnt; unsigned want;
    __device__ __forceinline__ void fused(f32x4 (&acc)[2][2][4][2], const Unit& u, int wr, int wc, int fr, int fq, LAS unsigned char* lds, int wid, int lane) const {
        LAS f32x2* P = (LAS f32x2*)lds;
        LAS f32x2* S = (LAS f32x2*)(lds + 8192);
        const int row0 = u.pm * BM + wr * 64 + fr, col0 = u.pn * BM + wc * 32 + 8 * fq;
        {
            u32x4 hw[2][2];
#pragma unroll
            for (int bj = 0; bj < 2; ++bj) hw[0][bj] = *(const u32x4*)(X16 + (size_t)row0 * D + col0 + bj * HALF);
#pragma unroll
            for (int gi = 0; gi < 8; ++gi) {
                const int ai = gi >> 2, m = gi & 3;
                if (gi + 1 < 8) { const int ai1 = (gi + 1) >> 2, m1 = (gi + 1) & 3;
#pragma unroll
                    for (int bj = 0; bj < 2; ++bj) hw[(gi + 1) & 1][bj] = *(const u32x4*)(X16 + (size_t)(row0 + ai1 * HALF + m1 * 16) * D + col0 + bj * HALF); }
                asm volatile("" ::: "memory");
#pragma unroll
                for (int bj = 0; bj < 2; ++bj) { const u32x4 h = hw[gi & 1][bj];
                    const f32x4 x0 = (f32x4){h_lo(h.x), h_hi(h.x), h_lo(h.y), h_hi(h.y)}, x1 = (f32x4){h_lo(h.z), h_hi(h.z), h_lo(h.w), h_hi(h.w)};
                    acc[ai][bj][m][0] = x0 * ALPHA + acc[ai][bj][m][0] * beta; acc[ai][bj][m][1] = x1 * ALPHA + acc[ai][bj][m][1] * beta; }
                asm volatile("" : "+v"(acc[ai][0][m][0]), "+v"(acc[ai][0][m][1]), "+v"(acc[ai][1][m][0]), "+v"(acc[ai][1][m][1]));
            }
        }
#pragma unroll
        for (int ai = 0; ai < 2; ++ai)
#pragma unroll
            for (int m = 0; m < 4; ++m) {
                float s = 0.f;
#pragma unroll
                for (int bj = 0; bj < 2; ++bj)
#pragma unroll
                    for (int n = 0; n < 2; ++n) { const f32x4 x = acc[ai][bj][m][n]; s += (x[0] + x[1]) + (x[2] + x[3]); }
                s = rowgrp_sum(s);
                const float mw = s * (1.0f / 64.0f); float q = 0.f;
#pragma unroll
                for (int bj = 0; bj < 2; ++bj)
#pragma unroll
                    for (int n = 0; n < 2; ++n) { const f32x4 d = acc[ai][bj][m][n] - mw; q += (d[0] * d[0] + d[1] * d[1]) + (d[2] * d[2] + d[3] * d[3]); }
                q = rowgrp_sum(q);
                if (fq == 0) P[(ai * HALF + wr * 64 + m * 16 + fr) * 4 + wc] = (f32x2){mw, q};
            }
        asm volatile("s_waitcnt lgkmcnt(0)" ::: "memory"); __builtin_amdgcn_s_barrier(); asm volatile("" ::: "memory");
        const int row = wid * 32 + (lane & 31);
        if (lane < 32) {
            const f32x2 a = P[row * 4 + 0], b = P[row * 4 + 1], c = P[row * 4 + 2], d = P[row * 4 + 3];
            const float mt = (a.x + b.x + c.x + d.x) * 0.25f;
            const float da = a.x - mt, db = b.x - mt, dc = c.x - mt, dd = d.x - mt;
            const float m2 = (a.y + b.y) + (c.y + d.y) + 64.0f * ((da * da + db * db) + (dc * dc + dd * dd));
            unsigned long long* slot = xbuf + ((size_t)((u.pm & 63) * BM + row) * 4 + u.pn);
            __hip_atomic_store(slot, ((unsigned long long)__float_as_uint(m2) << 32) | __float_as_uint(mt), __ATOMIC_RELAXED, __HIP_MEMORY_SCOPE_AGENT);
        }
        asm volatile("s_waitcnt vmcnt(0)" ::: "memory");
        if (lane == 0) __hip_atomic_fetch_add(cnt + 64 * (u.pm & 63), 1u, __ATOMIC_RELAXED, __HIP_MEMORY_SCOPE_AGENT);
        if (wid == 0) {
            unsigned spins = 0;
            while ((unsigned)__builtin_amdgcn_readfirstlane(__hip_atomic_load(cnt + 64 * (u.pm & 63), __ATOMIC_RELAXED, __HIP_MEMORY_SCOPE_AGENT)) < want) { __builtin_amdgcn_s_sleep(2); if (++spins > (1u << 22)) break; }
            __builtin_amdgcn_fence(__ATOMIC_ACQUIRE, "agent");
        }
        asm volatile("s_waitcnt vmcnt(0) lgkmcnt(0)" ::: "memory"); __builtin_amdgcn_s_barrier(); asm volatile("" ::: "memory");
        if (lane < 32) {
            const unsigned long long* slot = xbuf + (size_t)((u.pm & 63) * BM + row) * 4; float mt[4], m2[4]; float ms = 0.f;
#pragma unroll
            for (int t = 0; t < 4; ++t) { const unsigned long long w = __hip_atomic_load(slot + t, __ATOMIC_RELAXED, __HIP_MEMORY_SCOPE_AGENT); mt[t] = __uint_as_float((unsigned)w); m2[t] = __uint_as_float((unsigned)(w >> 32)); ms += mt[t]; }
            const float mean = ms * 0.25f; float q = 0.f;
#pragma unroll
            for (int t = 0; t < 4; ++t) { const float dm = mt[t] - mean; q += m2[t] + 256.0f * dm * dm; }
            S[row] = (f32x2){mean, 1.0f / sqrtf(q * (1.0f / 1024.0f) + LN_EPS)};
        }
        asm volatile("s_waitcnt lgkmcnt(0)" ::: "memory"); __builtin_amdgcn_s_barrier(); asm volatile("" ::: "memory");
        f32x4 gv[2][2], bv[2][2];
#pragma unroll
        for (int bj = 0; bj < 2; ++bj)
#pragma unroll
            for (int n = 0; n < 2; ++n) { gv[bj][n] = *(const f32x4*)(gam + col0 + bj * HALF + 4 * n); bv[bj][n] = *(const f32x4*)(bet + col0 + bj * HALF + 4 * n); }
#pragma unroll
        for (int ai = 0; ai < 2; ++ai)
#pragma unroll
            for (int m = 0; m < 4; ++m) { const int r = ai * HALF + wr * 64 + m * 16 + fr; const f32x2 sr = S[r]; const size_t off = (size_t)(u.pm * BM + r) * D + col0;
#pragma unroll
                for (int bj = 0; bj < 2; ++bj) {
                    const f32x4 y0 = (acc[ai][bj][m][0] - sr.x) * sr.y * gv[bj][0] + bv[bj][0], y1 = (acc[ai][bj][m][1] - sr.x) * sr.y * gv[bj][1] + bv[bj][1];
                    if (xout) { *(f32x4*)(xout + off + bj * HALF) = y0; *(f32x4*)(xout + off + bj * HALF + 4) = y1; }
                    else { u32x4 hw; hw.x = cvt_pk_h(y0[0], y0[1]); hw.y = cvt_pk_h(y0[2], y0[3]); hw.z = cvt_pk_h(y1[0], y1[1]); hw.w = cvt_pk_h(y1[2], y1[3]); *(u32x4*)(X16 + off + bj * HALF) = hw; } }
                asm volatile("" ::: "memory"); }
    }
};
struct EpiInproj {
    static constexpr bool PERM = true, AFTER_DRAIN = false, KEEP_ACC = false, ALIGN = true, F16A = true;
    bf16_t* P; bf16_t* G;
    __device__ __forceinline__ void operator()(const f32x4 (&acc)[2][2][4][2], const Unit& u, int wr, int wc, int fr, int fq) const {
        const bool isg = u.pn >= 11;
        bf16_t* base = isg ? G : P; const int ldc = isg ? GATEC : PROJC; const int colt = isg ? (u.pn - 11) * BM : u.pn * BM;
        const int row0 = u.pm * BM + wr * 64 + fr, col0 = colt + wc * 32 + 8 * fq;
#pragma unroll
        for (int ai = 0; ai < 2; ++ai)
#pragma unroll
            for (int m = 0; m < 4; ++m) { bf16_t* rowp = base + (size_t)(row0 + ai * HALF + m * 16) * ldc + col0;
#pragma unroll
                for (int bj = 0; bj < 2; ++bj) { f32x4 v0 = acc[ai][bj][m][0], v1 = acc[ai][bj][m][1];
                    if (isg) {
#pragma unroll
                        for (int j = 0; j < 4; ++j) { v0[j] = fmaxf(sigmoidf_fast(v0[j]), 1e-30f); v1[j] = fmaxf(sigmoidf_fast(v1[j]), 1e-30f); } }
                    u32x4 w; w.x = cvt_pk_bf16(v0[0], v0[1]); w.y = cvt_pk_bf16(v0[2], v0[3]); w.z = cvt_pk_bf16(v1[0], v1[1]); w.w = cvt_pk_bf16(v1[2], v1[3]);
                    *(u32x4*)(rowp + bj * HALF) = w; } }
    }
};
struct EpiBf16Plain {
    static constexpr bool PERM = true, AFTER_DRAIN = false, KEEP_ACC = false, ALIGN = true, F16A = false;
    bf16_t* O; int ldc;
    __device__ __forceinline__ void operator()(const f32x4 (&acc)[2][2][4][2], const Unit& u, int wr, int wc, int fr, int fq) const {
        const int row0 = u.pm * BM + wr * 64 + fr, col0 = u.pn * BM + wc * 32 + 8 * fq;
#pragma unroll
        for (int ai = 0; ai < 2; ++ai)
#pragma unroll
            for (int m = 0; m < 4; ++m) { bf16_t* rowp = O + (size_t)(row0 + ai * HALF + m * 16) * ldc + col0;
#pragma unroll
                for (int bj = 0; bj < 2; ++bj) { const f32x4 v0 = acc[ai][bj][m][0], v1 = acc[ai][bj][m][1];
                    u32x4 w; w.x = cvt_pk_bf16(v0[0], v0[1]); w.y = cvt_pk_bf16(v0[2], v0[3]); w.z = cvt_pk_bf16(v1[0], v1[1]); w.w = cvt_pk_bf16(v1[2], v1[3]);
                    *(u32x4*)(rowp + bj * HALF) = w; } }
    }
};
struct EpiBranch {
    static constexpr bool PERM = true, AFTER_DRAIN = false, KEEP_ACC = true, ALIGN = true, F16A = false;
    const bf16_t* G; bf16_t* O;
    __device__ __forceinline__ void operator()(f32x4 (&acc)[2][2][4][2], const Unit& u, int wr, int wc, int fr, int fq) const {
        const int row0 = u.pm * BM + wr * 64 + fr, col0 = u.pn * BM + wc * 32 + 8 * fq;
        const bool mid = u.z < 2;
        const bf16_t* g0p = G + (size_t)u.z * D + col0; const bf16_t* g1p = G + (size_t)(mid ? u.z + 1 : u.z) * D + col0;
        u32x4 gq[2][2][2];
#pragma unroll
        for (int bj = 0; bj < 2; ++bj) { gq[0][bj][0] = *(const u32x4*)(g0p + (size_t)row0 * GATEC + bj * HALF); gq[0][bj][1] = *(const u32x4*)(g1p + (size_t)row0 * GATEC + bj * HALF); }
#pragma unroll
        for (int gi = 0; gi < 8; ++gi) {
            const int ai = gi >> 2, m = gi & 3; const size_t row = (size_t)(row0 + ai * HALF + m * 16);
            if (gi + 1 < 8) { const size_t row1 = (size_t)(row0 + ((gi + 1) >> 2) * HALF + ((gi + 1) & 3) * 16);
#pragma unroll
                for (int bj = 0; bj < 2; ++bj) { gq[(gi + 1) & 1][bj][0] = *(const u32x4*)(g0p + row1 * GATEC + bj * HALF); gq[(gi + 1) & 1][bj][1] = *(const u32x4*)(g1p + row1 * GATEC + bj * HALF); } }
            asm volatile("" ::: "memory");
#pragma unroll
            for (int bj = 0; bj < 2; ++bj) {
                const int col = col0 + bj * HALF;
                const u32x4 gw = gq[gi & 1][bj][0];
                f32x4 g0 = (f32x4){bf_lo(gw.x), bf_hi(gw.x), bf_lo(gw.y), bf_hi(gw.y)}, g1 = (f32x4){bf_lo(gw.z), bf_hi(gw.z), bf_lo(gw.w), bf_hi(gw.w)};
                if (mid) {
                    const u32x4 nw = gq[gi & 1][bj][1];
#pragma unroll
                    for (int j = 0; j < 2; ++j) { const unsigned a = j == 0 ? nw.x : nw.y, b = j == 0 ? nw.z : nw.w;
                        g0[2 * j] *= fast_rcp(bf_lo(a)); g0[2 * j + 1] *= fast_rcp(bf_hi(a)); g1[2 * j] *= fast_rcp(bf_lo(b)); g1[2 * j + 1] *= fast_rcp(bf_hi(b)); }
                    acc[ai][bj][m][0] *= g0; acc[ai][bj][m][1] *= g1;
                } else {
                    const f32x4 v0 = g0 * acc[ai][bj][m][0], v1 = g1 * acc[ai][bj][m][1];
                    u32x4 w; w.x = cvt_pk_bf16(v0[0], v0[1]); w.y = cvt_pk_bf16(v0[2], v0[3]); w.z = cvt_pk_bf16(v1[0], v1[1]); w.w = cvt_pk_bf16(v1[2], v1[3]);
                    *(u32x4*)(O + row * D + col) = w; }
            }
            asm volatile("" : "+v"(acc[ai][0][m][0]), "+v"(acc[ai][0][m][1]), "+v"(acc[ai][1][m][0]), "+v"(acc[ai][1][m][1]));
        }
    }
};
}

template <bool F16>
__device__ __forceinline__ void tr_item(const float* W, int ldw, bf16_t* WT, int ldt, int k0, int n0, int c0, float scale, LAS float* scr, int lane) {
    float wv[32];
#pragma unroll
    for (int i = 0; i < 32; ++i) wv[i] = W[(size_t)(k0 + 2 * i + (lane >> 5)) * ldw + c0 + (lane & 31)];
#pragma unroll
    for (int i = 0; i < 32; ++i) scr[(2 * i + (lane >> 5)) * 33 + (lane & 31)] = wv[i];
    asm volatile("s_waitcnt lgkmcnt(0)" ::: "memory");
    const int c = lane & 7;
#pragma unroll
    for (int j = 0; j < 4; ++j) { const int n = (lane >> 3) + 8 * j; const LAS float* sp = scr + (8 * c) * 33 + n;
        u32x4 o;
        if (F16) { o.x = cvt_pk_h(sp[0 * 33] * scale, sp[1 * 33] * scale); o.y = cvt_pk_h(sp[2 * 33] * scale, sp[3 * 33] * scale); o.z = cvt_pk_h(sp[4 * 33] * scale, sp[5 * 33] * scale); o.w = cvt_pk_h(sp[6 * 33] * scale, sp[7 * 33] * scale); }
        else { o.x = cvt_pk_bf16(sp[0 * 33] * scale, sp[1 * 33] * scale); o.y = cvt_pk_bf16(sp[2 * 33] * scale, sp[3 * 33] * scale); o.z = cvt_pk_bf16(sp[4 * 33] * scale, sp[5 * 33] * scale); o.w = cvt_pk_bf16(sp[6 * 33] * scale, sp[7 * 33] * scale); }
        *(u32x4*)(WT + (size_t)(n0 + n) * ldt + k0 + 8 * c) = o; }
    asm volatile("s_waitcnt lgkmcnt(0)" ::: "memory");
}
template <int MODE>
__device__ __forceinline__ void tr_matrix(const float* W, int K, int N, int ldw, bf16_t* WT, int ldt, LAS float* scr, int gw, int ngw, int lane) {
    const int nblk = N / 32, nitems = (K / 64) * nblk;
    for (int it = gw; it < nitems; it += ngw) {
        const int kb = it / nblk, nb = it - kb * nblk, n0 = nb * 32; int c0 = n0; float scale = 1.f;
        if (MODE == 1) { const int tile = n0 >> 8, bj = (n0 >> 7) & 1, c = n0 & 127; c0 = bj * DFF + tile * 128 + c; scale = bj ? 0.6931471805599453f : LOG2E; }
        if (MODE == 2) { if (n0 < 512 || (n0 >= 768 && n0 < 1280)) scale = 0.125f * LOG2E; else if (n0 >= 2304 && n0 < 2816) scale = 0.08838834764831845f * LOG2E; }
        tr_item<(MODE == 1 || MODE == 2)>(W, ldw, WT, ldt, kb * 64, n0, c0, scale, scr, lane);
    }
}

struct AttnP {
    const bf16_t *q, *k, *v; bf16_t* o; float* lse;
    int q_rs, q_toff, kv_rs, o_rs, o_toff, lse_rs, lse_toff;
    int qpos0, qpos_tstep, k_lo, nsteps, sub_len, radius;
    float slope2, slope_tmul;
    float sink2[4];
};
__device__ __forceinline__ s16x4 vtr(const LAS unsigned char* p) {
    typedef short v4i16_t __attribute__((ext_vector_type(4)));
    return __builtin_bit_cast(s16x4, __builtin_amdgcn_ds_read_tr16_b64_v4i16((LAS v4i16_t*)p));
}
template <int DH, int NT, int MODE>
__device__ __forceinline__ void attn_item(const AttnP& P, LAS unsigned char* vl, int lane_in, const LAS unsigned char* kl = nullptr) {
    int lane = lane_in; asm volatile("" : "+v"(lane));
    constexpr bool MASK = MODE < 2, SINK = MODE == 0, LSE = MODE == 1, INLDS = MODE == 3;
    constexpr int NSTEPS = MODE == 0 ? 9 : (MODE == 1 ? 6 : 8), QTSTEP = MODE == 1 ? 16 : 0;
    constexpr float RADF = MODE == 0 ? 128.f : 64.f, SLOPE_TMUL = MODE == 0 ? 0.5f : 1.0f;
    constexpr int KS = DH / 32, ND = DH / 16, VP = DH * 2 + 32, NVL = DH / 16;
    const int fr = lane & 15, g = lane >> 4;
    bf16x8 qf[NT][KS];
#pragma unroll
    for (int i = 0; i < NT; ++i)
#pragma unroll
        for (int ks = 0; ks < KS; ++ks) qf[i][ks] = *(const bf16x8*)(P.q + (size_t)i * P.q_toff + (size_t)fr * P.q_rs + ks * 32 + g * 8);
    f32x4 o[NT][ND]; float mrun[NT], lrun[NT];
#pragma unroll
    for (int i = 0; i < NT; ++i) {
#pragma unroll
        for (int d = 0; d < ND; ++d) o[i][d] = (f32x4){0.f, 0.f, 0.f, 0.f};
        mrun[i] = SINK ? P.sink2[i] : -1e30f; lrun[i] = (SINK && g == 0) ? 1.f : 0.f; }
    bf16x8 kf[2][KS]; u32x4 vr[NVL];
    constexpr int CPR = DH / 8;
    const int kmax = P.sub_len - 1, klo = P.k_lo, kvrs = P.kv_rs;
    const bf16_t* kbase = P.k + g * 8; const bf16_t* vbase = P.v;
    if (!INLDS) {
#pragma unroll
        for (int a = 0; a < 2; ++a) { int kp = klo + 16 * a + fr; kp = kp < 0 ? 0 : (kp > kmax ? kmax : kp);
#pragma unroll
            for (int ks = 0; ks < KS; ++ks) kf[a][ks] = *(const bf16x8*)(kbase + (size_t)kp * kvrs + ks * 32); }
#pragma unroll
        for (int it = 0; it < NVL; ++it) { const int idx = it * 64 + lane, r = idx / CPR, ch = idx % CPR; int kp = klo + r; kp = kp < 0 ? 0 : (kp > kmax ? kmax : kp);
            vr[it] = *(const u32x4*)(vbase + (size_t)kp * kvrs + ch * 8); }
    }
    const LAS unsigned char* vrd = vl + (4 * g + (fr >> 2)) * VP + 8 * (fr & 3);
    const float qbase = (float)(4 * g - P.qpos0 - fr);
    for (int s = 0; s < NSTEPS; ++s) {
        const int k0 = klo + 32 * s;
        asm volatile("" ::: "memory");
        bf16x8 kc[2][KS];
        if (INLDS) {
#pragma unroll
            for (int a = 0; a < 2; ++a)
#pragma unroll
                for (int ks = 0; ks < KS; ++ks) kc[a][ks] = *(const LAS bf16x8*)(kl + (32 * s + 16 * a + fr) * VP + (ks * 32 + 8 * g) * 2);
        } else {
#pragma unroll
        for (int it = 0; it < NVL; ++it) { const int idx = it * 64 + lane, r = idx / CPR, ch = idx % CPR; *(LAS u32x4*)(vl + r * VP + ch * 16) = vr[it]; }
#pragma unroll
        for (int a = 0; a < 2; ++a)
#pragma unroll
            for (int ks = 0; ks < KS; ++ks) kc[a][ks] = kf[a][ks];
        }
        if (!INLDS && s + 1 < NSTEPS) {
            const int k1 = k0 + 32;
#pragma unroll
            for (int a = 0; a < 2; ++a) { int kp = k1 + 16 * a + fr; kp = kp < 0 ? 0 : (kp > kmax ? kmax : kp);
#pragma unroll
                for (int ks = 0; ks < KS; ++ks) kf[a][ks] = *(const bf16x8*)(kbase + (size_t)kp * kvrs + ks * 32); }
#pragma unroll
            for (int it = 0; it < NVL; ++it) { const int idx = it * 64 + lane, r = idx / CPR, ch = idx % CPR; int kp = k1 + r; kp = kp < 0 ? 0 : (kp > kmax ? kmax : kp);
                vr[it] = *(const u32x4*)(vbase + (size_t)kp * kvrs + ch * 8); }
        }
        asm volatile("s_waitcnt lgkmcnt(0)" ::: "memory");
        const bool edge = (k0 < 0) || (k0 + 31 > kmax);
        const float kf0 = (float)k0 + qbase;
        float koff[2][4];
#pragma unroll
        for (int a = 0; a < 2; ++a)
#pragma unroll
            for (int r = 0; r < 4; ++r) { koff[a][r] = (float)(16 * a + r); if (MASK && edge) { const int kp = k0 + 16 * a + 4 * g + r; if (kp < 0 || kp > kmax) koff[a][r] = INFINITY; } }
        bf16x8 pf[NT]; float alv[NT]; bool act[NT];
#pragma unroll
        for (int i = 0; i < NT; ++i) {
            act[i] = !(MODE == 1) || (s >= (i >> 1) && s <= (i >> 1) + 4);
            if (!act[i]) { alv[i] = 1.0f; continue; }
            f32x4 sc[2];
#pragma unroll
            for (int a = 0; a < 2; ++a) { sc[a] = (f32x4){0.f, 0.f, 0.f, 0.f};
#pragma unroll
                for (int ks = 0; ks < KS; ++ks) sc[a] = __builtin_amdgcn_mfma_f32_16x16x32_bf16(kc[a][ks], qf[i][ks], sc[a], 0, 0, 0); }
            if (MASK) {
                float slope = P.slope2;
#pragma unroll
                for (int t = 0; t < i; ++t) slope *= SLOPE_TMUL;
                const float base = kf0 - (float)(i * QTSTEP);
#pragma unroll
                for (int a = 0; a < 2; ++a)
#pragma unroll
                    for (int r = 0; r < 4; ++r) { const float ad = fabsf(base + koff[a][r]);
                        sc[a][r] = (ad <= RADF) ? fmaf(-slope, ad, sc[a][r]) : -INFINITY; }
            }
            float mx = fmaxf(fmaxf(fmaxf(sc[0][0], sc[0][1]), fmaxf(sc[0][2], sc[0][3])), fmaxf(fmaxf(sc[1][0], sc[1][1]), fmaxf(sc[1][2], sc[1][3])));
            mx = rowgrp_max(mx);
            const float mnew = fmaxf(mrun[i], mx); alv[i] = fast_exp2(mrun[i] - mnew);
            mrun[i] = mnew;
            float ps = 0.f;
#pragma unroll
            for (int a = 0; a < 2; ++a)
#pragma unroll
                for (int r = 0; r < 4; ++r) { const float p = fast_exp2(sc[a][r] - mnew); sc[a][r] = p; ps += p; }
            lrun[i] = lrun[i] * alv[i] + ps;
            union { bf16x8 v; unsigned u[4]; } pk;
            pk.u[0] = cvt_pk_bf16(sc[0][0], sc[0][1]); pk.u[1] = cvt_pk_bf16(sc[0][2], sc[0][3]); pk.u[2] = cvt_pk_bf16(sc[1][0], sc[1][1]); pk.u[3] = cvt_pk_bf16(sc[1][2], sc[1][3]);
            pf[i] = pk.v;
        }
        bool resc[NT];
#pragma unroll
        for (int i = 0; i < NT; ++i) resc[i] = act[i];
#pragma unroll
        for (int d = 0; d < ND; ++d) {
            const LAS unsigned char* vs = INLDS ? vrd + s * 32 * VP : vrd;
            const s16x4 lo = vtr(vs + d * 32), hi = vtr(vs + 16 * VP + d * 32);
            const bf16x8 vt = (bf16x8){lo[0], lo[1], lo[2], lo[3], hi[0], hi[1], hi[2], hi[3]};
#pragma unroll
            for (int i = 0; i < NT; ++i) { if (resc[i]) o[i][d] = o[i][d] * alv[i]; if (act[i]) o[i][d] = __builtin_amdgcn_mfma_f32_16x16x32_bf16(vt, pf[i], o[i][d], 0, 0, 0); }
        }
        asm volatile("" ::: "memory");
    }
#pragma unroll
    for (int i = 0; i < NT; ++i) {
        const float l = rowgrp_sum(lrun[i]);
        const float inv = 1.0f / l;
        bf16_t* orow = P.o + (size_t)i * P.o_toff + (size_t)fr * P.o_rs + 4 * g;
#pragma unroll
        for (int d = 0; d < ND; ++d) { u32x2 w; w.x = cvt_pk_bf16(o[i][d][0] * inv, o[i][d][1] * inv); w.y = cvt_pk_bf16(o[i][d][2] * inv, o[i][d][3] * inv); *(u32x2*)(orow + 16 * d) = w; }
        if (LSE) { if (g == 0) P.lse[(size_t)i * P.lse_toff + (size_t)fr * P.lse_rs] = mrun[i] + __log2f(l); }
    }
}

struct Args {
    const float* in[19];
    float* out; unsigned char* ws;
};

__global__ void __launch_bounds__(512, 2) mega_fwd(Args args) {
    extern __shared__ __attribute__((aligned(16))) unsigned char lds_raw[];
    LAS unsigned char* lds = (LAS unsigned char*)lds_raw;
    cg::grid_group grid = cg::this_grid();
    const int G = gridDim.x, bx = blockIdx.x;
    volatile LAS unsigned* MISC = (volatile LAS unsigned*)(lds + LDS_MISC);
    if (threadIdx.x < 32) MISC[threadIdx.x] = 0u;
    __syncthreads();
    grid.sync();
    const XcdBarrier bar = xcd_barrier_post((unsigned*)(args.ws + WS_CTL), MISC + 8);
    constexpr int PH_PER_CHUNK = NLAYER * 9, NPH = 2 + NCHUNK * PH_PER_CHUNK;
    for (int ph_i = 0; ph_i < NPH; ++ph_i) {
        int ph = ph_i; asm volatile("" : "+s"(ph));
        int lane = threadIdx.x & 63; asm volatile("" : "+v"(lane));
        const int wave = __builtin_amdgcn_readfirstlane(threadIdx.x >> 6);
        const int vcu = (G % 8 == 0) ? (bx % 8) * (G / 8) + bx / 8 : bx;
        const int gw = vcu * 8 + wave, NGW = G * 8;
        unsigned char* ws = args.ws;
        bf16_t* Wb = (bf16_t*)(ws + WS_W); bf16_t* Wmem = (bf16_t*)(ws + WS_WMEM); bf16_t* memb = (bf16_t*)(ws + WS_MEMB); bf16_t* memkv = (bf16_t*)(ws + WS_MEMKV);
        bf16_t* hb = (bf16_t*)(ws + WS_U + U_H); bf16_t* proj = (bf16_t*)(ws + WS_U + U_PROJ); bf16_t* gates = (bf16_t*)(ws + WS_U + U_GATES); bf16_t* br = (bf16_t*)(ws + WS_U + U_BR);
        bf16_t* bpart = (bf16_t*)(ws + WS_U + U_BPART); float* lseb = (float*)(ws + WS_U + U_LSE); float* mixf = (float*)(ws + WS_U + U_MIXF); bf16_t* mixb = (bf16_t*)(ws + WS_U + U_MIXB);
        int load_chunk = -1;
        if (ph == 0) { for (int rep = 0; rep < REP_PRO; ++rep) {
            LAS float* scr = (LAS float*)(lds + wave * 16384);
            for (int l = 0; l < NLAYER; ++l) {
                bf16_t* WL = Wb + (size_t)l * W_LAYER_ELEMS;
                tr_matrix<1>(args.in[4] + (size_t)l * D * 2 * DFF, D, 2 * DFF, 2 * DFF, WL + OFF_W1IN, D, scr, gw, NGW, lane);
                tr_matrix<0>(args.in[5] + (size_t)l * DFF * D, DFF, D, D, WL + OFF_W1OUT, DFF, scr, gw, NGW, lane);
                tr_matrix<2>(args.in[8] + (size_t)l * D * INC, D, INC, INC, WL + OFF_WIN, D, scr, gw, NGW, lane);
                tr_matrix<0>(args.in[9] + (size_t)l * D * 1024, D, 1024, 1024, Wmem + (size_t)l * 1024 * D, D, scr, gw, NGW, lane);
                for (int i = 0; i < 3; ++i) tr_matrix<0>(args.in[11] + ((size_t)l * 3 + i) * 512 * D, 512, D, D, WL + OFF_WBR + (size_t)i * D * 512, 512, scr, gw, NGW, lane);
                tr_matrix<0>(args.in[12] + (size_t)l * D * D, D, D, D, WL + OFF_WOUT, D, scr, gw, NGW, lane);
                tr_matrix<1>(args.in[15] + (size_t)l * D * 2 * DFF, D, 2 * DFF, 2 * DFF, WL + OFF_W2IN, D, scr, gw, NGW, lane);
                tr_matrix<0>(args.in[16] + (size_t)l * DFF * D, DFF, D, D, WL + OFF_W2OUT, DFF, scr, gw, NGW, lane);
            }
            for (int m = gw; m < MEMROWS; m += NGW) {
                const float* src = (m < 4096) ? args.in[2] + (size_t)m * D : args.in[3] + (size_t)(m - 4096) * D;
#pragma unroll
                for (int j = 0; j < 4; ++j) { const f32x4 v = *((const f32x4*)src + lane + 64 * j); u32x2 w; w.x = cvt_pk_bf16(v[0], v[1]); w.y = cvt_pk_bf16(v[2], v[3]); *((u32x2*)(memb + (size_t)m * D) + lane + 64 * j) = w; }
            } }
            load_chunk = 0;
        } else if (ph == 1) {
            pg8::Gemm g{memb, Wmem, MEMROWS, 2048, D, D, D, 0, 0}; pg8::Order S; S.init(MEMROWS, 2048, 1, G, bx);
            pg8::EpiBf16Plain E{memkv, 2048};
            pg8::gemm_phase(lds, g, S, E);
        } else {
            const int q = ph - 2, c = q / PH_PER_CHUNK, r = q - c * PH_PER_CHUNK;
            const bool is_prompt = c < 2;
            float* X = args.out + (size_t)c * TC * D;
            const int L = is_prompt ? 2048 : 8192;
            bf16_t* xb = (bf16_t*)(ws + ((c & 1) ? WS_XB : WS_X16));
            {
                const int l = r / 9, k = r - l * 9;
                const bf16_t* WL = Wb + (size_t)l * W_LAYER_ELEMS;
                if (k == 0 || k == 7) {
                    pg8::Gemm g{xb, WL + (k == 0 ? OFF_W1IN : OFF_W2IN), TC, 2 * DFF, D, D, D, 0, 0}; pg8::Order S; S.init(TC, 2 * DFF, 1, G, bx); pg8::EpiSwiglu E{hb, DFF}; for (int rep = 0; rep < REP_UP; ++rep) pg8::gemm_phase(lds, g, S, E);
                } else if (k == 1 || k == 8 || k == 6) {
                    const bool ffn = (k != 6); const int sidx = (k == 1) ? 0 : (k == 6 ? 1 : 2);
                    const bool last = (l == NLAYER - 1 && k == 8);
                    pg8::Gemm g{ffn ? hb : mixb, WL + (k == 1 ? OFF_W1OUT : (k == 8 ? OFF_W2OUT : OFF_WOUT)), TC, D, ffn ? DFF : D, ffn ? DFF : D, ffn ? DFF : D, 0, 0};
                    pg8::Order S; S.init(TC, D, 1, G, bx);
                    const int nuse = (c * NLAYER + l) * 3 + sidx;
                    pg8::EpiResidLN E{last ? X : nullptr, xb, args.in[sidx == 0 ? 6 : (sidx == 1 ? 13 : 17)] + l * D, args.in[sidx == 0 ? 7 : (sidx == 1 ? 14 : 18)] + l * D, ffn ? 0.5f : 1.0f,
                                      (unsigned long long*)(ws + WS_CTL + CTL_XBUF), (unsigned*)(ws + WS_CTL + 16384), 32u * (unsigned)(nuse + 1)};
                    pg8::gemm_phase(lds, g, S, E);
                    if (last && c + 1 < NCHUNK) load_chunk = c + 1;
                } else if (k == 2) {
                    pg8::Gemm g{xb, WL + OFF_WIN, TC, INC, D, D, D, 0, 0}; pg8::Order S; S.init(TC, INC, 1, G, bx); pg8::EpiInproj E{proj, gates}; for (int rep = 0; rep < REP_INPROJ; ++rep) pg8::gemm_phase(lds, g, S, E);
                } else if (k == 3) {
                    LAS unsigned char* vl = lds + wave * 9216;
                    const float* sink = args.in[10] + l * 8;
                    const int memrow0 = is_prompt ? c * 8 * NMEM : 4096 + (c - 2) * 2 * NMEM;
                    for (int rep = 0; rep < REP_ATT; ++rep) {
                    for (int u = vcu; u < 256; u += G) {
                        const int nqb = L / 256; const int qb = u % nqb, hh = (u / nqb) & 3, sq = u / (nqb * 4);
                        const bf16_t* mb = memkv + (size_t)(memrow0 + sq * NMEM) * 2048 + l * 1024 + hh * 128;
                        __syncthreads();
#pragma unroll 2
                        for (int j = 0; j < 8; ++j) { const int idx = j * 512 + (int)threadIdx.x, rrow = idx >> 4, pc = idx & 15;
                            const u32x4 kv = *(const u32x4*)(mb + (size_t)rrow * 2048 + pc * 8), vv = *(const u32x4*)(mb + 512 + (size_t)rrow * 2048 + pc * 8);
                            *(LAS u32x4*)(lds + rrow * 288 + pc * 16) = kv; *(LAS u32x4*)(lds + 73728 + rrow * 288 + pc * 16) = vv; }
                        __syncthreads();
                        AttnP P;
                        const int tok0 = sq * L + qb * 256 + wave * 32;
                        P.q = proj + (size_t)tok0 * PROJC + 2304 + hh * 128; P.q_rs = PROJC; P.q_toff = 16 * PROJC;
                        P.k = mb; P.v = mb + 512; P.kv_rs = 2048;
                        P.o = br + (size_t)tok0 * BRC + 1024 + hh * 128; P.o_rs = BRC; P.o_toff = 16 * BRC; P.lse = nullptr; P.lse_rs = 0; P.lse_toff = 0;
                        P.qpos0 = 0; P.qpos_tstep = 0; P.k_lo = 0; P.nsteps = 8; P.sub_len = NMEM; P.radius = 1 << 20;
                        P.slope2 = 0.f; P.slope_tmul = 1.f;
#pragma unroll
                        for (int i = 0; i < 4; ++i) P.sink2[i] = 0.f;
                        attn_item<128, 2, 3>(P, lds + 73728, lane, lds);
                    }
                    __syncthreads();
                    for (int it = gw; it < 4 * 2048; it += NGW) {
                        const int type = it >> 11, id = it & 2047;
                        AttnP P;
                        if (type == 0) {
                            const int hk = id & 1, tb = id >> 1; const int tok0 = tb * 16; const int sq = tok0 / L, pos0 = tok0 - sq * L;
                            const bf16_t* base = proj + (size_t)(sq * L) * PROJC;
                            P.q = proj + (size_t)tok0 * PROJC + hk * 256; P.q_rs = PROJC; P.q_toff = 64;
                            P.k = base + 512 + hk * 64; P.v = base + 512 + 128 + hk * 64; P.kv_rs = PROJC;
                            P.o = br + (size_t)tok0 * BRC + hk * 256; P.o_rs = BRC; P.o_toff = 64; P.lse = nullptr; P.lse_rs = 0; P.lse_toff = 0;
                            P.qpos0 = pos0; P.qpos_tstep = 0; P.k_lo = pos0 - 128; P.nsteps = 9; P.sub_len = L; P.radius = 128;
                            P.slope2 = LOG2E * exp2f(-(float)(hk * 4 + 1)); P.slope_tmul = 0.5f;
#pragma unroll
                            for (int i = 0; i < 4; ++i) P.sink2[i] = sink[hk * 4 + i] * LOG2E;
                            attn_item<64, 4, 0>(P, vl, lane);
                        } else {
                            const int cfg = type - 1, dil = cfg == 0 ? 1 : (cfg == 1 ? 4 : 16);
                            const int h = id & 7, blk = id >> 3;
                            const int sub_len = L / dil, bps = sub_len / 64;
                            const int sr = blk / bps, jb = blk - sr * bps; const int sq = sr / dil, rs = sr - sq * dil; const int j0 = jb * 64;
                            const bf16_t* base = proj + (size_t)(sq * L + rs) * PROJC + 768 + h * 64;
                            const size_t tok0 = (size_t)sq * L + rs + (size_t)j0 * dil;
                            P.q = proj + tok0 * PROJC + 768 + h * 64; P.q_rs = PROJC * dil; P.q_toff = 16 * PROJC * dil;
                            P.k = base + 512; P.v = base + 1024; P.kv_rs = PROJC * dil;
                            P.o = bpart + (size_t)cfg * TC * 512 + tok0 * 512 + h * 64; P.o_rs = 512 * dil; P.o_toff = 16 * 512 * dil;
                            P.lse = lseb + (size_t)cfg * TC * 8 + tok0 * 8 + h; P.lse_rs = 8 * dil; P.lse_toff = 16 * 8 * dil;
                            P.qpos0 = j0; P.qpos_tstep = 16; P.k_lo = j0 - 64; P.nsteps = 6; P.sub_len = sub_len; P.radius = 64;
                            P.slope2 = LOG2E * exp2f(-(float)(h + 1)) * (float)dil; P.slope_tmul = 1.0f;
#pragma unroll
                            for (int i = 0; i < 4; ++i) P.sink2[i] = 0.f;
                            attn_item<64, 4, 1>(P, vl, lane);
                        }
                    }
                    }
                } else if (k == 4) {
                    for (int rep = 0; rep < REP_CMB; ++rep) for (int m0 = gw; m0 < TC; m0 += 4 * NGW) {
                        const int h = lane >> 3;
                        float l0[4], l1[4], l2[4]; u32x4 a[4], b[4], cc[4];
#pragma unroll
                        for (int r = 0; r < 4; ++r) { const int mm = m0 + r * NGW; const size_t m = (size_t)(mm < TC ? mm : m0);
                            l0[r] = lseb[m * 8 + h]; l1[r] = lseb[(size_t)TC * 8 + m * 8 + h]; l2[r] = lseb[(size_t)2 * TC * 8 + m * 8 + h];
                            a[r] = *((const u32x4*)(bpart + m * 512) + lane); b[r] = *((const u32x4*)(bpart + (size_t)TC * 512 + m * 512) + lane); cc[r] = *((const u32x4*)(bpart + (size_t)2 * TC * 512 + m * 512) + lane); }
#pragma unroll
                        for (int r = 0; r < 4; ++r) { const int mm = m0 + r * NGW; if (mm >= TC) continue;
                            const float mx = fmaxf(l0[r], fmaxf(l1[r], l2[r])); float w0 = fast_exp2(l0[r] - mx), w1 = fast_exp2(l1[r] - mx), w2 = fast_exp2(l2[r] - mx); const float inv = 1.0f / (w0 + w1 + w2); w0 *= inv; w1 *= inv; w2 *= inv;
                            u32x4 w;
                            w.x = cvt_pk_bf16(w0 * bf_lo(a[r].x) + w1 * bf_lo(b[r].x) + w2 * bf_lo(cc[r].x), w0 * bf_hi(a[r].x) + w1 * bf_hi(b[r].x) + w2 * bf_hi(cc[r].x));
                            w.y = cvt_pk_bf16(w0 * bf_lo(a[r].y) + w1 * bf_lo(b[r].y) + w2 * bf_lo(cc[r].y), w0 * bf_hi(a[r].y) + w1 * bf_hi(b[r].y) + w2 * bf_hi(cc[r].y));
                            w.z = cvt_pk_bf16(w0 * bf_lo(a[r].z) + w1 * bf_lo(b[r].z) + w2 * bf_lo(cc[r].z), w0 * bf_hi(a[r].z) + w1 * bf_hi(b[r].z) + w2 * bf_hi(cc[r].z));
                            w.w = cvt_pk_bf16(w0 * bf_lo(a[r].w) + w1 * bf_lo(b[r].w) + w2 * bf_lo(cc[r].w), w0 * bf_hi(a[r].w) + w1 * bf_hi(b[r].w) + w2 * bf_hi(cc[r].w));
                            *((u32x4*)(br + (size_t)mm * BRC + 512) + lane) = w; }
                    }
                } else {
                    pg8::Gemm g{br, WL + OFF_WBR, TC, D, 512, BRC, 512, 512, (size_t)D * 512}; pg8::Order S; S.init(TC, D, 3, G, bx); pg8::EpiBranch E{gates, mixb}; for (int rep = 0; rep < REP_BR; ++rep) pg8::gemm_phase(lds, g, S, E);
                }
            }
        }
        if (load_chunk >= 0) {
            const float* xin = load_chunk < 2 ? args.in[0] + (size_t)load_chunk * TC * D : args.in[1] + (size_t)(load_chunk - 2) * TC * D;
            bf16_t* xnext = (bf16_t*)(ws + ((load_chunk & 1) ? WS_XB : WS_X16));
            for (int m0 = gw; m0 < TC; m0 += 4 * NGW) {
                f32x4 v[4][4];
#pragma unroll
                for (int r = 0; r < 4; ++r) { const int mm = m0 + r * NGW; const size_t m = (size_t)(mm < TC ? mm : m0);
#pragma unroll
                    for (int j = 0; j < 4; ++j) v[r][j] = *((const f32x4*)(xin + m * D) + lane + 64 * j); }
#pragma unroll
                for (int r = 0; r < 4; ++r) { const int mm = m0 + r * NGW; if (mm >= TC) continue;
#pragma unroll
                    for (int j = 0; j < 4; ++j) { u32x2 w; w.x = cvt_pk_h(v[r][j][0], v[r][j][1]); w.y = cvt_pk_h(v[r][j][2], v[r][j][3]); *((u32x2*)(xnext + (size_t)mm * D) + lane + 64 * j) = w; } }
            }
        }
        for (int rep = 0; rep < REP_SYNC; ++rep) xcd_barrier(bar);
    }
}

extern "C" void kernel_launch(void* const* d_in, const int* in_sizes, int n_in, void* d_out, int out_size, void* d_ws, size_t ws_size, hipStream_t stream) {
    static int grid = 0;
    if (grid == 0) {
        if (n_in != 19 || ws_size < WS_END) { fprintf(stderr, "kernel_launch: need 19 inputs and %zu bytes of workspace; got %d, %zu\n", (size_t)WS_END, n_in, ws_size); grid = -1; return; }
        int dev = 0, cus = 0, per_cu = 0;
        hipGetDevice(&dev); hipDeviceGetAttribute(&cus, hipDeviceAttributeMultiprocessorCount, dev);
        if (hipFuncSetAttribute((const void*)mega_fwd, hipFuncAttributeMaxDynamicSharedMemorySize, LDS_BYTES) != hipSuccess) { fprintf(stderr, "kernel_launch: hipFuncSetAttribute failed\n"); grid = -1; return; }
        if (hipOccupancyMaxActiveBlocksPerMultiprocessor(&per_cu, (const void*)mega_fwd, 512, LDS_BYTES) != hipSuccess || per_cu < 1) { fprintf(stderr, "kernel_launch: occupancy query says %d\n", per_cu); per_cu = 1; }
        (void)hipGetLastError();
        grid = cus;
        if (grid != 256) { fprintf(stderr, "kernel_launch: built for a 256-CU device (fused LayerNorm epilogue needs one 256x256 unit per workgroup); got %d CUs\n", cus); grid = -1; return; }
    }
    if (grid < 0) return;
    if (hipMemsetAsync((char*)d_ws + WS_CTL, 0, CTL_BYTES, stream) != hipSuccess) { fprintf(stderr, "kernel_launch: memset failed\n"); return; }
    Args a{};
    for (int i = 0; i < 19; ++i) a.in[i] = (const float*)d_in[i];
    a.out = (float*)d_out; a.ws = (unsigned char*)d_ws;
    void* kargs[] = {&a};
    hipError_t e = hipLaunchCooperativeKernel((const void*)mega_fwd, dim3(grid), dim3(512), kargs, LDS_BYTES, stream);
    if (e != hipSuccess) fprintf(stderr, "cooperative launch failed: %s (grid %d)\n", hipGetErrorString(e), grid);
}
```

```cpp
#include <hip/hip_runtime.h>
#include <hip/hip_cooperative_groups.h>
#include <cstdio>
#include <cstdint>
namespace cg = cooperative_groups;

#define LAS __attribute__((address_space(3)))
typedef unsigned short bf16_t;
typedef short bf16x8 __attribute__((ext_vector_type(8)));
typedef short s16x4 __attribute__((ext_vector_type(4)));
typedef float f32x4 __attribute__((ext_vector_type(4)));
typedef float f32x2 __attribute__((ext_vector_type(2)));
typedef unsigned u32x4 __attribute__((ext_vector_type(4)));
typedef unsigned u32x2 __attribute__((ext_vector_type(2)));

constexpr int D = 1024, DFF = 2816, NLAYER = 2;
constexpr int TC = 16384;
constexpr int NCHUNK = 4;
constexpr int INC = 5888, PROJC = 2816, GATEC = 3072, BRC = 1536;
constexpr int NMEM = 256, MEMROWS = 5120;
constexpr float LN_EPS = 1e-5f;
constexpr float ALPHA = 1.41421356237309515f;
constexpr float LOG2E = 1.44269504088896341f;

constexpr size_t MiB = 1u << 20;
constexpr size_t W_LAYER_ELEMS = (size_t)5632 * 1024 + (size_t)1024 * 2816 + (size_t)5888 * 1024 + (size_t)3 * 1024 * 512 + (size_t)1024 * 1024 + (size_t)5632 * 1024 + (size_t)1024 * 2816;
constexpr size_t OFF_W1IN = 0, OFF_W1OUT = OFF_W1IN + (size_t)5632 * 1024, OFF_WIN = OFF_W1OUT + (size_t)1024 * 2816, OFF_WBR = OFF_WIN + (size_t)5888 * 1024,
                 OFF_WOUT = OFF_WBR + (size_t)3 * 1024 * 512, OFF_W2IN = OFF_WOUT + (size_t)1024 * 1024, OFF_W2OUT = OFF_W2IN + (size_t)5632 * 1024;
constexpr size_t WS_W = 0;
constexpr size_t WS_WMEM = 100 * MiB;
constexpr size_t WS_MEMB = 108 * MiB;
constexpr size_t WS_MEMKV = 118 * MiB;
constexpr size_t WS_XB = 158 * MiB;
constexpr size_t WS_U = 190 * MiB;
constexpr size_t U_H = 0;
constexpr size_t U_PROJ = 0;
constexpr size_t U_GATES = 88 * MiB;
constexpr size_t U_BR = 184 * MiB;
constexpr size_t U_BPART = 232 * MiB;
constexpr size_t U_LSE = 280 * MiB;
constexpr size_t U_MIXF = 0;
constexpr size_t U_MIXB = 232 * MiB;
constexpr size_t WS_X16 = WS_U + 282 * MiB;
constexpr size_t WS_CTL = WS_X16 + 32 * MiB;
constexpr size_t CTL_BYTES = 32768;
constexpr size_t CTL_XBUF = 65536;
constexpr size_t WS_END = WS_CTL + 1 * MiB;
static_assert(W_LAYER_ELEMS * 2 * 2 <= 100 * MiB, "weights fit");

constexpr int REP_ATT = 1, REP_UP = 1, REP_INPROJ = 1, REP_BR = 1, REP_PRO = 1, REP_SYNC = 1, REP_CMB = 1;
constexpr int LDS_BYTES = 147456 + 256;
constexpr int LDS_MISC = 147456;

__device__ __forceinline__ unsigned cvt_pk_bf16(float lo, float hi) { unsigned r; asm("v_cvt_pk_bf16_f32 %0, %1, %2" : "=v"(r) : "v"(lo), "v"(hi)); return r; }
__device__ __forceinline__ float bf_lo(unsigned u) { return __uint_as_float(u << 16); }
__device__ __forceinline__ float bf_hi(unsigned u) { return __uint_as_float(u & 0xffff0000u); }
typedef _Float16 f16x2 __attribute__((ext_vector_type(2)));
typedef _Float16 f16x8 __attribute__((ext_vector_type(8)));
__device__ __forceinline__ unsigned cvt_pk_h(float lo, float hi) { const f16x2 v = {(_Float16)lo, (_Float16)hi}; return __builtin_bit_cast(unsigned, v); }
__device__ __forceinline__ float h_lo(unsigned u) { return (float)__builtin_bit_cast(f16x2, u)[0]; }
__device__ __forceinline__ float h_hi(unsigned u) { return (float)__builtin_bit_cast(f16x2, u)[1]; }
__device__ __forceinline__ float fast_exp2(float x) { return __builtin_amdgcn_exp2f(x); }
__device__ __forceinline__ float fast_rcp(float x) { return __builtin_amdgcn_rcpf(x); }
__device__ __forceinline__ float sigmoidf_fast(float v) { return fast_rcp(1.0f + fast_exp2(-LOG2E * v)); }
__device__ __forceinline__ float rowgrp_max(float m) {
    const auto r = __builtin_amdgcn_permlane16_swap(__float_as_uint(m), __float_as_uint(m), false, false);
    const float a = fmaxf(__uint_as_float(r[0]), __uint_as_float(r[1]));
    const auto r2 = __builtin_amdgcn_permlane32_swap(__float_as_uint(a), __float_as_uint(a), false, false);
    return fmaxf(__uint_as_float(r2[0]), __uint_as_float(r2[1]));
}
__device__ __forceinline__ float rowgrp_sum(float m) {
    const auto r = __builtin_amdgcn_permlane16_swap(__float_as_uint(m), __float_as_uint(m), false, false);
    const float a = __uint_as_float(r[0]) + __uint_as_float(r[1]);
    const auto r2 = __builtin_amdgcn_permlane32_swap(__float_as_uint(a), __float_as_uint(a), false, false);
    return __uint_as_float(r2[0]) + __uint_as_float(r2[1]);
}
__device__ __forceinline__ float wave_sum(float v) {
#pragma unroll
    for (int o = 1; o < 64; o <<= 1) v += __shfl_xor(v, o);
    return v;
}

#define XB_TMO      128
#define XB_XCNT(j)  (256  + 64 * (j))
#define XB_XSUB(j)  (1280 + 64 * (j))
#define XB_XGEN(j)  (2304 + 64 * (j))
#define XB_TOP      3328
#define XB_TOPGEN   3392
#define XCD_BAR_WORDS 3456
#define XB_SPIN_CAP (1u << 18)

__device__ __forceinline__ unsigned xb_ld(unsigned* p)              { return __hip_atomic_load(p, __ATOMIC_RELAXED, __HIP_MEMORY_SCOPE_AGENT); }
__device__ __forceinline__ unsigned xb_add(unsigned* p, unsigned v) { return __hip_atomic_fetch_add(p, v, __ATOMIC_RELAXED, __HIP_MEMORY_SCOPE_AGENT); }
__device__ __forceinline__ unsigned xb_xcc_id() { return (unsigned)__builtin_amdgcn_s_getreg((3 << 11) | 20) & 0xFu; }
#define XB_SPIN(cond, bar) do { unsigned _sp = 0; while (cond) { __builtin_amdgcn_s_sleep(1); \
    if ((++_sp & 255u) == 0u) { if (xb_ld(&(bar)[XB_TMO])) break; if (_sp > XB_SPIN_CAP) { atomicAdd(&(bar)[XB_TMO], 1u); break; } } } } while (0)

struct XcdBarrier {
    unsigned* bar; unsigned x;
    volatile LAS unsigned* st;
};

__device__ __forceinline__ XcdBarrier xcd_barrier_post(unsigned* bar, volatile LAS unsigned* st) {
    XcdBarrier b; b.bar = bar; b.x = xb_xcc_id(); b.st = st;
    if (threadIdx.x == 0) (void)xb_add(&bar[XB_XCNT(b.x)], 1u);
    return b;
}
__device__ __forceinline__ void xcd_barrier_complete(unsigned* bar, unsigned x, unsigned& nloc, unsigned& nx) {
    const unsigned G = gridDim.x * gridDim.y * gridDim.z;
    unsigned sum, cnt, mine, sp = 0u;
    for (;;) {
        sum = 0u; cnt = 0u; mine = 0u;
#pragma unroll
        for (unsigned j = 0; j < 16; ++j) { const unsigned c = xb_ld(&bar[XB_XCNT(j)]); sum += c; cnt += (c > 0u) ? 1u : 0u; mine = (j == x) ? c : mine; }
        if (sum == G) break;
        __builtin_amdgcn_s_sleep(1);
        if ((++sp & 255u) == 0u) { if (xb_ld(&bar[XB_TMO])) break; if (sp > XB_SPIN_CAP) { atomicAdd(&bar[XB_TMO], 1u); break; } }
    }
    nloc = mine > 0u ? mine : 1u; nx = cnt > 0u ? cnt : 1u;
}

__device__ __forceinline__ void xcd_barrier(const XcdBarrier& b) {
    asm volatile("s_waitcnt vmcnt(0)" ::: "memory");
    __syncthreads();
    if (threadIdx.x == 0) {
        unsigned* bar = b.bar;
        __builtin_amdgcn_s_waitcnt(0);
        unsigned nloc = b.st[0], nx = b.st[1];
        if (nloc == 0u) { xcd_barrier_complete(bar, b.x, nloc, nx); b.st[0] = nloc; b.st[1] = nx; }
        const unsigned old = xb_add(&bar[XB_XSUB(b.x)], 1u);
        const unsigned gen = old / nloc;
        if (old + 1u == (gen + 1u) * nloc) {
            __builtin_amdgcn_fence(__ATOMIC_RELEASE, "agent");
            asm volatile("s_waitcnt vmcnt(0)" ::: "memory");
            const unsigned og = xb_add(&bar[XB_TOP], 1u);
            const unsigned tg = og / nx;
            if (og + 1u == (tg + 1u) * nx) xb_add(&bar[XB_TOPGEN], 1u);
            else XB_SPIN(xb_ld(&bar[XB_TOPGEN]) == tg, bar);
            __builtin_amdgcn_fence(__ATOMIC_ACQUIRE, "agent");
            xb_add(&bar[XB_XGEN(b.x)], 1u);
            asm volatile("s_waitcnt vmcnt(0)" ::: "memory");
        } else {
            XB_SPIN(xb_ld(&bar[XB_XGEN(b.x)]) == gen, bar);
            __builtin_amdgcn_fence(__ATOMIC_ACQUIRE, "agent");
            asm volatile("s_waitcnt vmcnt(0)" ::: "memory");
        }
    }
    __syncthreads();
}


namespace pg8 {
constexpr int BM = 256, BK = 64, HALF = 128, HTB = HALF * BK * 2, STAGE_BYTES = 8 * HTB, NXCD = 8, WGM = 4;
__host__ __device__ __forceinline__ int lds_byte(int r, int c) { const int st = (r >> 4) * 2 + (c >> 5), rr = r & 15, cc = c & 31, ob = rr * 64 + cc * 2; return st * 1024 + (ob ^ (((ob >> 9) & 1) << 5)); }
__host__ __device__ __forceinline__ void stage_rc(int b, int& R, int& C) { const int st = b / 1024, sb = b % 1024, swz = sb ^ (((sb >> 9) & 1) << 5); R = (st >> 1) * 16 + swz / 64; C = (st & 1) * 32 + (swz % 64) / 2; }
__host__ __device__ __forceinline__ int perm32(int rho) { const int n = rho >> 4, i = rho & 15; return 8 * (i >> 2) + 4 * n + (i & 3); }

struct Unit { int pm, pn, z; };
struct Gemm { const bf16_t* A; const bf16_t* Bt; int M, N, K, lda, ldb; size_t za, zb; };

struct Order {
    int nM, nN, nZ, nwg, G, c;
    __device__ void init(int M, int N, int nZ_, int G_, int c_) { nM = M / BM; nN = N / BM; nZ = nZ_; nwg = nM * nN; G = G_; c = c_; }
    __device__ bool next(int i, Unit& u) const {
        const int ti = i / nZ; u.z = i - ti * nZ;
        const long L = (long)ti * G + c; if (L >= nwg) return false;
        int wgid = (int)L; { const int q = nwg / NXCD, r = nwg % NXCD, xcd = wgid % NXCD, off = wgid / NXCD; wgid = (xcd < r ? xcd * (q + 1) : r * (q + 1) + (xcd - r) * q) + off; }
        const int nig = WGM * nN, gid = wgid / nig, fm = gid * WGM, gsz = (nM - fm) < WGM ? (nM - fm) : WGM;
        u.pm = fm + ((wgid % nig) % gsz); u.pn = (wgid % nig) / gsz; return true;
    }
};

template <class Epi>
__device__ __forceinline__ void gemm_phase(LAS unsigned char* lds, const Gemm g, const Order& S, const Epi& E) {
    int tid = threadIdx.x; asm volatile("" : "+v"(tid));
    const int wid = __builtin_amdgcn_readfirstlane(tid >> 6), lane = tid & 63, wr = wid >> 2, wc = wid & 3, fr = lane & 15, fq = lane >> 4;
    const int K = g.K, nt = K / BK;
    unsigned voffA[2], voffB[2];
#pragma unroll
    for (int i = 0; i < 2; ++i) { int R, C; stage_rc(tid * 16 + i * 8192, R, C); const int Rb = Epi::PERM ? ((R & ~31) + perm32(R & 31)) : R;
        voffA[i] = (unsigned)(R * g.lda + C) * 2u; voffB[i] = (unsigned)(Rb * g.ldb + C) * 2u; }
    const size_t kstep = (size_t)(BK * 2);
    const size_t hstepA = (size_t)HALF * g.lda * 2, hstepB = (size_t)HALF * g.ldb * 2;
    const unsigned ldsw = (unsigned)wid * 1024u;
    const int aoff = lds_byte(wr * 64 + fr, fq * 8), boff = lds_byte(wc * 32 + fr, fq * 8);
#define PG8_SA(b, h) (((b) * 2 + (h)) * HTB)
#define PG8_SB(b, h) ((4 + (b) * 2 + (h)) * HTB)
#define PG8_STAGE(bufoff, gbase, voff) do { _Pragma("unroll") for (int _i = 0; _i < 2; ++_i) \
        __builtin_amdgcn_global_load_lds((const unsigned*)((const char*)(gbase) + (voff)[_i]), (LAS unsigned*)(lds + (bufoff) + ldsw + _i * 8192), 16, 0, 0); } while (0)
#define PG8_LDA(dst, b, h) do { _Pragma("unroll") for (int m = 0; m < 4; ++m) _Pragma("unroll") for (int k = 0; k < 2; ++k) dst[m][k] = *(const LAS bf16x8*)(lds + PG8_SA(b, h) + aoff + m * 2048 + k * 1024); } while (0)
#define PG8_LDB(dst, b, h) do { _Pragma("unroll") for (int n = 0; n < 2; ++n) _Pragma("unroll") for (int k = 0; k < 2; ++k) dst[n][k] = *(const LAS bf16x8*)(lds + PG8_SB(b, h) + boff + n * 2048 + k * 1024); } while (0)
#define PG8_MMA(ai, bj, At, Bt) do { __builtin_amdgcn_s_setprio(1); _Pragma("unroll") for (int m = 0; m < 4; ++m) _Pragma("unroll") for (int n = 0; n < 2; ++n) _Pragma("unroll") for (int k = 0; k < 2; ++k) \
        acc[ai][bj][m][n] = Epi::F16A ? __builtin_amdgcn_mfma_f32_16x16x32_f16(__builtin_bit_cast(f16x8, Bt[n][k]), __builtin_bit_cast(f16x8, At[m][k]), acc[ai][bj][m][n], 0, 0, 0) \
                                      : __builtin_amdgcn_mfma_f32_16x16x32_bf16(Bt[n][k], At[m][k], acc[ai][bj][m][n], 0, 0, 0); __builtin_amdgcn_s_setprio(0); } while (0)
#define PG8_WAIT_V(n) asm volatile("s_waitcnt vmcnt(" #n ")" ::: "memory")
#define PG8_WAIT_L(n) asm volatile("s_waitcnt lgkmcnt(" #n ")" ::: "memory")
#define PG8_BAR __builtin_amdgcn_s_barrier()
#define PG8_SCHED __builtin_amdgcn_sched_barrier(0)
    Unit cur, nxt; int ui = 0;
    if (!S.next(0, cur)) return;
    f32x4 acc[2][2][4][2];
#pragma unroll
    for (int a = 0; a < 2; ++a)
#pragma unroll
        for (int b = 0; b < 2; ++b)
#pragma unroll
            for (int m = 0; m < 4; ++m)
#pragma unroll
                for (int n = 0; n < 2; ++n) acc[a][b][m][n] = (f32x4){0.f, 0.f, 0.f, 0.f};
    bf16x8 At[4][2], B0[2][2], B1[2][2];
    const char* cA = (const char*)(g.A + (size_t)cur.pm * BM * g.lda + (size_t)cur.z * g.za);
    const char* cB = (const char*)(g.Bt + (size_t)cur.pn * BM * g.ldb + (size_t)cur.z * g.zb);
    constexpr bool ALIGN_EPI = Epi::ALIGN && !Epi::AFTER_DRAIN;
    PG8_STAGE(PG8_SB(0, 0), cB, voffB); PG8_STAGE(PG8_SB(0, 1), cB + hstepB, voffB); PG8_STAGE(PG8_SA(0, 0), cA, voffA); PG8_STAGE(PG8_SA(0, 1), cA + hstepA, voffA);
    if (wr == 1) PG8_BAR;
    PG8_WAIT_V(2); PG8_BAR;
    PG8_STAGE(PG8_SB(1, 0), cB + kstep, voffB); PG8_STAGE(PG8_SA(1, 0), cA + kstep, voffA); PG8_STAGE(PG8_SB(1, 1), cB + hstepB + kstep, voffB);
    PG8_WAIT_V(6); PG8_BAR;
    for (;;) {
        const bool has_next = S.next(ui + 1, nxt);
        const char* nA = has_next ? (const char*)(g.A + (size_t)nxt.pm * BM * g.lda + (size_t)nxt.z * g.za) : cA;
        const char* nB = has_next ? (const char*)(g.Bt + (size_t)nxt.pn * BM * g.ldb + (size_t)nxt.z * g.zb) : cB;
        for (int t = 0; t < nt; t += 2) {
            const bool last = (t == nt - 2);
            const char* a1 = cA + (size_t)(t + 1) * kstep;
            const char* a2 = last ? nA : cA + (size_t)(t + 2) * kstep; const char* b2 = last ? nB : cB + (size_t)(t + 2) * kstep;
            const char* a3 = a2 + kstep; const char* b3 = b2 + kstep;
            PG8_LDB(B0, 0, 0); PG8_LDB(B1, 0, 1); PG8_SCHED; PG8_LDA(At, 0, 0); PG8_STAGE(PG8_SA(1, 1), a1 + hstepA, voffA);
            PG8_WAIT_V(8); PG8_WAIT_L(0); PG8_BAR; PG8_MMA(0, 0, At, B0); PG8_MMA(0, 1, At, B1); PG8_BAR; PG8_SCHED;
            PG8_LDA(At, 0, 1); PG8_STAGE(PG8_SB(0, 0), b2, voffB); PG8_STAGE(PG8_SB(0, 1), b2 + hstepB, voffB); PG8_STAGE(PG8_SA(0, 0), a2, voffA);
            PG8_WAIT_V(8); PG8_WAIT_L(0); PG8_BAR; PG8_MMA(1, 0, At, B0); PG8_MMA(1, 1, At, B1); PG8_BAR; PG8_SCHED;
            PG8_LDB(B0, 1, 0); PG8_LDB(B1, 1, 1); PG8_SCHED; PG8_LDA(At, 1, 0); PG8_STAGE(PG8_SA(0, 1), a2 + hstepA, voffA);
            PG8_WAIT_V(8); PG8_WAIT_L(0); PG8_BAR; PG8_MMA(0, 0, At, B0); PG8_MMA(0, 1, At, B1); PG8_BAR; PG8_SCHED;
            PG8_LDA(At, 1, 1); PG8_STAGE(PG8_SB(1, 0), b3, voffB); PG8_STAGE(PG8_SB(1, 1), b3 + hstepB, voffB); PG8_STAGE(PG8_SA(1, 0), a3, voffA);
            PG8_WAIT_V(8); PG8_WAIT_L(0); PG8_BAR; PG8_MMA(1, 0, At, B0); PG8_MMA(1, 1, At, B1); PG8_BAR; PG8_SCHED;
        }
        if constexpr (ALIGN_EPI) { if (wr == 0) PG8_BAR; }
        if constexpr (!Epi::AFTER_DRAIN) E(acc, cur, wr, wc, fr, fq);
        if (!has_next) break;
        if (!(Epi::KEEP_ACC && nxt.z != 0)) {
#pragma unroll
        for (int a = 0; a < 2; ++a)
#pragma unroll
            for (int b = 0; b < 2; ++b)
#pragma unroll
                for (int m = 0; m < 4; ++m)
#pragma unroll
                    for (int n = 0; n < 2; ++n) acc[a][b][m][n] = (f32x4){0.f, 0.f, 0.f, 0.f};
        }
        cur = nxt; cA = nA; cB = nB; ++ui;
        if constexpr (ALIGN_EPI) { if (wr == 1) PG8_BAR; }
    }
    PG8_WAIT_V(0);
    if constexpr (!ALIGN_EPI) { if (wr == 0) PG8_BAR; }
    PG8_BAR;
    if constexpr (Epi::AFTER_DRAIN) E.fused(acc, cur, wr, wc, fr, fq, lds, wid, lane);
#undef PG8_SA
#undef PG8_SB
#undef PG8_STAGE
#undef PG8_LDA
#undef PG8_LDB
#undef PG8_MMA
#undef PG8_WAIT_V
#undef PG8_WAIT_L
#undef PG8_BAR
#undef PG8_SCHED
}

struct EpiSwiglu {
    static constexpr bool PERM = true, AFTER_DRAIN = false, KEEP_ACC = false, ALIGN = true, F16A = true;
    bf16_t* O; int ldc;
    __device__ __forceinline__ void operator()(const f32x4 (&acc)[2][2][4][2], const Unit& u, int wr, int wc, int fr, int fq) const {
        const int row0 = u.pm * BM + wr * 64 + fr, col0 = u.pn * HALF + wc * 32 + 8 * fq;
#pragma unroll
        for (int ai = 0; ai < 2; ++ai)
#pragma unroll
            for (int m = 0; m < 4; ++m) {
                bf16_t* rowp = O + (size_t)(row0 + ai * HALF + m * 16) * ldc + col0;
                float r[8];
#pragma unroll
                for (int n = 0; n < 2; ++n)
#pragma unroll
                    for (int j = 0; j < 4; ++j) { const float gv = acc[ai][0][m][n][j], uv = acc[ai][1][m][n][j]; r[n * 4 + j] = gv * uv * fast_rcp(1.0f + fast_exp2(-gv)); }
                u32x4 w; w.x = cvt_pk_bf16(r[0], r[1]); w.y = cvt_pk_bf16(r[2], r[3]); w.z = cvt_pk_bf16(r[4], r[5]); w.w = cvt_pk_bf16(r[6], r[7]);
                *(u32x4*)rowp = w;
            }
    }
};
struct EpiResidLN {
    static constexpr bool PERM = true, AFTER_DRAIN = true, KEEP_ACC = false, ALIGN = false, F16A = false;
    float* xout; bf16_t* X16; const float* gam; const float* bet; float beta;
    unsigned long long* xbuf; unsigned* cnt; unsigned want;
    __device__ __forceinline__ void fused(f32x4 (&acc)[2][2][4][2], const Unit& u, int wr, int wc, int fr, int fq, LAS unsigned char* lds, int wid, int lane) const {
        LAS f32x2* P = (LAS f32x2*)lds;
        LAS f32x2* S = (LAS f32x2*)(lds + 8192);
        const int row0 = u.pm * BM + wr * 64 + fr, col0 = u.pn * BM + wc * 32 + 8 * fq;
        {
            u32x4 hw[2][2];
#pragma unroll
            for (int bj = 0; bj < 2; ++bj) hw[0][bj] = *(const u32x4*)(X16 + (size_t)row0 * D + col0 + bj * HALF);
#pragma unroll
            for (int gi = 0; gi < 8; ++gi) {
                const int ai = gi >> 2, m = gi & 3;
                if (gi + 1 < 8) { const int ai1 = (gi + 1) >> 2, m1 = (gi + 1) & 3;
#pragma unroll
                    for (int bj = 0; bj < 2; ++bj) hw[(gi + 1) & 1][bj] = *(const u32x4*)(X16 + (size_t)(row0 + ai1 * HALF + m1 * 16) * D + col0 + bj * HALF); }
                asm volatile("" ::: "memory");
#pragma unroll
                for (int bj = 0; bj < 2; ++bj) { const u32x4 h = hw[gi & 1][bj];
                    const f32x4 x0 = (f32x4){h_lo(h.x), h_hi(h.x), h_lo(h.y), h_hi(h.y)}, x1 = (f32x4){h_lo(h.z), h_hi(h.z), h_lo(h.w), h_hi(h.w)};
                    acc[ai][bj][m][0] = x0 * ALPHA + acc[ai][bj][m][0] * beta; acc[ai][bj][m][1] = x1 * ALPHA + acc[ai][bj][m][1] * beta; }
                asm volatile("" : "+v"(acc[ai][0][m][0]), "+v"(acc[ai][0][m][1]), "+v"(acc[ai][1][m][0]), "+v"(acc[ai][1][m][1]));
            }
        }
#pragma unroll
        for (int ai = 0; ai < 2; ++ai)
#pragma unroll
            for (int m = 0; m < 4; ++m) {
                float s = 0.f;
#pragma unroll
                for (int bj = 0; bj < 2; ++bj)
#pragma unroll
                    for (int n = 0; n < 2; ++n) { const f32x4 x = acc[ai][bj][m][n]; s += (x[0] + x[1]) + (x[2] + x[3]); }
                s = rowgrp_sum(s);
                const float mw = s * (1.0f / 64.0f); float q = 0.f;
#pragma unroll
                for (int bj = 0; bj < 2; ++bj)
#pragma unroll
                    for (int n = 0; n < 2; ++n) { const f32x4 d = acc[ai][bj][m][n] - mw; q += (d[0] * d[0] + d[1] * d[1]) + (d[2] * d[2] + d[3] * d[3]); }
                q = rowgrp_sum(q);
                if (fq == 0) P[(ai * HALF + wr * 64 + m * 16 + fr) * 4 + wc] = (f32x2){mw, q};
            }
        asm volatile("s_waitcnt lgkmcnt(0)" ::: "memory"); __builtin_amdgcn_s_barrier(); asm volatile("" ::: "memory");
        const int row = wid * 32 + (lane & 31);
        if (lane < 32) {
            const f32x2 a = P[row * 4 + 0], b = P[row * 4 + 1], c = P[row * 4 + 2], d = P[row * 4 + 3];
            const float mt = (a.x + b.x + c.x + d.x) * 0.25f;
            const float da = a.x - mt, db = b.x - mt, dc = c.x - mt, dd = d.x - mt;
            const float m2 = (a.y + b.y) + (c.y + d.y) + 64.0f * ((da * da + db * db) + (dc * dc + dd * dd));
            unsigned long long* slot = xbuf + ((size_t)((u.pm & 63) * BM + row) * 4 + u.pn);
            __hip_atomic_store(slot, ((unsigned long long)__float_as_uint(m2) << 32) | __float_as_uint(mt), __ATOMIC_RELAXED, __HIP_MEMORY_SCOPE_AGENT);
        }
        asm volatile("s_waitcnt vmcnt(0)" ::: "memory");
        if (lane == 0) __hip_atomic_fetch_add(cnt + 64 * (u.pm & 63), 1u, __ATOMIC_RELAXED, __HIP_MEMORY_SCOPE_AGENT);
        if (wid == 0) {
            unsigned spins = 0;
            while ((unsigned)__builtin_amdgcn_readfirstlane(__hip_atomic_load(cnt + 64 * (u.pm & 63), __ATOMIC_RELAXED, __HIP_MEMORY_SCOPE_AGENT)) < want) { __builtin_amdgcn_s_sleep(2); if (++spins > (1u << 22)) break; }
            __builtin_amdgcn_fence(__ATOMIC_ACQUIRE, "agent");
        }
        asm volatile("s_waitcnt vmcnt(0) lgkmcnt(0)" ::: "memory"); __builtin_amdgcn_s_barrier(); asm volatile("" ::: "memory");
        if (lane < 32) {
            const unsigned long long* slot = xbuf + (size_t)((u.pm & 63) * BM + row) * 4; float mt[4], m2[4]; float ms = 0.f;
#pragma unroll
            for (int t = 0; t < 4; ++t) { const unsigned long long w = __hip_atomic_load(slot + t, __ATOMIC_RELAXED, __HIP_MEMORY_SCOPE_AGENT); mt[t] = __uint_as_float((unsigned)w); m2[t] = __uint_as_float((unsigned)(w >> 32)); ms += mt[t]; }
            const float mean = ms * 0.25f; float q = 0.f;
#pragma unroll
            for (int t = 0; t < 4; ++t) { const float dm = mt[t] - mean; q += m2[t] + 256.0f * dm * dm; }
            S[row] = (f32x2){mean, 1.0f / sqrtf(q * (1.0f / 1024.0f) + LN_EPS)};
        }
        asm volatile("s_waitcnt lgkmcnt(0)" ::: "memory"); __builtin_amdgcn_s_barrier(); asm volatile("" ::: "memory");
        f32x4 gv[2][2], bv[2][2];
#pragma unroll
        for (int bj = 0; bj < 2; ++bj)
#pragma unroll
            for (int n = 0; n < 2; ++n) { gv[bj][n] = *(const f32x4*)(gam + col0 + bj * HALF + 4 * n); bv[bj][n] = *(const f32x4*)(bet + col0 + bj * HALF + 4 * n); }
#pragma unroll
        for (int ai = 0; ai < 2; ++ai)
#pragma unroll
            for (int m = 0; m < 4; ++m) { const int r = ai * HALF + wr * 64 + m * 16 + fr; const f32x2 sr = S[r]; const size_t off = (size_t)(u.pm * BM + r) * D + col0;
#pragma unroll
                for (int bj = 0; bj < 2; ++bj) {
                    const f32x4 y0 = (acc[ai][bj][m][0] - sr.x) * sr.y * gv[bj][0] + bv[bj][0], y1 = (acc[ai][bj][m][1] - sr.x) * sr.y * gv[bj][1] + bv[bj][1];
                    if (xout) { *(f32x4*)(xout + off + bj * HALF) = y0; *(f32x4*)(xout + off + bj * HALF + 4) = y1; }
                    else { u32x4 hw; hw.x = cvt_pk_h(y0[0], y0[1]); hw.y = cvt_pk_h(y0[2], y0[3]); hw.z = cvt_pk_h(y1[0], y1[1]); hw.w = cvt_pk_h(y1[2], y1[3]); *(u32x4*)(X16 + off + bj * HALF) = hw; } }
                asm volatile("" ::: "memory"); }
    }
};
struct EpiInproj {
    static constexpr bool PERM = true, AFTER_DRAIN = false, KEEP_ACC = false, ALIGN = true, F16A = true;
    bf16_t* P; unsigned char* G;
    __device__ __forceinline__ void operator()(const f32x4 (&acc)[2][2][4][2], const Unit& u, int wr, int wc, int fr, int fq) const {
        const bool isg = u.pn >= 11;
        const int colt = isg ? (u.pn - 11) * BM : u.pn * BM;
        const int row0 = u.pm * BM + wr * 64 + fr, col0 = colt + wc * 32 + 8 * fq;
#pragma unroll
        for (int ai = 0; ai < 2; ++ai)
#pragma unroll
            for (int m = 0; m < 4; ++m) { const size_t row = (size_t)(row0 + ai * HALF + m * 16);
#pragma unroll
                for (int bj = 0; bj < 2; ++bj) { const f32x4 v0 = acc[ai][bj][m][0], v1 = acc[ai][bj][m][1];
                    if (isg) {
                        unsigned w0 = 0u, w1 = 0u;
#pragma unroll
                        for (int j = 0; j < 4; ++j) { w0 = __builtin_amdgcn_cvt_pk_u8_f32(fmaf(sigmoidf_fast(v0[j]), 256.0f, -0.5f), j, w0); w1 = __builtin_amdgcn_cvt_pk_u8_f32(fmaf(sigmoidf_fast(v1[j]), 256.0f, -0.5f), j, w1); }
                        *(u32x2*)(G + row * GATEC + col0 + bj * HALF) = (u32x2){w0, w1};
                    } else {
                        u32x4 w; w.x = cvt_pk_bf16(v0[0], v0[1]); w.y = cvt_pk_bf16(v0[2], v0[3]); w.z = cvt_pk_bf16(v1[0], v1[1]); w.w = cvt_pk_bf16(v1[2], v1[3]);
                        *(u32x4*)(P + row * PROJC + col0 + bj * HALF) = w; } } }
    }
};
struct EpiBf16Plain {
    static constexpr bool PERM = true, AFTER_DRAIN = false, KEEP_ACC = false, ALIGN = true, F16A = false;
    bf16_t* O; int ldc;
    __device__ __forceinline__ void operator()(const f32x4 (&acc)[2][2][4][2], const Unit& u, int wr, int wc, int fr, int fq) const {
        const int row0 = u.pm * BM + wr * 64 + fr, col0 = u.pn * BM + wc * 32 + 8 * fq;
#pragma unroll
        for (int ai = 0; ai < 2; ++ai)
#pragma unroll
            for (int m = 0; m < 4; ++m) { bf16_t* rowp = O + (size_t)(row0 + ai * HALF + m * 16) * ldc + col0;
#pragma unroll
                for (int bj = 0; bj < 2; ++bj) { const f32x4 v0 = acc[ai][bj][m][0], v1 = acc[ai][bj][m][1];
                    u32x4 w; w.x = cvt_pk_bf16(v0[0], v0[1]); w.y = cvt_pk_bf16(v0[2], v0[3]); w.z = cvt_pk_bf16(v1[0], v1[1]); w.w = cvt_pk_bf16(v1[2], v1[3]);
                    *(u32x4*)(rowp + bj * HALF) = w; } }
    }
};
struct EpiBranch {
    static constexpr bool PERM = true, AFTER_DRAIN = false, KEEP_ACC = true, ALIGN = true, F16A = false;
    const unsigned char* G; bf16_t* O;
    static __device__ __forceinline__ f32x4 dec4(unsigned w) {
        return (f32x4){fmaf((float)(w & 0xffu), 0.00390625f, 0.001953125f), fmaf((float)((w >> 8) & 0xffu), 0.00390625f, 0.001953125f),
                       fmaf((float)((w >> 16) & 0xffu), 0.00390625f, 0.001953125f), fmaf((float)(w >> 24), 0.00390625f, 0.001953125f)}; }
    __device__ __forceinline__ void operator()(f32x4 (&acc)[2][2][4][2], const Unit& u, int wr, int wc, int fr, int fq) const {
        const int row0 = u.pm * BM + wr * 64 + fr, col0 = u.pn * BM + wc * 32 + 8 * fq;
        const bool mid = u.z < 2;
        const unsigned char* g0p = G + (size_t)u.z * D + col0; const unsigned char* g1p = G + (size_t)(mid ? u.z + 1 : u.z) * D + col0;
        u32x2 gq[2][2][2];
#pragma unroll
        for (int bj = 0; bj < 2; ++bj) { gq[0][bj][0] = *(const u32x2*)(g0p + (size_t)row0 * GATEC + bj * HALF); gq[0][bj][1] = *(const u32x2*)(g1p + (size_t)row0 * GATEC + bj * HALF); }
#pragma unroll
        for (int gi = 0; gi < 8; ++gi) {
            const int ai = gi >> 2, m = gi & 3; const size_t row = (size_t)(row0 + ai * HALF + m * 16);
            if (gi + 1 < 8) { const size_t row1 = (size_t)(row0 + ((gi + 1) >> 2) * HALF + ((gi + 1) & 3) * 16);
#pragma unroll
                for (int bj = 0; bj < 2; ++bj) { gq[(gi + 1) & 1][bj][0] = *(const u32x2*)(g0p + row1 * GATEC + bj * HALF); gq[(gi + 1) & 1][bj][1] = *(const u32x2*)(g1p + row1 * GATEC + bj * HALF); } }
            asm volatile("" ::: "memory");
#pragma unroll
            for (int bj = 0; bj < 2; ++bj) {
                const int col = col0 + bj * HALF;
                const u32x2 gw = gq[gi & 1][bj][0];
                f32x4 g0 = dec4(gw.x), g1 = dec4(gw.y);
                if (mid) {
                    const u32x2 nw = gq[gi & 1][bj][1];
                    const f32x4 n0 = dec4(nw.x), n1 = dec4(nw.y);
#pragma unroll
                    for (int j = 0; j < 4; ++j) { g0[j] *= fast_rcp(n0[j]); g1[j] *= fast_rcp(n1[j]); }
                    acc[ai][bj][m][0] *= g0; acc[ai][bj][m][1] *= g1;
                } else {
                    const f32x4 v0 = g0 * acc[ai][bj][m][0], v1 = g1 * acc[ai][bj][m][1];
                    u32x4 w; w.x = cvt_pk_bf16(v0[0], v0[1]); w.y = cvt_pk_bf16(v0[2], v0[3]); w.z = cvt_pk_bf16(v1[0], v1[1]); w.w = cvt_pk_bf16(v1[2], v1[3]);
                    *(u32x4*)(O + row * D + col) = w; }
            }
            asm volatile("" : "+v"(acc[ai][0][m][0]), "+v"(acc[ai][0][m][1]), "+v"(acc[ai][1][m][0]), "+v"(acc[ai][1][m][1]));
        }
    }
};
}

template <bool F16>
__device__ __forceinline__ void tr_item(const float* W, int ldw, bf16_t* WT, int ldt, int k0, int n0, int c0, float scale, LAS float* scr, int lane) {
    float wv[32];
#pragma unroll
    for (int i = 0; i < 32; ++i) wv[i] = W[(size_t)(k0 + 2 * i + (lane >> 5)) * ldw + c0 + (lane & 31)];
#pragma unroll
    for (int i = 0; i < 32; ++i) scr[(2 * i + (lane >> 5)) * 33 + (lane & 31)] = wv[i];
    asm volatile("s_waitcnt lgkmcnt(0)" ::: "memory");
    const int c = lane & 7;
#pragma unroll
    for (int j = 0; j < 4; ++j) { const int n = (lane >> 3) + 8 * j; const LAS float* sp = scr + (8 * c) * 33 + n;
        u32x4 o;
        if (F16) { o.x = cvt_pk_h(sp[0 * 33] * scale, sp[1 * 33] * scale); o.y = cvt_pk_h(sp[2 * 33] * scale, sp[3 * 33] * scale); o.z = cvt_pk_h(sp[4 * 33] * scale, sp[5 * 33] * scale); o.w = cvt_pk_h(sp[6 * 33] * scale, sp[7 * 33] * scale); }
        else { o.x = cvt_pk_bf16(sp[0 * 33] * scale, sp[1 * 33] * scale); o.y = cvt_pk_bf16(sp[2 * 33] * scale, sp[3 * 33] * scale); o.z = cvt_pk_bf16(sp[4 * 33] * scale, sp[5 * 33] * scale); o.w = cvt_pk_bf16(sp[6 * 33] * scale, sp[7 * 33] * scale); }
        *(u32x4*)(WT + (size_t)(n0 + n) * ldt + k0 + 8 * c) = o; }
    asm volatile("s_waitcnt lgkmcnt(0)" ::: "memory");
}
template <int MODE>
__device__ __forceinline__ void tr_matrix(const float* W, int K, int N, int ldw, bf16_t* WT, int ldt, LAS float* scr, int gw, int ngw, int lane) {
    const int nblk = N / 32, nitems = (K / 64) * nblk;
    for (int it = gw; it < nitems; it += ngw) {
        const int kb = it / nblk, nb = it - kb * nblk, n0 = nb * 32; int c0 = n0; float scale = 1.f;
        if (MODE == 1) { const int tile = n0 >> 8, bj = (n0 >> 7) & 1, c = n0 & 127; c0 = bj * DFF + tile * 128 + c; scale = bj ? 0.6931471805599453f : LOG2E; }
        if (MODE == 2) { if (n0 < 512 || (n0 >= 768 && n0 < 1280)) scale = 0.125f * LOG2E; else if (n0 >= 2304 && n0 < 2816) scale = 0.08838834764831845f * LOG2E; }
        tr_item<(MODE == 1 || MODE == 2)>(W, ldw, WT, ldt, kb * 64, n0, c0, scale, scr, lane);
    }
}

struct AttnP {
    const bf16_t *q, *k, *v; bf16_t* o; float* lse;
    int q_rs, q_toff, kv_rs, o_rs, o_toff, lse_rs, lse_toff;
    int qpos0, qpos_tstep, k_lo, nsteps, sub_len, radius;
    float slope2, slope_tmul;
    float sink2[4];
};
__device__ __forceinline__ s16x4 vtr(const LAS unsigned char* p) {
    typedef short v4i16_t __attribute__((ext_vector_type(4)));
    return __builtin_bit_cast(s16x4, __builtin_amdgcn_ds_read_tr16_b64_v4i16((LAS v4i16_t*)p));
}
template <int DH, int NT, int MODE>
__device__ __forceinline__ void attn_item(const AttnP& P, LAS unsigned char* vl, int lane_in, const LAS unsigned char* kl = nullptr) {
    int lane = lane_in; asm volatile("" : "+v"(lane));
    constexpr bool MASK = MODE < 2, SINK = MODE == 0, LSE = MODE == 1, INLDS = MODE == 3;
    constexpr int NSTEPS = MODE == 0 ? 9 : (MODE == 1 ? 6 : 8), QTSTEP = MODE == 1 ? 16 : 0;
    constexpr float RADF = MODE == 0 ? 128.f : 64.f, SLOPE_TMUL = MODE == 0 ? 0.5f : 1.0f;
    constexpr int KS = DH / 32, ND = DH / 16, VP = DH * 2 + 32, NVL = DH / 16;
    const int fr = lane & 15, g = lane >> 4;
    bf16x8 qf[NT][KS];
#pragma unroll
    for (int i = 0; i < NT; ++i)
#pragma unroll
        for (int ks = 0; ks < KS; ++ks) qf[i][ks] = *(const bf16x8*)(P.q + (size_t)i * P.q_toff + (size_t)fr * P.q_rs + ks * 32 + g * 8);
    f32x4 o[NT][ND]; float mrun[NT], lrun[NT];
#pragma unroll
    for (int i = 0; i < NT; ++i) {
#pragma unroll
        for (int d = 0; d < ND; ++d) o[i][d] = (f32x4){0.f, 0.f, 0.f, 0.f};
        mrun[i] = SINK ? P.sink2[i] : -1e30f; lrun[i] = (SINK && g == 0) ? 1.f : 0.f; }
    bf16x8 kf[2][KS]; u32x4 vr[NVL];
    constexpr int CPR = DH / 8;
    const int kmax = P.sub_len - 1, klo = P.k_lo, kvrs = P.kv_rs;
    const bf16_t* kbase = P.k + g * 8; const bf16_t* vbase = P.v;
    if (!INLDS) {
#pragma unroll
        for (int a = 0; a < 2; ++a) { int kp = klo + 16 * a + fr; kp = kp < 0 ? 0 : (kp > kmax ? kmax : kp);
#pragma unroll
            for (int ks = 0; ks < KS; ++ks) kf[a][ks] = *(const bf16x8*)(kbase + (size_t)kp * kvrs + ks * 32); }
#pragma unroll
        for (int it = 0; it < NVL; ++it) { const int idx = it * 64 + lane, r = idx / CPR, ch = idx % CPR; int kp = klo + r; kp = kp < 0 ? 0 : (kp > kmax ? kmax : kp);
            vr[it] = *(const u32x4*)(vbase + (size_t)kp * kvrs + ch * 8); }
    }
    const LAS unsigned char* vrd = vl + (4 * g + (fr >> 2)) * VP + 8 * (fr & 3);
    const float qbase = (float)(4 * g - P.qpos0 - fr);
    for (int s = 0; s < NSTEPS; ++s) {
        const int k0 = klo + 32 * s;
        asm volatile("" ::: "memory");
        bf16x8 kc[2][KS];
        if (INLDS) {
#pragma unroll
            for (int a = 0; a < 2; ++a)
#pragma unroll
                for (int ks = 0; ks < KS; ++ks) kc[a][ks] = *(const LAS bf16x8*)(kl + (32 * s + 16 * a + fr) * VP + (ks * 32 + 8 * g) * 2);
        } else {
#pragma unroll
        for (int it = 0; it < NVL; ++it) { const int idx = it * 64 + lane, r = idx / CPR, ch = idx % CPR; *(LAS u32x4*)(vl + r * VP + ch * 16) = vr[it]; }
#pragma unroll
        for (int a = 0; a < 2; ++a)
#pragma unroll
            for (int ks = 0; ks < KS; ++ks) kc[a][ks] = kf[a][ks];
        }
        if (!INLDS && s + 1 < NSTEPS) {
            const int k1 = k0 + 32;
#pragma unroll
            for (int a = 0; a < 2; ++a) { int kp = k1 + 16 * a + fr; kp = kp < 0 ? 0 : (kp > kmax ? kmax : kp);
#pragma unroll
                for (int ks = 0; ks < KS; ++ks) kf[a][ks] = *(const bf16x8*)(kbase + (size_t)kp * kvrs + ks * 32); }
#pragma unroll
            for (int it = 0; it < NVL; ++it) { const int idx = it * 64 + lane, r = idx / CPR, ch = idx % CPR; int kp = k1 + r; kp = kp < 0 ? 0 : (kp > kmax ? kmax : kp);
                vr[it] = *(const u32x4*)(vbase + (size_t)kp * kvrs + ch * 8); }
        }
        asm volatile("s_waitcnt lgkmcnt(0)" ::: "memory");
        const bool edge = (k0 < 0) || (k0 + 31 > kmax);
        const float kf0 = (float)k0 + qbase;
        float koff[2][4];
#pragma unroll
        for (int a = 0; a < 2; ++a)
#pragma unroll
            for (int r = 0; r < 4; ++r) { koff[a][r] = (float)(16 * a + r); if (MASK && edge) { const int kp = k0 + 16 * a + 4 * g + r; if (kp < 0 || kp > kmax) koff[a][r] = INFINITY; } }
        bf16x8 pf[NT]; float alv[NT]; bool act[NT];
#pragma unroll
        for (int i = 0; i < NT; ++i) {
            act[i] = !(MODE == 1) || (s >= (i >> 1) && s <= (i >> 1) + 4);
            if (!act[i]) { alv[i] = 1.0f; continue; }
            f32x4 sc[2];
#pragma unroll
            for (int a = 0; a < 2; ++a) { sc[a] = (f32x4){0.f, 0.f, 0.f, 0.f};
#pragma unroll
                for (int ks = 0; ks < KS; ++ks) sc[a] = __builtin_amdgcn_mfma_f32_16x16x32_bf16(kc[a][ks], qf[i][ks], sc[a], 0, 0, 0); }
            if (MASK) {
                float slope = P.slope2;
#pragma unroll
                for (int t = 0; t < i; ++t) slope *= SLOPE_TMUL;
                const float base = kf0 - (float)(i * QTSTEP);
#pragma unroll
                for (int a = 0; a < 2; ++a)
#pragma unroll
                    for (int r = 0; r < 4; ++r) { const float ad = fabsf(base + koff[a][r]);
                        sc[a][r] = (ad <= RADF) ? fmaf(-slope, ad, sc[a][r]) : -INFINITY; }
            }
            float mx = fmaxf(fmaxf(fmaxf(sc[0][0], sc[0][1]), fmaxf(sc[0][2], sc[0][3])), fmaxf(fmaxf(sc[1][0], sc[1][1]), fmaxf(sc[1][2], sc[1][3])));
            mx = rowgrp_max(mx);
            const float mnew = fmaxf(mrun[i], mx); alv[i] = fast_exp2(mrun[i] - mnew);
            mrun[i] = mnew;
            float ps = 0.f;
#pragma unroll
            for (int a = 0; a < 2; ++a)
#pragma unroll
                for (int r = 0; r < 4; ++r) { const float p = fast_exp2(sc[a][r] - mnew); sc[a][r] = p; ps += p; }
            lrun[i] = lrun[i] * alv[i] + ps;
            union { bf16x8 v; unsigned u[4]; } pk;
            pk.u[0] = cvt_pk_bf16(sc[0][0], sc[0][1]); pk.u[1] = cvt_pk_bf16(sc[0][2], sc[0][3]); pk.u[2] = cvt_pk_bf16(sc[1][0], sc[1][1]); pk.u[3] = cvt_pk_bf16(sc[1][2], sc[1][3]);
            pf[i] = pk.v;
        }
        bool resc[NT];
#pragma unroll
        for (int i = 0; i < NT; ++i) resc[i] = act[i];
#pragma unroll
        for (int d = 0; d < ND; ++d) {
            const LAS unsigned char* vs = INLDS ? vrd + s * 32 * VP : vrd;
            const s16x4 lo = vtr(vs + d * 32), hi = vtr(vs + 16 * VP + d * 32);
            const bf16x8 vt = (bf16x8){lo[0], lo[1], lo[2], lo[3], hi[0], hi[1], hi[2], hi[3]};
#pragma unroll
            for (int i = 0; i < NT; ++i) { if (resc[i]) o[i][d] = o[i][d] * alv[i]; if (act[i]) o[i][d] = __builtin_amdgcn_mfma_f32_16x16x32_bf16(vt, pf[i], o[i][d], 0, 0, 0); }
        }
        asm volatile("" ::: "memory");
    }
#pragma unroll
    for (int i = 0; i < NT; ++i) {
        const float l = rowgrp_sum(lrun[i]);
        const float inv = 1.0f / l;
        bf16_t* orow = P.o + (size_t)i * P.o_toff + (size_t)fr * P.o_rs + 4 * g;
#pragma unroll
        for (int d = 0; d < ND; ++d) { u32x2 w; w.x = cvt_pk_bf16(o[i][d][0] * inv, o[i][d][1] * inv); w.y = cvt_pk_bf16(o[i][d][2] * inv, o[i][d][3] * inv); *(u32x2*)(orow + 16 * d) = w; }
        if (LSE) { if (g == 0) P.lse[(size_t)i * P.lse_toff + (size_t)fr * P.lse_rs] = mrun[i] + __log2f(l); }
    }
}

struct Args {
    const float* in[19];
    float* out; unsigned char* ws;
};

__global__ void __launch_bounds__(512, 2) mega_fwd(Args args) {
    extern __shared__ __attribute__((aligned(16))) unsigned char lds_raw[];
    LAS unsigned char* lds = (LAS unsigned char*)lds_raw;
    cg::grid_group grid = cg::this_grid();
    const int G = gridDim.x, bx = blockIdx.x;
    volatile LAS unsigned* MISC = (volatile LAS unsigned*)(lds + LDS_MISC);
    if (threadIdx.x < 32) MISC[threadIdx.x] = 0u;
    __syncthreads();
    grid.sync();
    const XcdBarrier bar = xcd_barrier_post((unsigned*)(args.ws + WS_CTL), MISC + 8);
    constexpr int PH_PER_CHUNK = NLAYER * 9, NPH = 2 + NCHUNK * PH_PER_CHUNK;
    for (int ph_i = 0; ph_i < NPH; ++ph_i) {
        int ph = ph_i; asm volatile("" : "+s"(ph));
        int lane = threadIdx.x & 63; asm volatile("" : "+v"(lane));
        const int wave = __builtin_amdgcn_readfirstlane(threadIdx.x >> 6);
        const int vcu = (G % 8 == 0) ? (bx % 8) * (G / 8) + bx / 8 : bx;
        const int gw = vcu * 8 + wave, NGW = G * 8;
        unsigned char* ws = args.ws;
        bf16_t* Wb = (bf16_t*)(ws + WS_W); bf16_t* Wmem = (bf16_t*)(ws + WS_WMEM); bf16_t* memb = (bf16_t*)(ws + WS_MEMB); bf16_t* memkv = (bf16_t*)(ws + WS_MEMKV);
        bf16_t* hb = (bf16_t*)(ws + WS_U + U_H); bf16_t* proj = (bf16_t*)(ws + WS_U + U_PROJ); unsigned char* gates = (unsigned char*)(ws + WS_U + U_GATES); bf16_t* br = (bf16_t*)(ws + WS_U + U_BR);
        bf16_t* bpart = (bf16_t*)(ws + WS_U + U_BPART); float* lseb = (float*)(ws + WS_U + U_LSE); float* mixf = (float*)(ws + WS_U + U_MIXF); bf16_t* mixb = (bf16_t*)(ws + WS_U + U_MIXB);
        int load_chunk = -1;
        if (ph == 0) { for (int rep = 0; rep < REP_PRO; ++rep) {
            LAS float* scr = (LAS float*)(lds + wave * 16384);
            for (int l = 0; l < NLAYER; ++l) {
                bf16_t* WL = Wb + (size_t)l * W_LAYER_ELEMS;
                tr_matrix<1>(args.in[4] + (size_t)l * D * 2 * DFF, D, 2 * DFF, 2 * DFF, WL + OFF_W1IN, D, scr, gw, NGW, lane);
                tr_matrix<0>(args.in[5] + (size_t)l * DFF * D, DFF, D, D, WL + OFF_W1OUT, DFF, scr, gw, NGW, lane);
                tr_matrix<2>(args.in[8] + (size_t)l * D * INC, D, INC, INC, WL + OFF_WIN, D, scr, gw, NGW, lane);
                tr_matrix<0>(args.in[9] + (size_t)l * D * 1024, D, 1024, 1024, Wmem + (size_t)l * 1024 * D, D, scr, gw, NGW, lane);
                for (int i = 0; i < 3; ++i) tr_matrix<0>(args.in[11] + ((size_t)l * 3 + i) * 512 * D, 512, D, D, WL + OFF_WBR + (size_t)i * D * 512, 512, scr, gw, NGW, lane);
                tr_matrix<0>(args.in[12] + (size_t)l * D * D, D, D, D, WL + OFF_WOUT, D, scr, gw, NGW, lane);
                tr_matrix<1>(args.in[15] + (size_t)l * D * 2 * DFF, D, 2 * DFF, 2 * DFF, WL + OFF_W2IN, D, scr, gw, NGW, lane);
                tr_matrix<0>(args.in[16] + (size_t)l * DFF * D, DFF, D, D, WL + OFF_W2OUT, DFF, scr, gw, NGW, lane);
            }
            for (int m = gw; m < MEMROWS; m += NGW) {
                const float* src = (m < 4096) ? args.in[2] + (size_t)m * D : args.in[3] + (size_t)(m - 4096) * D;
#pragma unroll
                for (int j = 0; j < 4; ++j) { const f32x4 v = *((const f32x4*)src + lane + 64 * j); u32x2 w; w.x = cvt_pk_bf16(v[0], v[1]); w.y = cvt_pk_bf16(v[2], v[3]); *((u32x2*)(memb + (size_t)m * D) + lane + 64 * j) = w; }
            } }
            load_chunk = 0;
        } else if (ph == 1) {
            pg8::Gemm g{memb, Wmem, MEMROWS, 2048, D, D, D, 0, 0}; pg8::Order S; S.init(MEMROWS, 2048, 1, G, bx);
            pg8::EpiBf16Plain E{memkv, 2048};
            pg8::gemm_phase(lds, g, S, E);
        } else {
            const int q = ph - 2, c = q / PH_PER_CHUNK, r = q - c * PH_PER_CHUNK;
            const bool is_prompt = c < 2;
            float* X = args.out + (size_t)c * TC * D;
            const int L = is_prompt ? 2048 : 8192;
            bf16_t* xb = (bf16_t*)(ws + ((c & 1) ? WS_XB : WS_X16));
            {
                const int l = r / 9, k = r - l * 9;
                const bf16_t* WL = Wb + (size_t)l * W_LAYER_ELEMS;
                if (k == 0 || k == 7) {
                    pg8::Gemm g{xb, WL + (k == 0 ? OFF_W1IN : OFF_W2IN), TC, 2 * DFF, D, D, D, 0, 0}; pg8::Order S; S.init(TC, 2 * DFF, 1, G, bx); pg8::EpiSwiglu E{hb, DFF}; for (int rep = 0; rep < REP_UP; ++rep) pg8::gemm_phase(lds, g, S, E);
                } else if (k == 1 || k == 8 || k == 6) {
                    const bool ffn = (k != 6); const int sidx = (k == 1) ? 0 : (k == 6 ? 1 : 2);
                    const bool last = (l == NLAYER - 1 && k == 8);
                    pg8::Gemm g{ffn ? hb : mixb, WL + (k == 1 ? OFF_W1OUT : (k == 8 ? OFF_W2OUT : OFF_WOUT)), TC, D, ffn ? DFF : D, ffn ? DFF : D, ffn ? DFF : D, 0, 0};
                    pg8::Order S; S.init(TC, D, 1, G, bx);
                    const int nuse = (c * NLAYER + l) * 3 + sidx;
                    pg8::EpiResidLN E{last ? X : nullptr, xb, args.in[sidx == 0 ? 6 : (sidx == 1 ? 13 : 17)] + l * D, args.in[sidx == 0 ? 7 : (sidx == 1 ? 14 : 18)] + l * D, ffn ? 0.5f : 1.0f,
                                      (unsigned long long*)(ws + WS_CTL + CTL_XBUF), (unsigned*)(ws + WS_CTL + 16384), 32u * (unsigned)(nuse + 1)};
                    pg8::gemm_phase(lds, g, S, E);
                    if (last && c + 1 < NCHUNK) load_chunk = c + 1;
                } else if (k == 2) {
                    pg8::Gemm g{xb, WL + OFF_WIN, TC, INC, D, D, D, 0, 0}; pg8::Order S; S.init(TC, INC, 1, G, bx); pg8::EpiInproj E{proj, gates}; for (int rep = 0; rep < REP_INPROJ; ++rep) pg8::gemm_phase(lds, g, S, E);
                } else if (k == 3) {
                    LAS unsigned char* vl = lds + wave * 9216;
                    const float* sink = args.in[10] + l * 8;
                    const int memrow0 = is_prompt ? c * 8 * NMEM : 4096 + (c - 2) * 2 * NMEM;
                    for (int rep = 0; rep < REP_ATT; ++rep) {
                    for (int u = vcu; u < 256; u += G) {
                        const int nqb = L / 256; const int qb = u % nqb, hh = (u / nqb) & 3, sq = u / (nqb * 4);
                        const bf16_t* mb = memkv + (size_t)(memrow0 + sq * NMEM) * 2048 + l * 1024 + hh * 128;
                        __syncthreads();
#pragma unroll 2
                        for (int j = 0; j < 8; ++j) { const int idx = j * 512 + (int)threadIdx.x, rrow = idx >> 4, pc = idx & 15;
                            const u32x4 kv = *(const u32x4*)(mb + (size_t)rrow * 2048 + pc * 8), vv = *(const u32x4*)(mb + 512 + (size_t)rrow * 2048 + pc * 8);
                            *(LAS u32x4*)(lds + rrow * 288 + pc * 16) = kv; *(LAS u32x4*)(lds + 73728 + rrow * 288 + pc * 16) = vv; }
                        __syncthreads();
                        AttnP P;
                        const int tok0 = sq * L + qb * 256 + wave * 32;
                        P.q = proj + (size_t)tok0 * PROJC + 2304 + hh * 128; P.q_rs = PROJC; P.q_toff = 16 * PROJC;
                        P.k = mb; P.v = mb + 512; P.kv_rs = 2048;
                        P.o = br + (size_t)tok0 * BRC + 1024 + hh * 128; P.o_rs = BRC; P.o_toff = 16 * BRC; P.lse = nullptr; P.lse_rs = 0; P.lse_toff = 0;
                        P.qpos0 = 0; P.qpos_tstep = 0; P.k_lo = 0; P.nsteps = 8; P.sub_len = NMEM; P.radius = 1 << 20;
                        P.slope2 = 0.f; P.slope_tmul = 1.f;
#pragma unroll
                        for (int i = 0; i < 4; ++i) P.sink2[i] = 0.f;
                        attn_item<128, 2, 3>(P, lds + 73728, lane, lds);
                    }
                    __syncthreads();
                    for (int it = gw; it < 4 * 2048; it += NGW) {
                        const int type = it >> 11, id = it & 2047;
                        AttnP P;
                        if (type == 0) {
                            const int hk = id & 1, tb = id >> 1; const int tok0 = tb * 16; const int sq = tok0 / L, pos0 = tok0 - sq * L;
                            const bf16_t* base = proj + (size_t)(sq * L) * PROJC;
                            P.q = proj + (size_t)tok0 * PROJC + hk * 256; P.q_rs = PROJC; P.q_toff = 64;
                            P.k = base + 512 + hk * 64; P.v = base + 512 + 128 + hk * 64; P.kv_rs = PROJC;
                            P.o = br + (size_t)tok0 * BRC + hk * 256; P.o_rs = BRC; P.o_toff = 64; P.lse = nullptr; P.lse_rs = 0; P.lse_toff = 0;
                            P.qpos0 = pos0; P.qpos_tstep = 0; P.k_lo = pos0 - 128; P.nsteps = 9; P.sub_len = L; P.radius = 128;
                            P.slope2 = LOG2E * exp2f(-(float)(hk * 4 + 1)); P.slope_tmul = 0.5f;
#pragma unroll
                            for (int i = 0; i < 4; ++i) P.sink2[i] = sink[hk * 4 + i] * LOG2E;
                            attn_item<64, 4, 0>(P, vl, lane);
                        } else {
                            const int cfg = type - 1, dil = cfg == 0 ? 1 : (cfg == 1 ? 4 : 16);
                            const int h = id & 7, blk = id >> 3;
                            const int sub_len = L / dil, bps = sub_len / 64;
                            const int sr = blk / bps, jb = blk - sr * bps; const int sq = sr / dil, rs = sr - sq * dil; const int j0 = jb * 64;
                            const bf16_t* base = proj + (size_t)(sq * L + rs) * PROJC + 768 + h * 64;
                            const size_t tok0 = (size_t)sq * L + rs + (size_t)j0 * dil;
                            P.q = proj + tok0 * PROJC + 768 + h * 64; P.q_rs = PROJC * dil; P.q_toff = 16 * PROJC * dil;
                            P.k = base + 512; P.v = base + 1024; P.kv_rs = PROJC * dil;
                            P.o = bpart + (size_t)cfg * TC * 512 + tok0 * 512 + h * 64; P.o_rs = 512 * dil; P.o_toff = 16 * 512 * dil;
                            P.lse = lseb + (size_t)cfg * TC * 8 + tok0 * 8 + h; P.lse_rs = 8 * dil; P.lse_toff = 16 * 8 * dil;
                            P.qpos0 = j0; P.qpos_tstep = 16; P.k_lo = j0 - 64; P.nsteps = 6; P.sub_len = sub_len; P.radius = 64;
                            P.slope2 = LOG2E * exp2f(-(float)(h + 1)) * (float)dil; P.slope_tmul = 1.0f;
#pragma unroll
                            for (int i = 0; i < 4; ++i) P.sink2[i] = 0.f;
                            attn_item<64, 4, 1>(P, vl, lane);
                        }
                    }
                    }
                } else if (k == 4) {
                    for (int rep = 0; rep < REP_CMB; ++rep) for (int m0 = gw; m0 < TC; m0 += 4 * NGW) {
                        const int h = lane >> 3;
                        float l0[4], l1[4], l2[4]; u32x4 a[4], b[4], cc[4];
#pragma unroll
                        for (int r = 0; r < 4; ++r) { const int mm = m0 + r * NGW; const size_t m = (size_t)(mm < TC ? mm : m0);
                            l0[r] = lseb[m * 8 + h]; l1[r] = lseb[(size_t)TC * 8 + m * 8 + h]; l2[r] = lseb[(size_t)2 * TC * 8 + m * 8 + h];
                            a[r] = *((const u32x4*)(bpart + m * 512) + lane); b[r] = *((const u32x4*)(bpart + (size_t)TC * 512 + m * 512) + lane); cc[r] = *((const u32x4*)(bpart + (size_t)2 * TC * 512 + m * 512) + lane); }
#pragma unroll
                        for (int r = 0; r < 4; ++r) { const int mm = m0 + r * NGW; if (mm >= TC) continue;
                            const float mx = fmaxf(l0[r], fmaxf(l1[r], l2[r])); float w0 = fast_exp2(l0[r] - mx), w1 = fast_exp2(l1[r] - mx), w2 = fast_exp2(l2[r] - mx); const float inv = 1.0f / (w0 + w1 + w2); w0 *= inv; w1 *= inv; w2 *= inv;
                            u32x4 w;
                            w.x = cvt_pk_bf16(w0 * bf_lo(a[r].x) + w1 * bf_lo(b[r].x) + w2 * bf_lo(cc[r].x), w0 * bf_hi(a[r].x) + w1 * bf_hi(b[r].x) + w2 * bf_hi(cc[r].x));
                            w.y = cvt_pk_bf16(w0 * bf_lo(a[r].y) + w1 * bf_lo(b[r].y) + w2 * bf_lo(cc[r].y), w0 * bf_hi(a[r].y) + w1 * bf_hi(b[r].y) + w2 * bf_hi(cc[r].y));
                            w.z = cvt_pk_bf16(w0 * bf_lo(a[r].z) + w1 * bf_lo(b[r].z) + w2 * bf_lo(cc[r].z), w0 * bf_hi(a[r].z) + w1 * bf_hi(b[r].z) + w2 * bf_hi(cc[r].z));
                            w.w = cvt_pk_bf16(w0 * bf_lo(a[r].w) + w1 * bf_lo(b[r].w) + w2 * bf_lo(cc[r].w), w0 * bf_hi(a[r].w) + w1 * bf_hi(b[r].w) + w2 * bf_hi(cc[r].w));
                            *((u32x4*)(br + (size_t)mm * BRC + 512) + lane) = w; }
                    }
                } else {
                    pg8::Gemm g{br, WL + OFF_WBR, TC, D, 512, BRC, 512, 512, (size_t)D * 512}; pg8::Order S; S.init(TC, D, 3, G, bx); pg8::EpiBranch E{gates, mixb}; for (int rep = 0; rep < REP_BR; ++rep) pg8::gemm_phase(lds, g, S, E);
                }
            }
        }
        if (load_chunk >= 0) {
            const float* xin = load_chunk < 2 ? args.in[0] + (size_t)load_chunk * TC * D : args.in[1] + (size_t)(load_chunk - 2) * TC * D;
            bf16_t* xnext = (bf16_t*)(ws + ((load_chunk & 1) ? WS_XB : WS_X16));
            for (int m0 = gw; m0 < TC; m0 += 4 * NGW) {
                f32x4 v[4][4];
#pragma unroll
                for (int r = 0; r < 4; ++r) { const int mm = m0 + r * NGW; const size_t m = (size_t)(mm < TC ? mm : m0);
#pragma unroll
                    for (int j = 0; j < 4; ++j) v[r][j] = *((const f32x4*)(xin + m * D) + lane + 64 * j); }
#pragma unroll
                for (int r = 0; r < 4; ++r) { const int mm = m0 + r * NGW; if (mm >= TC) continue;
#pragma unroll
                    for (int j = 0; j < 4; ++j) { u32x2 w; w.x = cvt_pk_h(v[r][j][0], v[r][j][1]); w.y = cvt_pk_h(v[r][j][2], v[r][j][3]); *((u32x2*)(xnext + (size_t)mm * D) + lane + 64 * j) = w; } }
            }
        }
        for (int rep = 0; rep < REP_SYNC; ++rep) xcd_barrier(bar);
    }
}

extern "C" void kernel_launch(void* const* d_in, const int* in_sizes, int n_in, void* d_out, int out_size, void* d_ws, size_t ws_size, hipStream_t stream) {
    static int grid = 0;
    if (grid == 0) {
        if (n_in != 19 || ws_size < WS_END) { fprintf(stderr, "kernel_launch: need 19 inputs and %zu bytes of workspace; got %d, %zu\n", (size_t)WS_END, n_in, ws_size); grid = -1; return; }
        int dev = 0, cus = 0, per_cu = 0;
        hipGetDevice(&dev); hipDeviceGetAttribute(&cus, hipDeviceAttributeMultiprocessorCount, dev);
        if (hipFuncSetAttribute((const void*)mega_fwd, hipFuncAttributeMaxDynamicSharedMemorySize, LDS_BYTES) != hipSuccess) { fprintf(stderr, "kernel_launch: hipFuncSetAttribute failed\n"); grid = -1; return; }
        if (hipOccupancyMaxActiveBlocksPerMultiprocessor(&per_cu, (const void*)mega_fwd, 512, LDS_BYTES) != hipSuccess || per_cu < 1) { fprintf(stderr, "kernel_launch: occupancy query says %d\n", per_cu); per_cu = 1; }
        (void)hipGetLastError();
        grid = cus;
        if (grid != 256) { fprintf(stderr, "kernel_launch: built for a 256-CU device (fused LayerNorm epilogue needs one 256x256 unit per workgroup); got %d CUs\n", cus); grid = -1; return; }
    }
    if (grid < 0) return;
    if (hipMemsetAsync((char*)d_ws + WS_CTL, 0, CTL_BYTES, stream) != hipSuccess) { fprintf(stderr, "kernel_launch: memset failed\n"); return; }
    Args a{};
    for (int i = 0; i < 19; ++i) a.in[i] = (const float*)d_in[i];
    a.out = (float*)d_out; a.ws = (unsigned char*)d_ws;
    void* kargs[] = {&a};
    hipError_t e = hipLaunchCooperativeKernel((const void*)mega_fwd, dim3(grid), dim3(512), kargs, LDS_BYTES, stream);
    if (e != hipSuccess) fprintf(stderr, "cooperative launch failed: %s (grid %d)\n", hipGetErrorString(e), grid);
}
```

```cpp
#include <hip/hip_runtime.h>
#include <hip/hip_cooperative_groups.h>
#include <cstdio>
#include <cstdint>
namespace cg = cooperative_groups;

#define LAS __attribute__((address_space(3)))
typedef unsigned short bf16_t;
typedef short bf16x8 __attribute__((ext_vector_type(8)));
typedef short s16x4 __attribute__((ext_vector_type(4)));
typedef float f32x4 __attribute__((ext_vector_type(4)));
typedef float f32x2 __attribute__((ext_vector_type(2)));
typedef unsigned u32x4 __attribute__((ext_vector_type(4)));
typedef unsigned u32x2 __attribute__((ext_vector_type(2)));

constexpr int D = 1024, DFF = 2816, NLAYER = 2;
constexpr int TC = 16384;
constexpr int NCHUNK = 4;
constexpr int INC = 5888, PROJC = 2816, GATEC = 3072, BRC = 1536;
constexpr int NMEM = 256, MEMROWS = 5120;
constexpr float LN_EPS = 1e-5f;
constexpr float ALPHA = 1.41421356237309515f;
constexpr float LOG2E = 1.44269504088896341f;

constexpr size_t MiB = 1u << 20;
constexpr size_t W_LAYER_ELEMS = (size_t)5632 * 1024 + (size_t)1024 * 2816 + (size_t)5888 * 1024 + (size_t)3 * 1024 * 512 + (size_t)1024 * 1024 + (size_t)5632 * 1024 + (size_t)1024 * 2816;
constexpr size_t OFF_W1IN = 0, OFF_W1OUT = OFF_W1IN + (size_t)5632 * 1024, OFF_WIN = OFF_W1OUT + (size_t)1024 * 2816, OFF_WBR = OFF_WIN + (size_t)5888 * 1024,
                 OFF_WOUT = OFF_WBR + (size_t)3 * 1024 * 512, OFF_W2IN = OFF_WOUT + (size_t)1024 * 1024, OFF_W2OUT = OFF_W2IN + (size_t)5632 * 1024;
constexpr size_t WS_W = 0;
constexpr size_t WS_WMEM = 100 * MiB;
constexpr size_t WS_MEMB = 108 * MiB;
constexpr size_t WS_MEMKV = 118 * MiB;
constexpr size_t WS_XB = 158 * MiB;
constexpr size_t WS_U = 190 * MiB;
constexpr size_t U_H = 0;
constexpr size_t U_PROJ = 0;
constexpr size_t U_GATES = 88 * MiB;
constexpr size_t U_BR = 184 * MiB;
constexpr size_t U_BPART = 232 * MiB;
constexpr size_t U_LSE = 280 * MiB;
constexpr size_t U_MIXF = 0;
constexpr size_t U_MIXB = 232 * MiB;
constexpr size_t WS_X16 = WS_U + 282 * MiB;
constexpr size_t WS_CTL = WS_X16 + 32 * MiB;
constexpr size_t CTL_BYTES = 32768;
constexpr size_t CTL_XBUF = 65536;
constexpr size_t WS_END = WS_CTL + 1 * MiB;
static_assert(W_LAYER_ELEMS * 2 * 2 <= 100 * MiB, "weights fit");

constexpr int REP_ATT = 1, REP_UP = 1, REP_INPROJ = 1, REP_BR = 1, REP_PRO = 1, REP_SYNC = 1, REP_CMB = 1;
constexpr int LDS_BYTES = 147456 + 256;
constexpr int LDS_MISC = 147456;

__device__ __forceinline__ unsigned cvt_pk_bf16(float lo, float hi) { unsigned r; asm("v_cvt_pk_bf16_f32 %0, %1, %2" : "=v"(r) : "v"(lo), "v"(hi)); return r; }
__device__ __forceinline__ float bf_lo(unsigned u) { return __uint_as_float(u << 16); }
__device__ __forceinline__ float bf_hi(unsigned u) { return __uint_as_float(u & 0xffff0000u); }
typedef _Float16 f16x2 __attribute__((ext_vector_type(2)));
typedef _Float16 f16x8 __attribute__((ext_vector_type(8)));
__device__ __forceinline__ unsigned cvt_pk_h(float lo, float hi) { const f16x2 v = {(_Float16)lo, (_Float16)hi}; return __builtin_bit_cast(unsigned, v); }
__device__ __forceinline__ float h_lo(unsigned u) { return (float)__builtin_bit_cast(f16x2, u)[0]; }
__device__ __forceinline__ float h_hi(unsigned u) { return (float)__builtin_bit_cast(f16x2, u)[1]; }
__device__ __forceinline__ float fast_exp2(float x) { return __builtin_amdgcn_exp2f(x); }
__device__ __forceinline__ float fast_rcp(float x) { return __builtin_amdgcn_rcpf(x); }
__device__ __forceinline__ float sigmoidf_fast(float v) { return fast_rcp(1.0f + fast_exp2(-LOG2E * v)); }
__device__ __forceinline__ float rowgrp_max(float m) {
    const auto r = __builtin_amdgcn_permlane16_swap(__float_as_uint(m), __float_as_uint(m), false, false);
    const float a = fmaxf(__uint_as_float(r[0]), __uint_as_float(r[1]));
    const auto r2 = __builtin_amdgcn_permlane32_swap(__float_as_uint(a), __float_as_uint(a), false, false);
    return fmaxf(__uint_as_float(r2[0]), __uint_as_float(r2[1]));
}
__device__ __forceinline__ float rowgrp_sum(float m) {
    const auto r = __builtin_amdgcn_permlane16_swap(__float_as_uint(m), __float_as_uint(m), false, false);
    const float a = __uint_as_float(r[0]) + __uint_as_float(r[1]);
    const auto r2 = __builtin_amdgcn_permlane32_swap(__float_as_uint(a), __float_as_uint(a), false, false);
    return __uint_as_float(r2[0]) + __uint_as_float(r2[1]);
}
__device__ __forceinline__ float wave_sum(float v) {
#pragma unroll
    for (int o = 1; o < 64; o <<= 1) v += __shfl_xor(v, o);
    return v;
}

#define XB_TMO      128
#define XB_XCNT(j)  (256  + 64 * (j))
#define XB_XSUB(j)  (1280 + 64 * (j))
#define XB_XGEN(j)  (2304 + 64 * (j))
#define XB_TOP      3328
#define XB_TOPGEN   3392
#define XCD_BAR_WORDS 3456
#define XB_SPIN_CAP (1u << 18)

__device__ __forceinline__ unsigned xb_ld(unsigned* p)              { return __hip_atomic_load(p, __ATOMIC_RELAXED, __HIP_MEMORY_SCOPE_AGENT); }
__device__ __forceinline__ unsigned xb_add(unsigned* p, unsigned v) { return __hip_atomic_fetch_add(p, v, __ATOMIC_RELAXED, __HIP_MEMORY_SCOPE_AGENT); }
__device__ __forceinline__ unsigned xb_xcc_id() { return (unsigned)__builtin_amdgcn_s_getreg((3 << 11) | 20) & 0xFu; }
#define XB_SPIN(cond, bar) do { unsigned _sp = 0; while (cond) { __builtin_amdgcn_s_sleep(1); \
    if ((++_sp & 255u) == 0u) { if (xb_ld(&(bar)[XB_TMO])) break; if (_sp > XB_SPIN_CAP) { atomicAdd(&(bar)[XB_TMO], 1u); break; } } } } while (0)

struct XcdBarrier {
    unsigned* bar; unsigned x;
    volatile LAS unsigned* st;
};

__device__ __forceinline__ XcdBarrier xcd_barrier_post(unsigned* bar, volatile LAS unsigned* st) {
    XcdBarrier b; b.bar = bar; b.x = xb_xcc_id(); b.st = st;
    if (threadIdx.x == 0) (void)xb_add(&bar[XB_XCNT(b.x)], 1u);
    return b;
}
__device__ __forceinline__ void xcd_barrier_complete(unsigned* bar, unsigned x, unsigned& nloc, unsigned& nx) {
    const unsigned G = gridDim.x * gridDim.y * gridDim.z;
    unsigned sum, cnt, mine, sp = 0u;
    for (;;) {
        sum = 0u; cnt = 0u; mine = 0u;
#pragma unroll
        for (unsigned j = 0; j < 16; ++j) { const unsigned c = xb_ld(&bar[XB_XCNT(j)]); sum += c; cnt += (c > 0u) ? 1u : 0u; mine = (j == x) ? c : mine; }
        if (sum == G) break;
        __builtin_amdgcn_s_sleep(1);
        if ((++sp & 255u) == 0u) { if (xb_ld(&bar[XB_TMO])) break; if (sp > XB_SPIN_CAP) { atomicAdd(&bar[XB_TMO], 1u); break; } }
    }
    nloc = mine > 0u ? mine : 1u; nx = cnt > 0u ? cnt : 1u;
}

__device__ __forceinline__ void xcd_barrier(const XcdBarrier& b) {
    asm volatile("s_waitcnt vmcnt(0)" ::: "memory");
    __syncthreads();
    if (threadIdx.x == 0) {
        unsigned* bar = b.bar;
        __builtin_amdgcn_s_waitcnt(0);
        unsigned nloc = b.st[0], nx = b.st[1];
        if (nloc == 0u) { xcd_barrier_complete(bar, b.x, nloc, nx); b.st[0] = nloc; b.st[1] = nx; }
        const unsigned old = xb_add(&bar[XB_XSUB(b.x)], 1u);
        const unsigned gen = old / nloc;
        if (old + 1u == (gen + 1u) * nloc) {
            __builtin_amdgcn_fence(__ATOMIC_RELEASE, "agent");
            asm volatile("s_waitcnt vmcnt(0)" ::: "memory");
            const unsigned og = xb_add(&bar[XB_TOP], 1u);
            const unsigned tg = og / nx;
            if (og + 1u == (tg + 1u) * nx) xb_add(&bar[XB_TOPGEN], 1u);
            else XB_SPIN(xb_ld(&bar[XB_TOPGEN]) == tg, bar);
            __builtin_amdgcn_fence(__ATOMIC_ACQUIRE, "agent");
            xb_add(&bar[XB_XGEN(b.x)], 1u);
            asm volatile("s_waitcnt vmcnt(0)" ::: "memory");
        } else {
            XB_SPIN(xb_ld(&bar[XB_XGEN(b.x)]) == gen, bar);
            __builtin_amdgcn_fence(__ATOMIC_ACQUIRE, "agent");
            asm volatile("s_waitcnt vmcnt(0)" ::: "memory");
        }
    }
    __syncthreads();
}


namespace pg8 {
constexpr int BM = 256, BK = 64, HALF = 128, HTB = HALF * BK * 2, STAGE_BYTES = 8 * HTB, NXCD = 8, WGM = 4;
__host__ __device__ __forceinline__ int lds_byte(int r, int c) { const int st = (r >> 4) * 2 + (c >> 5), rr = r & 15, cc = c & 31, ob = rr * 64 + cc * 2; return st * 1024 + (ob ^ (((ob >> 9) & 1) << 5)); }
__host__ __device__ __forceinline__ void stage_rc(int b, int& R, int& C) { const int st = b / 1024, sb = b % 1024, swz = sb ^ (((sb >> 9) & 1) << 5); R = (st >> 1) * 16 + swz / 64; C = (st & 1) * 32 + (swz % 64) / 2; }
__host__ __device__ __forceinline__ int perm32(int rho) { const int n = rho >> 4, i = rho & 15; return 8 * (i >> 2) + 4 * n + (i & 3); }

struct Unit { int pm, pn, z; };
struct Gemm { const bf16_t* A; const bf16_t* Bt; int M, N, K, lda, ldb; size_t za, zb; };

struct Order {
    int nM, nN, nZ, nwg, G, c;
    __device__ void init(int M, int N, int nZ_, int G_, int c_) { nM = M / BM; nN = N / BM; nZ = nZ_; nwg = nM * nN; G = G_; c = c_; }
    __device__ bool next(int i, Unit& u) const {
        const int ti = i / nZ; u.z = i - ti * nZ;
        const long L = (long)ti * G + c; if (L >= nwg) return false;
        int wgid = (int)L; { const int q = nwg / NXCD, r = nwg % NXCD, xcd = wgid % NXCD, off = wgid / NXCD; wgid = (xcd < r ? xcd * (q + 1) : r * (q + 1) + (xcd - r) * q) + off; }
        const int nig = WGM * nN, gid = wgid / nig, fm = gid * WGM, gsz = (nM - fm) < WGM ? (nM - fm) : WGM;
        u.pm = fm + ((wgid % nig) % gsz); u.pn = (wgid % nig) / gsz; return true;
    }
};

template <class Epi>
__device__ __forceinline__ void gemm_phase(LAS unsigned char* lds, const Gemm g, const Order& S, const Epi& E) {
    int tid = threadIdx.x; asm volatile("" : "+v"(tid));
    const int wid = __builtin_amdgcn_readfirstlane(tid >> 6), lane = tid & 63, wr = wid >> 2, wc = wid & 3, fr = lane & 15, fq = lane >> 4;
    const int K = g.K, nt = K / BK;
    unsigned voffA[2], voffB[2];
#pragma unroll
    for (int i = 0; i < 2; ++i) { int R, C; stage_rc(tid * 16 + i * 8192, R, C); const int Rb = Epi::PERM ? ((R & ~31) + perm32(R & 31)) : R;
        voffA[i] = (unsigned)(R * g.lda + C) * 2u; voffB[i] = (unsigned)(Rb * g.ldb + C) * 2u; }
    const size_t kstep = (size_t)(BK * 2);
    const size_t hstepA = (size_t)HALF * g.lda * 2, hstepB = (size_t)HALF * g.ldb * 2;
    const unsigned ldsw = (unsigned)wid * 1024u;
    const int aoff = lds_byte(wr * 64 + fr, fq * 8), boff = lds_byte(wc * 32 + fr, fq * 8);
#define PG8_SA(b, h) (((b) * 2 + (h)) * HTB)
#define PG8_SB(b, h) ((4 + (b) * 2 + (h)) * HTB)
#define PG8_STAGE(bufoff, gbase, voff) do { _Pragma("unroll") for (int _i = 0; _i < 2; ++_i) \
        __builtin_amdgcn_global_load_lds((const unsigned*)((const char*)(gbase) + (voff)[_i]), (LAS unsigned*)(lds + (bufoff) + ldsw + _i * 8192), 16, 0, 0); } while (0)
#define PG8_LDA(dst, b, h) do { _Pragma("unroll") for (int m = 0; m < 4; ++m) _Pragma("unroll") for (int k = 0; k < 2; ++k) dst[m][k] = *(const LAS bf16x8*)(lds + PG8_SA(b, h) + aoff + m * 2048 + k * 1024); } while (0)
#define PG8_LDB(dst, b, h) do { _Pragma("unroll") for (int n = 0; n < 2; ++n) _Pragma("unroll") for (int k = 0; k < 2; ++k) dst[n][k] = *(const LAS bf16x8*)(lds + PG8_SB(b, h) + boff + n * 2048 + k * 1024); } while (0)
#define PG8_MMA(ai, bj, At, Bt) do { __builtin_amdgcn_s_setprio(1); _Pragma("unroll") for (int m = 0; m < 4; ++m) _Pragma("unroll") for (int n = 0; n < 2; ++n) _Pragma("unroll") for (int k = 0; k < 2; ++k) \
        acc[ai][bj][m][n] = Epi::F16A ? __builtin_amdgcn_mfma_f32_16x16x32_f16(__builtin_bit_cast(f16x8, Bt[n][k]), __builtin_bit_cast(f16x8, At[m][k]), acc[ai][bj][m][n], 0, 0, 0) \
                                      : __builtin_amdgcn_mfma_f32_16x16x32_bf16(Bt[n][k], At[m][k], acc[ai][bj][m][n], 0, 0, 0); __builtin_amdgcn_s_setprio(0); } while (0)
#define PG8_WAIT_V(n) asm volatile("s_waitcnt vmcnt(" #n ")" ::: "memory")
#define PG8_WAIT_L(n) asm volatile("s_waitcnt lgkmcnt(" #n ")" ::: "memory")
#define PG8_BAR __builtin_amdgcn_s_barrier()
#define PG8_SCHED __builtin_amdgcn_sched_barrier(0)
    Unit cur, nxt; int ui = 0;
    if (!S.next(0, cur)) return;
    f32x4 acc[2][2][4][2];
#pragma unroll
    for (int a = 0; a < 2; ++a)
#pragma unroll
        for (int b = 0; b < 2; ++b)
#pragma unroll
            for (int m = 0; m < 4; ++m)
#pragma unroll
                for (int n = 0; n < 2; ++n) acc[a][b][m][n] = (f32x4){0.f, 0.f, 0.f, 0.f};
    bf16x8 At[4][2], B0[2][2], B1[2][2];
    const char* cA = (const char*)(g.A + (size_t)cur.pm * BM * g.lda + (size_t)cur.z * g.za);
    const char* cB = (const char*)(g.Bt + (size_t)cur.pn * BM * g.ldb + (size_t)cur.z * g.zb);
    constexpr bool ALIGN_EPI = Epi::ALIGN && !Epi::AFTER_DRAIN;
    PG8_STAGE(PG8_SB(0, 0), cB, voffB); PG8_STAGE(PG8_SB(0, 1), cB + hstepB, voffB); PG8_STAGE(PG8_SA(0, 0), cA, voffA); PG8_STAGE(PG8_SA(0, 1), cA + hstepA, voffA);
    if (wr == 1) PG8_BAR;
    PG8_WAIT_V(2); PG8_BAR;
    PG8_STAGE(PG8_SB(1, 0), cB + kstep, voffB); PG8_STAGE(PG8_SA(1, 0), cA + kstep, voffA); PG8_STAGE(PG8_SB(1, 1), cB + hstepB + kstep, voffB);
    PG8_WAIT_V(6); PG8_BAR;
    for (;;) {
        const bool has_next = S.next(ui + 1, nxt);
        const char* nA = has_next ? (const char*)(g.A + (size_t)nxt.pm * BM * g.lda + (size_t)nxt.z * g.za) : cA;
        const char* nB = has_next ? (const char*)(g.Bt + (size_t)nxt.pn * BM * g.ldb + (size_t)nxt.z * g.zb) : cB;
        for (int t = 0; t < nt; t += 2) {
            const bool last = (t == nt - 2);
            const char* a1 = cA + (size_t)(t + 1) * kstep;
            const char* a2 = last ? nA : cA + (size_t)(t + 2) * kstep; const char* b2 = last ? nB : cB + (size_t)(t + 2) * kstep;
            const char* a3 = a2 + kstep; const char* b3 = b2 + kstep;
            PG8_LDB(B0, 0, 0); PG8_LDB(B1, 0, 1); PG8_SCHED; PG8_LDA(At, 0, 0); PG8_STAGE(PG8_SA(1, 1), a1 + hstepA, voffA);
            PG8_WAIT_V(8); PG8_WAIT_L(0); PG8_BAR; PG8_MMA(0, 0, At, B0); PG8_MMA(0, 1, At, B1); PG8_BAR; PG8_SCHED;
            PG8_LDA(At, 0, 1); PG8_STAGE(PG8_SB(0, 0), b2, voffB); PG8_STAGE(PG8_SB(0, 1), b2 + hstepB, voffB); PG8_STAGE(PG8_SA(0, 0), a2, voffA);
            PG8_WAIT_V(8); PG8_WAIT_L(0); PG8_BAR; PG8_MMA(1, 0, At, B0); PG8_MMA(1, 1, At, B1); PG8_BAR; PG8_SCHED;
            PG8_LDB(B0, 1, 0); PG8_LDB(B1, 1, 1); PG8_SCHED; PG8_LDA(At, 1, 0); PG8_STAGE(PG8_SA(0, 1), a2 + hstepA, voffA);
            PG8_WAIT_V(8); PG8_WAIT_L(0); PG8_BAR; PG8_MMA(0, 0, At, B0); PG8_MMA(0, 1, At, B1); PG8_BAR; PG8_SCHED;
            PG8_LDA(At, 1, 1); PG8_STAGE(PG8_SB(1, 0), b3, voffB); PG8_STAGE(PG8_SB(1, 1), b3 + hstepB, voffB); PG8_STAGE(PG8_SA(1, 0), a3, voffA);
            PG8_WAIT_V(8); PG8_WAIT_L(0); PG8_BAR; PG8_MMA(1, 0, At, B0); PG8_MMA(1, 1, At, B1); PG8_BAR; PG8_SCHED;
        }
        if constexpr (ALIGN_EPI) { if (wr == 0) PG8_BAR; }
        if constexpr (!Epi::AFTER_DRAIN) E(acc, cur, wr, wc, fr, fq);
        if (!has_next) break;
        if (!(Epi::KEEP_ACC && nxt.z != 0)) {
#pragma unroll
        for (int a = 0; a < 2; ++a)
#pragma unroll
            for (int b = 0; b < 2; ++b)
#pragma unroll
                for (int m = 0; m < 4; ++m)
#pragma unroll
                    for (int n = 0; n < 2; ++n) acc[a][b][m][n] = (f32x4){0.f, 0.f, 0.f, 0.f};
        }
        cur = nxt; cA = nA; cB = nB; ++ui;
        if constexpr (ALIGN_EPI) { if (wr == 1) PG8_BAR; }
    }
    PG8_WAIT_V(0);
    if constexpr (!ALIGN_EPI) { if (wr == 0) PG8_BAR; }
    PG8_BAR;
    if constexpr (Epi::AFTER_DRAIN) E.fused(acc, cur, wr, wc, fr, fq, lds, wid, lane);
#undef PG8_SA
#undef PG8_SB
#undef PG8_STAGE
#undef PG8_LDA
#undef PG8_LDB
#undef PG8_MMA
#undef PG8_WAIT_V
#undef PG8_WAIT_L
#undef PG8_BAR
#undef PG8_SCHED
}

struct EpiSwiglu {
    static constexpr bool PERM = true, AFTER_DRAIN = false, KEEP_ACC = false, ALIGN = true, F16A = true;
    bf16_t* O; int ldc;
    __device__ __forceinline__ void operator()(const f32x4 (&acc)[2][2][4][2], const Unit& u, int wr, int wc, int fr, int fq) const {
        const int row0 = u.pm * BM + wr * 64 + fr, col0 = u.pn * HALF + wc * 32 + 8 * fq;
#pragma unroll
        for (int ai = 0; ai < 2; ++ai)
#pragma unroll
            for (int m = 0; m < 4; ++m) {
                bf16_t* rowp = O + (size_t)(row0 + ai * HALF + m * 16) * ldc + col0;
                float r[8];
#pragma unroll
                for (int n = 0; n < 2; ++n)
#pragma unroll
                    for (int j = 0; j < 4; ++j) { const float gv = acc[ai][0][m][n][j], uv = acc[ai][1][m][n][j]; r[n * 4 + j] = gv * uv * fast_rcp(1.0f + fast_exp2(-gv)); }
                u32x4 w; w.x = cvt_pk_bf16(r[0], r[1]); w.y = cvt_pk_bf16(r[2], r[3]); w.z = cvt_pk_bf16(r[4], r[5]); w.w = cvt_pk_bf16(r[6], r[7]);
                *(u32x4*)rowp = w;
            }
    }
};
struct EpiResidLN {
    static constexpr bool PERM = true, AFTER_DRAIN = true, KEEP_ACC = false, ALIGN = false, F16A = false;
    float* xout; bf16_t* X16; const float* gam; const float* bet; float beta;
    unsigned long long* xbuf; unsigned* cnt; unsigned want;
    __device__ __forceinline__ void fused(f32x4 (&acc)[2][2][4][2], const Unit& u, int wr, int wc, int fr, int fq, LAS unsigned char* lds, int wid, int lane) const {
        LAS f32x2* P = (LAS f32x2*)lds;
        LAS f32x2* S = (LAS f32x2*)(lds + 8192);
        const int row0 = u.pm * BM + wr * 64 + fr, col0 = u.pn * BM + wc * 32 + 8 * fq;
        {
            u32x4 hw[2][2];
#pragma unroll
            for (int bj = 0; bj < 2; ++bj) hw[0][bj] = *(const u32x4*)(X16 + (size_t)row0 * D + col0 + bj * HALF);
#pragma unroll
            for (int gi = 0; gi < 8; ++gi) {
                const int ai = gi >> 2, m = gi & 3;
                if (gi + 1 < 8) { const int ai1 = (gi + 1) >> 2, m1 = (gi + 1) & 3;
#pragma unroll
                    for (int bj = 0; bj < 2; ++bj) hw[(gi + 1) & 1][bj] = *(const u32x4*)(X16 + (size_t)(row0 + ai1 * HALF + m1 * 16) * D + col0 + bj * HALF); }
                asm volatile("" ::: "memory");
#pragma unroll
                for (int bj = 0; bj < 2; ++bj) { const u32x4 h = hw[gi & 1][bj];
                    const f32x4 x0 = (f32x4){h_lo(h.x), h_hi(h.x), h_lo(h.y), h_hi(h.y)}, x1 = (f32x4){h_lo(h.z), h_hi(h.z), h_lo(h.w), h_hi(h.w)};
                    acc[ai][bj][m][0] = x0 * ALPHA + acc[ai][bj][m][0] * beta; acc[ai][bj][m][1] = x1 * ALPHA + acc[ai][bj][m][1] * beta; }
                asm volatile("" : "+v"(acc[ai][0][m][0]), "+v"(acc[ai][0][m][1]), "+v"(acc[ai][1][m][0]), "+v"(acc[ai][1][m][1]));
            }
        }
#pragma unroll
        for (int ai = 0; ai < 2; ++ai)
#pragma unroll
            for (int m = 0; m < 4; ++m) {
                float s = 0.f;
#pragma unroll
                for (int bj = 0; bj < 2; ++bj)
#pragma unroll
                    for (int n = 0; n < 2; ++n) { const f32x4 x = acc[ai][bj][m][n]; s += (x[0] + x[1]) + (x[2] + x[3]); }
                s = rowgrp_sum(s);
                const float mw = s * (1.0f / 64.0f); float q = 0.f;
#pragma unroll
                for (int bj = 0; bj < 2; ++bj)
#pragma unroll
                    for (int n = 0; n < 2; ++n) { const f32x4 d = acc[ai][bj][m][n] - mw; q += (d[0] * d[0] + d[1] * d[1]) + (d[2] * d[2] + d[3] * d[3]); }
                q = rowgrp_sum(q);
                if (fq == 0) P[(ai * HALF + wr * 64 + m * 16 + fr) * 4 + wc] = (f32x2){mw, q};
            }
        asm volatile("s_waitcnt lgkmcnt(0)" ::: "memory"); __builtin_amdgcn_s_barrier(); asm volatile("" ::: "memory");
        const int row = wid * 32 + (lane & 31);
        if (lane < 32) {
            const f32x2 a = P[row * 4 + 0], b = P[row * 4 + 1], c = P[row * 4 + 2], d = P[row * 4 + 3];
            const float mt = (a.x + b.x + c.x + d.x) * 0.25f;
            const float da = a.x - mt, db = b.x - mt, dc = c.x - mt, dd = d.x - mt;
            const float m2 = (a.y + b.y) + (c.y + d.y) + 64.0f * ((da * da + db * db) + (dc * dc + dd * dd));
            unsigned long long* slot = xbuf + ((size_t)((u.pm & 63) * BM + row) * 4 + u.pn);
            __hip_atomic_store(slot, ((unsigned long long)__float_as_uint(m2) << 32) | __float_as_uint(mt), __ATOMIC_RELAXED, __HIP_MEMORY_SCOPE_AGENT);
        }
        asm volatile("s_waitcnt vmcnt(0)" ::: "memory");
        if (lane == 0) __hip_atomic_fetch_add(cnt + 64 * (u.pm & 63), 1u, __ATOMIC_RELAXED, __HIP_MEMORY_SCOPE_AGENT);
        if (wid == 0) {
            unsigned spins = 0;
            while ((unsigned)__builtin_amdgcn_readfirstlane(__hip_atomic_load(cnt + 64 * (u.pm & 63), __ATOMIC_RELAXED, __HIP_MEMORY_SCOPE_AGENT)) < want) { __builtin_amdgcn_s_sleep(2); if (++spins > (1u << 22)) break; }
            __builtin_amdgcn_fence(__ATOMIC_ACQUIRE, "agent");
        }
        asm volatile("s_waitcnt vmcnt(0) lgkmcnt(0)" ::: "memory"); __builtin_amdgcn_s_barrier(); asm volatile("" ::: "memory");
        if (lane < 32) {
            const unsigned long long* slot = xbuf + (size_t)((u.pm & 63) * BM + row) * 4; float mt[4], m2[4]; float ms = 0.f;
#pragma unroll
            for (int t = 0; t < 4; ++t) { const unsigned long long w = __hip_atomic_load(slot + t, __ATOMIC_RELAXED, __HIP_MEMORY_SCOPE_AGENT); mt[t] = __uint_as_float((unsigned)w); m2[t] = __uint_as_float((unsigned)(w >> 32)); ms += mt[t]; }
            const float mean = ms * 0.25f; float q = 0.f;
#pragma unroll
            for (int t = 0; t < 4; ++t) { const float dm = mt[t] - mean; q += m2[t] + 256.0f * dm * dm; }
            S[row] = (f32x2){mean, 1.0f / sqrtf(q * (1.0f / 1024.0f) + LN_EPS)};
        }
        asm volatile("s_waitcnt lgkmcnt(0)" ::: "memory"); __builtin_amdgcn_s_barrier(); asm volatile("" ::: "memory");
        f32x4 gv[2][2], bv[2][2];
#pragma unroll
        for (int bj = 0; bj < 2; ++bj)
#pragma unroll
            for (int n = 0; n < 2; ++n) { gv[bj][n] = *(const f32x4*)(gam + col0 + bj * HALF + 4 * n); bv[bj][n] = *(const f32x4*)(bet + col0 + bj * HALF + 4 * n); }
#pragma unroll
        for (int ai = 0; ai < 2; ++ai)
#pragma unroll
            for (int m = 0; m < 4; ++m) { const int r = ai * HALF + wr * 64 + m * 16 + fr; const f32x2 sr = S[r]; const size_t off = (size_t)(u.pm * BM + r) * D + col0;
#pragma unroll
                for (int bj = 0; bj < 2; ++bj) {
                    const f32x4 y0 = (acc[ai][bj][m][0] - sr.x) * sr.y * gv[bj][0] + bv[bj][0], y1 = (acc[ai][bj][m][1] - sr.x) * sr.y * gv[bj][1] + bv[bj][1];
                    if (xout) { *(f32x4*)(xout + off + bj * HALF) = y0; *(f32x4*)(xout + off + bj * HALF + 4) = y1; }
                    else { u32x4 hw; hw.x = cvt_pk_h(y0[0], y0[1]); hw.y = cvt_pk_h(y0[2], y0[3]); hw.z = cvt_pk_h(y1[0], y1[1]); hw.w = cvt_pk_h(y1[2], y1[3]); *(u32x4*)(X16 + off + bj * HALF) = hw; } }
                asm volatile("" ::: "memory"); }
    }
};
struct EpiInproj {
    static constexpr bool PERM = true, AFTER_DRAIN = false, KEEP_ACC = false, ALIGN = true, F16A = true;
    bf16_t* P; unsigned char* G;
    __device__ __forceinline__ void operator()(const f32x4 (&acc)[2][2][4][2], const Unit& u, int wr, int wc, int fr, int fq) const {
        const bool isg = u.pn >= 11;
        const int colt = isg ? (u.pn - 11) * BM : u.pn * BM;
        const int row0 = u.pm * BM + wr * 64 + fr, col0 = colt + wc * 32 + 8 * fq;
#pragma unroll
        for (int ai = 0; ai < 2; ++ai)
#pragma unroll
            for (int m = 0; m < 4; ++m) { const size_t row = (size_t)(row0 + ai * HALF + m * 16);
#pragma unroll
                for (int bj = 0; bj < 2; ++bj) { const f32x4 v0 = acc[ai][bj][m][0], v1 = acc[ai][bj][m][1];
                    if (isg) {
                        unsigned w0 = 0u, w1 = 0u;
#pragma unroll
                        for (int j = 0; j < 4; ++j) { w0 = __builtin_amdgcn_cvt_pk_u8_f32(fmaf(fast_rcp(1.0f + fast_exp2(v0[j])), 256.0f, -0.5f), j, w0); w1 = __builtin_amdgcn_cvt_pk_u8_f32(fmaf(fast_rcp(1.0f + fast_exp2(v1[j])), 256.0f, -0.5f), j, w1); }
                        *(u32x2*)(G + row * GATEC + col0 + bj * HALF) = (u32x2){w0, w1};
                    } else {
                        u32x4 w; w.x = cvt_pk_bf16(v0[0], v0[1]); w.y = cvt_pk_bf16(v0[2], v0[3]); w.z = cvt_pk_bf16(v1[0], v1[1]); w.w = cvt_pk_bf16(v1[2], v1[3]);
                        *(u32x4*)(P + row * PROJC + col0 + bj * HALF) = w; } } }
    }
};
struct EpiBf16Plain {
    static constexpr bool PERM = true, AFTER_DRAIN = false, KEEP_ACC = false, ALIGN = true, F16A = false;
    bf16_t* O; int ldc;
    __device__ __forceinline__ void operator()(const f32x4 (&acc)[2][2][4][2], const Unit& u, int wr, int wc, int fr, int fq) const {
        const int row0 = u.pm * BM + wr * 64 + fr, col0 = u.pn * BM + wc * 32 + 8 * fq;
#pragma unroll
        for (int ai = 0; ai < 2; ++ai)
#pragma unroll
            for (int m = 0; m < 4; ++m) { bf16_t* rowp = O + (size_t)(row0 + ai * HALF + m * 16) * ldc + col0;
#pragma unroll
                for (int bj = 0; bj < 2; ++bj) { const f32x4 v0 = acc[ai][bj][m][0], v1 = acc[ai][bj][m][1];
                    u32x4 w; w.x = cvt_pk_bf16(v0[0], v0[1]); w.y = cvt_pk_bf16(v0[2], v0[3]); w.z = cvt_pk_bf16(v1[0], v1[1]); w.w = cvt_pk_bf16(v1[2], v1[3]);
                    *(u32x4*)(rowp + bj * HALF) = w; } }
    }
};
struct EpiBranch {
    static constexpr bool PERM = true, AFTER_DRAIN = false, KEEP_ACC = true, ALIGN = true, F16A = false;
    const unsigned char* G; bf16_t* O;
    static __device__ __forceinline__ f32x4 dec4(unsigned w) {
        return (f32x4){fmaf((float)(w & 0xffu), 0.00390625f, 0.001953125f), fmaf((float)((w >> 8) & 0xffu), 0.00390625f, 0.001953125f),
                       fmaf((float)((w >> 16) & 0xffu), 0.00390625f, 0.001953125f), fmaf((float)(w >> 24), 0.00390625f, 0.001953125f)}; }
    __device__ __forceinline__ void operator()(f32x4 (&acc)[2][2][4][2], const Unit& u, int wr, int wc, int fr, int fq) const {
        const int row0 = u.pm * BM + wr * 64 + fr, col0 = u.pn * BM + wc * 32 + 8 * fq;
        const bool mid = u.z < 2;
        const unsigned char* g0p = G + (size_t)u.z * D + col0; const unsigned char* g1p = G + (size_t)(mid ? u.z + 1 : u.z) * D + col0;
        u32x2 gq[2][2][2];
#pragma unroll
        for (int bj = 0; bj < 2; ++bj) { gq[0][bj][0] = *(const u32x2*)(g0p + (size_t)row0 * GATEC + bj * HALF); if (mid) gq[0][bj][1] = *(const u32x2*)(g1p + (size_t)row0 * GATEC + bj * HALF); }
#pragma unroll
        for (int gi = 0; gi < 8; ++gi) {
            const int ai = gi >> 2, m = gi & 3; const size_t row = (size_t)(row0 + ai * HALF + m * 16);
            if (gi + 1 < 8) { const size_t row1 = (size_t)(row0 + ((gi + 1) >> 2) * HALF + ((gi + 1) & 3) * 16);
#pragma unroll
                for (int bj = 0; bj < 2; ++bj) { gq[(gi + 1) & 1][bj][0] = *(const u32x2*)(g0p + row1 * GATEC + bj * HALF); if (mid) gq[(gi + 1) & 1][bj][1] = *(const u32x2*)(g1p + row1 * GATEC + bj * HALF); } }
            asm volatile("" ::: "memory");
#pragma unroll
            for (int bj = 0; bj < 2; ++bj) {
                const int col = col0 + bj * HALF;
                const u32x2 gw = gq[gi & 1][bj][0];
                f32x4 g0 = dec4(gw.x), g1 = dec4(gw.y);
                if (mid) {
                    const u32x2 nw = gq[gi & 1][bj][1];
                    const f32x4 n0 = dec4(nw.x), n1 = dec4(nw.y);
#pragma unroll
                    for (int j = 0; j < 4; ++j) { g0[j] *= fast_rcp(n0[j]); g1[j] *= fast_rcp(n1[j]); }
                    acc[ai][bj][m][0] *= g0; acc[ai][bj][m][1] *= g1;
                } else {
                    const f32x4 v0 = g0 * acc[ai][bj][m][0], v1 = g1 * acc[ai][bj][m][1];
                    u32x4 w; w.x = cvt_pk_bf16(v0[0], v0[1]); w.y = cvt_pk_bf16(v0[2], v0[3]); w.z = cvt_pk_bf16(v1[0], v1[1]); w.w = cvt_pk_bf16(v1[2], v1[3]);
                    *(u32x4*)(O + row * D + col) = w; }
            }
            asm volatile("" : "+v"(acc[ai][0][m][0]), "+v"(acc[ai][0][m][1]), "+v"(acc[ai][1][m][0]), "+v"(acc[ai][1][m][1]));
        }
    }
};
}

template <bool F16>
__device__ __forceinline__ void tr_item(const float* W, int ldw, bf16_t* WT, int ldt, int k0, int n0, int c0, float scale, LAS float* scr, int lane) {
    float wv[32];
#pragma unroll
    for (int i = 0; i < 32; ++i) wv[i] = W[(size_t)(k0 + 2 * i + (lane >> 5)) * ldw + c0 + (lane & 31)];
#pragma unroll
    for (int i = 0; i < 32; ++i) scr[(2 * i + (lane >> 5)) * 33 + (lane & 31)] = wv[i];
    asm volatile("s_waitcnt lgkmcnt(0)" ::: "memory");
    const int c = lane & 7;
#pragma unroll
    for (int j = 0; j < 4; ++j) { const int n = (lane >> 3) + 8 * j; const LAS float* sp = scr + (8 * c) * 33 + n;
        u32x4 o;
        if (F16) { o.x = cvt_pk_h(sp[0 * 33] * scale, sp[1 * 33] * scale); o.y = cvt_pk_h(sp[2 * 33] * scale, sp[3 * 33] * scale); o.z = cvt_pk_h(sp[4 * 33] * scale, sp[5 * 33] * scale); o.w = cvt_pk_h(sp[6 * 33] * scale, sp[7 * 33] * scale); }
        else { o.x = cvt_pk_bf16(sp[0 * 33] * scale, sp[1 * 33] * scale); o.y = cvt_pk_bf16(sp[2 * 33] * scale, sp[3 * 33] * scale); o.z = cvt_pk_bf16(sp[4 * 33] * scale, sp[5 * 33] * scale); o.w = cvt_pk_bf16(sp[6 * 33] * scale, sp[7 * 33] * scale); }
        *(u32x4*)(WT + (size_t)(n0 + n) * ldt + k0 + 8 * c) = o; }
    asm volatile("s_waitcnt lgkmcnt(0)" ::: "memory");
}
template <int MODE>
__device__ __forceinline__ void tr_matrix(const float* W, int K, int N, int ldw, bf16_t* WT, int ldt, LAS float* scr, int gw, int ngw, int lane) {
    const int nblk = N / 32, nitems = (K / 64) * nblk;
    for (int it = gw; it < nitems; it += ngw) {
        const int kb = it / nblk, nb = it - kb * nblk, n0 = nb * 32; int c0 = n0; float scale = 1.f;
        if (MODE == 1) { const int tile = n0 >> 8, bj = (n0 >> 7) & 1, c = n0 & 127; c0 = bj * DFF + tile * 128 + c; scale = bj ? 0.6931471805599453f : LOG2E; }
        if (MODE == 2) { if (n0 < 512 || (n0 >= 768 && n0 < 1280)) scale = 0.125f * LOG2E; else if (n0 >= 2304 && n0 < 2816) scale = 0.08838834764831845f * LOG2E; else if (n0 >= 2816) scale = -LOG2E; }
        tr_item<(MODE == 1 || MODE == 2)>(W, ldw, WT, ldt, kb * 64, n0, c0, scale, scr, lane);
    }
}

struct AttnP {
    const bf16_t *q, *k, *v; bf16_t* o; float* lse;
    int q_rs, q_toff, kv_rs, o_rs, o_toff, lse_rs, lse_toff;
    int qpos0, qpos_tstep, k_lo, nsteps, sub_len, radius;
    float slope2, slope_tmul;
    float sink2[4];
};
__device__ __forceinline__ s16x4 vtr(const LAS unsigned char* p) {
    typedef short v4i16_t __attribute__((ext_vector_type(4)));
    return __builtin_bit_cast(s16x4, __builtin_amdgcn_ds_read_tr16_b64_v4i16((LAS v4i16_t*)p));
}
template <int DH, int NT, int MODE>
__device__ __forceinline__ void attn_item(const AttnP& P, LAS unsigned char* vl, int lane_in, const LAS unsigned char* kl = nullptr) {
    int lane = lane_in; asm volatile("" : "+v"(lane));
    constexpr bool MASK = MODE < 2, SINK = MODE == 0, LSE = MODE == 1, INLDS = MODE == 3;
    constexpr int NSTEPS = MODE == 0 ? 9 : (MODE == 1 ? 6 : 8), QTSTEP = MODE == 1 ? 16 : 0;
    constexpr float RADF = MODE == 0 ? 128.f : 64.f, SLOPE_TMUL = MODE == 0 ? 0.5f : 1.0f;
    constexpr int KS = DH / 32, ND = DH / 16, VP = DH * 2 + 32, NVL = DH / 16;
    const int fr = lane & 15, g = lane >> 4;
    bf16x8 qf[NT][KS];
#pragma unroll
    for (int i = 0; i < NT; ++i)
#pragma unroll
        for (int ks = 0; ks < KS; ++ks) qf[i][ks] = *(const bf16x8*)(P.q + (size_t)i * P.q_toff + (size_t)fr * P.q_rs + ks * 32 + g * 8);
    f32x4 o[NT][ND]; float mrun[NT], lrun[NT];
#pragma unroll
    for (int i = 0; i < NT; ++i) {
#pragma unroll
        for (int d = 0; d < ND; ++d) o[i][d] = (f32x4){0.f, 0.f, 0.f, 0.f};
        mrun[i] = SINK ? P.sink2[i] : -1e30f; lrun[i] = (SINK && g == 0) ? 1.f : 0.f; }
    bf16x8 kf[2][KS]; u32x4 vr[NVL];
    constexpr int CPR = DH / 8;
    const int kmax = P.sub_len - 1, klo = P.k_lo, kvrs = P.kv_rs;
    const bf16_t* kbase = P.k + g * 8; const bf16_t* vbase = P.v;
    if (!INLDS) {
#pragma unroll
        for (int a = 0; a < 2; ++a) { int kp = klo + 16 * a + fr; kp = kp < 0 ? 0 : (kp > kmax ? kmax : kp);
#pragma unroll
            for (int ks = 0; ks < KS; ++ks) kf[a][ks] = *(const bf16x8*)(kbase + (size_t)kp * kvrs + ks * 32); }
#pragma unroll
        for (int it = 0; it < NVL; ++it) { const int idx = it * 64 + lane, r = idx / CPR, ch = idx % CPR; int kp = klo + r; kp = kp < 0 ? 0 : (kp > kmax ? kmax : kp);
            vr[it] = *(const u32x4*)(vbase + (size_t)kp * kvrs + ch * 8); }
    }
    const LAS unsigned char* vrd = vl + (4 * g + (fr >> 2)) * VP + 8 * (fr & 3);
    const float qbase = (float)(4 * g - P.qpos0 - fr);
    for (int s = 0; s < NSTEPS; ++s) {
        const int k0 = klo + 32 * s;
        asm volatile("" ::: "memory");
        bf16x8 kc[2][KS];
        if (INLDS) {
#pragma unroll
            for (int a = 0; a < 2; ++a)
#pragma unroll
                for (int ks = 0; ks < KS; ++ks) kc[a][ks] = *(const LAS bf16x8*)(kl + (32 * s + 16 * a + fr) * VP + (ks * 32 + 8 * g) * 2);
        } else {
#pragma unroll
        for (int it = 0; it < NVL; ++it) { const int idx = it * 64 + lane, r = idx / CPR, ch = idx % CPR; *(LAS u32x4*)(vl + r * VP + ch * 16) = vr[it]; }
#pragma unroll
        for (int a = 0; a < 2; ++a)
#pragma unroll
            for (int ks = 0; ks < KS; ++ks) kc[a][ks] = kf[a][ks];
        }
        if (!INLDS && s + 1 < NSTEPS) {
            const int k1 = k0 + 32;
#pragma unroll
            for (int a = 0; a < 2; ++a) { int kp = k1 + 16 * a + fr; kp = kp < 0 ? 0 : (kp > kmax ? kmax : kp);
#pragma unroll
                for (int ks = 0; ks < KS; ++ks) kf[a][ks] = *(const bf16x8*)(kbase + (size_t)kp * kvrs + ks * 32); }
#pragma unroll
            for (int it = 0; it < NVL; ++it) { const int idx = it * 64 + lane, r = idx / CPR, ch = idx % CPR; int kp = k1 + r; kp = kp < 0 ? 0 : (kp > kmax ? kmax : kp);
                vr[it] = *(const u32x4*)(vbase + (size_t)kp * kvrs + ch * 8); }
        }
        asm volatile("s_waitcnt lgkmcnt(0)" ::: "memory");
        const bool edge = (k0 < 0) || (k0 + 31 > kmax);
        const float kf0 = (float)k0 + qbase;
        float koff[2][4];
#pragma unroll
        for (int a = 0; a < 2; ++a)
#pragma unroll
            for (int r = 0; r < 4; ++r) { koff[a][r] = (float)(16 * a + r); if (MASK && edge) { const int kp = k0 + 16 * a + 4 * g + r; if (kp < 0 || kp > kmax) koff[a][r] = INFINITY; } }
        bf16x8 pf[NT]; float alv[NT]; bool act[NT];
#pragma unroll
        for (int i = 0; i < NT; ++i) {
            act[i] = !(MODE == 1) || (s >= (i >> 1) && s <= (i >> 1) + 4);
            if (!act[i]) { alv[i] = 1.0f; continue; }
            f32x4 sc[2];
#pragma unroll
            for (int a = 0; a < 2; ++a) { sc[a] = (f32x4){0.f, 0.f, 0.f, 0.f};
#pragma unroll
                for (int ks = 0; ks < KS; ++ks) sc[a] = __builtin_amdgcn_mfma_f32_16x16x32_bf16(kc[a][ks], qf[i][ks], sc[a], 0, 0, 0); }
            if (MASK) {
                float slope = P.slope2;
#pragma unroll
                for (int t = 0; t < i; ++t) slope *= SLOPE_TMUL;
                const float base = kf0 - (float)(i * QTSTEP);
#pragma unroll
                for (int a = 0; a < 2; ++a)
#pragma unroll
                    for (int r = 0; r < 4; ++r) { const float ad = fabsf(base + koff[a][r]);
                        sc[a][r] = (ad <= RADF) ? fmaf(-slope, ad, sc[a][r]) : -INFINITY; }
            }
            float mx = fmaxf(fmaxf(fmaxf(sc[0][0], sc[0][1]), fmaxf(sc[0][2], sc[0][3])), fmaxf(fmaxf(sc[1][0], sc[1][1]), fmaxf(sc[1][2], sc[1][3])));
            mx = rowgrp_max(mx);
            const float mnew = fmaxf(mrun[i], mx); alv[i] = fast_exp2(mrun[i] - mnew);
            mrun[i] = mnew;
            float ps = 0.f;
#pragma unroll
            for (int a = 0; a < 2; ++a)
#pragma unroll
                for (int r = 0; r < 4; ++r) { const float p = fast_exp2(sc[a][r] - mnew); sc[a][r] = p; ps += p; }
            lrun[i] = lrun[i] * alv[i] + ps;
            union { bf16x8 v; unsigned u[4]; } pk;
            pk.u[0] = cvt_pk_bf16(sc[0][0], sc[0][1]); pk.u[1] = cvt_pk_bf16(sc[0][2], sc[0][3]); pk.u[2] = cvt_pk_bf16(sc[1][0], sc[1][1]); pk.u[3] = cvt_pk_bf16(sc[1][2], sc[1][3]);
            pf[i] = pk.v;
        }
        bool resc[NT];
#pragma unroll
        for (int i = 0; i < NT; ++i) resc[i] = act[i];
#pragma unroll
        for (int d = 0; d < ND; ++d) {
            const LAS unsigned char* vs = INLDS ? vrd + s * 32 * VP : vrd;
            const s16x4 lo = vtr(vs + d * 32), hi = vtr(vs + 16 * VP + d * 32);
            const bf16x8 vt = (bf16x8){lo[0], lo[1], lo[2], lo[3], hi[0], hi[1], hi[2], hi[3]};
#pragma unroll
            for (int i = 0; i < NT; ++i) { if (resc[i]) o[i][d] = o[i][d] * alv[i]; if (act[i]) o[i][d] = __builtin_amdgcn_mfma_f32_16x16x32_bf16(vt, pf[i], o[i][d], 0, 0, 0); }
        }
        asm volatile("" ::: "memory");
    }
#pragma unroll
    for (int i = 0; i < NT; ++i) {
        const float l = rowgrp_sum(lrun[i]);
        const float inv = 1.0f / l;
        bf16_t* orow = P.o + (size_t)i * P.o_toff + (size_t)fr * P.o_rs + 4 * g;
#pragma unroll
        for (int d = 0; d < ND; ++d) { u32x2 w; w.x = cvt_pk_bf16(o[i][d][0] * inv, o[i][d][1] * inv); w.y = cvt_pk_bf16(o[i][d][2] * inv, o[i][d][3] * inv); *(u32x2*)(orow + 16 * d) = w; }
        if (LSE) { if (g == 0) P.lse[(size_t)i * P.lse_toff + (size_t)fr * P.lse_rs] = mrun[i] + __log2f(l); }
    }
}

struct Args {
    const float* in[19];
    float* out; unsigned char* ws;
};

__global__ void __launch_bounds__(512, 2) mega_fwd(Args args) {
    extern __shared__ __attribute__((aligned(16))) unsigned char lds_raw[];
    LAS unsigned char* lds = (LAS unsigned char*)lds_raw;
    cg::grid_group grid = cg::this_grid();
    const int G = gridDim.x, bx = blockIdx.x;
    volatile LAS unsigned* MISC = (volatile LAS unsigned*)(lds + LDS_MISC);
    if (threadIdx.x < 32) MISC[threadIdx.x] = 0u;
    __syncthreads();
    grid.sync();
    const XcdBarrier bar = xcd_barrier_post((unsigned*)(args.ws + WS_CTL), MISC + 8);
    constexpr int PH_PER_CHUNK = NLAYER * 9, NPH = 2 + NCHUNK * PH_PER_CHUNK;
    for (int ph_i = 0; ph_i < NPH; ++ph_i) {
        int ph = ph_i; asm volatile("" : "+s"(ph));
        int lane = threadIdx.x & 63; asm volatile("" : "+v"(lane));
        const int wave = __builtin_amdgcn_readfirstlane(threadIdx.x >> 6);
        const int vcu = (G % 8 == 0) ? (bx % 8) * (G / 8) + bx / 8 : bx;
        const int gw = vcu * 8 + wave, NGW = G * 8;
        unsigned char* ws = args.ws;
        bf16_t* Wb = (bf16_t*)(ws + WS_W); bf16_t* Wmem = (bf16_t*)(ws + WS_WMEM); bf16_t* memb = (bf16_t*)(ws + WS_MEMB); bf16_t* memkv = (bf16_t*)(ws + WS_MEMKV);
        bf16_t* hb = (bf16_t*)(ws + WS_U + U_H); bf16_t* proj = (bf16_t*)(ws + WS_U + U_PROJ); unsigned char* gates = (unsigned char*)(ws + WS_U + U_GATES); bf16_t* br = (bf16_t*)(ws + WS_U + U_BR);
        bf16_t* bpart = (bf16_t*)(ws + WS_U + U_BPART); float* lseb = (float*)(ws + WS_U + U_LSE); float* mixf = (float*)(ws + WS_U + U_MIXF); bf16_t* mixb = (bf16_t*)(ws + WS_U + U_MIXB);
        int load_chunk = -1;
        if (ph == 0) { for (int rep = 0; rep < REP_PRO; ++rep) {
            LAS float* scr = (LAS float*)(lds + wave * 16384);
            for (int l = 0; l < NLAYER; ++l) {
                bf16_t* WL = Wb + (size_t)l * W_LAYER_ELEMS;
                tr_matrix<1>(args.in[4] + (size_t)l * D * 2 * DFF, D, 2 * DFF, 2 * DFF, WL + OFF_W1IN, D, scr, gw, NGW, lane);
                tr_matrix<0>(args.in[5] + (size_t)l * DFF * D, DFF, D, D, WL + OFF_W1OUT, DFF, scr, gw, NGW, lane);
                tr_matrix<2>(args.in[8] + (size_t)l * D * INC, D, INC, INC, WL + OFF_WIN, D, scr, gw, NGW, lane);
                tr_matrix<0>(args.in[9] + (size_t)l * D * 1024, D, 1024, 1024, Wmem + (size_t)l * 1024 * D, D, scr, gw, NGW, lane);
                for (int i = 0; i < 3; ++i) tr_matrix<0>(args.in[11] + ((size_t)l * 3 + i) * 512 * D, 512, D, D, WL + OFF_WBR + (size_t)i * D * 512, 512, scr, gw, NGW, lane);
                tr_matrix<0>(args.in[12] + (size_t)l * D * D, D, D, D, WL + OFF_WOUT, D, scr, gw, NGW, lane);
                tr_matrix<1>(args.in[15] + (size_t)l * D * 2 * DFF, D, 2 * DFF, 2 * DFF, WL + OFF_W2IN, D, scr, gw, NGW, lane);
                tr_matrix<0>(args.in[16] + (size_t)l * DFF * D, DFF, D, D, WL + OFF_W2OUT, DFF, scr, gw, NGW, lane);
            }
            for (int m = gw; m < MEMROWS; m += NGW) {
                const float* src = (m < 4096) ? args.in[2] + (size_t)m * D : args.in[3] + (size_t)(m - 4096) * D;
#pragma unroll
                for (int j = 0; j < 4; ++j) { const f32x4 v = *((const f32x4*)src + lane + 64 * j); u32x2 w; w.x = cvt_pk_bf16(v[0], v[1]); w.y = cvt_pk_bf16(v[2], v[3]); *((u32x2*)(memb + (size_t)m * D) + lane + 64 * j) = w; }
            } }
            load_chunk = 0;
        } else if (ph == 1) {
            pg8::Gemm g{memb, Wmem, MEMROWS, 2048, D, D, D, 0, 0}; pg8::Order S; S.init(MEMROWS, 2048, 1, G, bx);
            pg8::EpiBf16Plain E{memkv, 2048};
            pg8::gemm_phase(lds, g, S, E);
        } else {
            const int q = ph - 2, c = q / PH_PER_CHUNK, r = q - c * PH_PER_CHUNK;
            const bool is_prompt = c < 2;
            float* X = args.out + (size_t)c * TC * D;
            const int L = is_prompt ? 2048 : 8192;
            bf16_t* xb = (bf16_t*)(ws + ((c & 1) ? WS_XB : WS_X16));
            {
                const int l = r / 9, k = r - l * 9;
                const bf16_t* WL = Wb + (size_t)l * W_LAYER_ELEMS;
                if (k == 0 || k == 7) {
                    pg8::Gemm g{xb, WL + (k == 0 ? OFF_W1IN : OFF_W2IN), TC, 2 * DFF, D, D, D, 0, 0}; pg8::Order S; S.init(TC, 2 * DFF, 1, G, bx); pg8::EpiSwiglu E{hb, DFF}; for (int rep = 0; rep < REP_UP; ++rep) pg8::gemm_phase(lds, g, S, E);
                } else if (k == 1 || k == 8 || k == 6) {
                    const bool ffn = (k != 6); const int sidx = (k == 1) ? 0 : (k == 6 ? 1 : 2);
                    const bool last = (l == NLAYER - 1 && k == 8);
                    pg8::Gemm g{ffn ? hb : mixb, WL + (k == 1 ? OFF_W1OUT : (k == 8 ? OFF_W2OUT : OFF_WOUT)), TC, D, ffn ? DFF : D, ffn ? DFF : D, ffn ? DFF : D, 0, 0};
                    pg8::Order S; S.init(TC, D, 1, G, bx);
                    const int nuse = (c * NLAYER + l) * 3 + sidx;
                    pg8::EpiResidLN E{last ? X : nullptr, xb, args.in[sidx == 0 ? 6 : (sidx == 1 ? 13 : 17)] + l * D, args.in[sidx == 0 ? 7 : (sidx == 1 ? 14 : 18)] + l * D, ffn ? 0.5f : 1.0f,
                                      (unsigned long long*)(ws + WS_CTL + CTL_XBUF), (unsigned*)(ws + WS_CTL + 16384), 32u * (unsigned)(nuse + 1)};
                    pg8::gemm_phase(lds, g, S, E);
                    if (last && c + 1 < NCHUNK) load_chunk = c + 1;
                } else if (k == 2) {
                    pg8::Gemm g{xb, WL + OFF_WIN, TC, INC, D, D, D, 0, 0}; pg8::Order S; S.init(TC, INC, 1, G, bx); pg8::EpiInproj E{proj, gates}; for (int rep = 0; rep < REP_INPROJ; ++rep) pg8::gemm_phase(lds, g, S, E);
                } else if (k == 3) {
                    LAS unsigned char* vl = lds + wave * 9216;
                    const float* sink = args.in[10] + l * 8;
                    const int memrow0 = is_prompt ? c * 8 * NMEM : 4096 + (c - 2) * 2 * NMEM;
                    for (int rep = 0; rep < REP_ATT; ++rep) {
                    for (int u = vcu; u < 256; u += G) {
                        const int nqb = L / 256; const int qb = u % nqb, hh = (u / nqb) & 3, sq = u / (nqb * 4);
                        const bf16_t* mb = memkv + (size_t)(memrow0 + sq * NMEM) * 2048 + l * 1024 + hh * 128;
                        __syncthreads();
#pragma unroll 2
                        for (int j = 0; j < 8; ++j) { const int idx = j * 512 + (int)threadIdx.x, rrow = idx >> 4, pc = idx & 15;
                            const u32x4 kv = *(const u32x4*)(mb + (size_t)rrow * 2048 + pc * 8), vv = *(const u32x4*)(mb + 512 + (size_t)rrow * 2048 + pc * 8);
                            *(LAS u32x4*)(lds + rrow * 288 + pc * 16) = kv; *(LAS u32x4*)(lds + 73728 + rrow * 288 + pc * 16) = vv; }
                        __syncthreads();
                        AttnP P;
                        const int tok0 = sq * L + qb * 256 + wave * 32;
                        P.q = proj + (size_t)tok0 * PROJC + 2304 + hh * 128; P.q_rs = PROJC; P.q_toff = 16 * PROJC;
                        P.k = mb; P.v = mb + 512; P.kv_rs = 2048;
                        P.o = br + (size_t)tok0 * BRC + 1024 + hh * 128; P.o_rs = BRC; P.o_toff = 16 * BRC; P.lse = nullptr; P.lse_rs = 0; P.lse_toff = 0;
                        P.qpos0 = 0; P.qpos_tstep = 0; P.k_lo = 0; P.nsteps = 8; P.sub_len = NMEM; P.radius = 1 << 20;
                        P.slope2 = 0.f; P.slope_tmul = 1.f;
#pragma unroll
                        for (int i = 0; i < 4; ++i) P.sink2[i] = 0.f;
                        attn_item<128, 2, 3>(P, lds + 73728, lane, lds);
                    }
                    __syncthreads();
                    for (int it = gw; it < 4 * 2048; it += NGW) {
                        const int type = it >> 11, id = it & 2047;
                        AttnP P;
                        if (type == 0) {
                            const int hk = id & 1, tb = id >> 1; const int tok0 = tb * 16; const int sq = tok0 / L, pos0 = tok0 - sq * L;
                            const bf16_t* base = proj + (size_t)(sq * L) * PROJC;
                            P.q = proj + (size_t)tok0 * PROJC + hk * 256; P.q_rs = PROJC; P.q_toff = 64;
                            P.k = base + 512 + hk * 64; P.v = base + 512 + 128 + hk * 64; P.kv_rs = PROJC;
                            P.o = br + (size_t)tok0 * BRC + hk * 256; P.o_rs = BRC; P.o_toff = 64; P.lse = nullptr; P.lse_rs = 0; P.lse_toff = 0;
                            P.qpos0 = pos0; P.qpos_tstep = 0; P.k_lo = pos0 - 128; P.nsteps = 9; P.sub_len = L; P.radius = 128;
                            P.slope2 = LOG2E * fast_exp2(-(float)(hk * 4 + 1)); P.slope_tmul = 0.5f;
#pragma unroll
                            for (int i = 0; i < 4; ++i) P.sink2[i] = sink[hk * 4 + i] * LOG2E;
                            attn_item<64, 4, 0>(P, vl, lane);
                        } else {
                            const int cfg = type - 1, dil = cfg == 0 ? 1 : (cfg == 1 ? 4 : 16);
                            const int h = id & 7, blk = id >> 3;
                            const int sub_len = L / dil, bps = sub_len / 64;
                            const int sr = blk / bps, jb = blk - sr * bps; const int sq = sr / dil, rs = sr - sq * dil; const int j0 = jb * 64;
                            const bf16_t* base = proj + (size_t)(sq * L + rs) * PROJC + 768 + h * 64;
                            const size_t tok0 = (size_t)sq * L + rs + (size_t)j0 * dil;
                            P.q = proj + tok0 * PROJC + 768 + h * 64; P.q_rs = PROJC * dil; P.q_toff = 16 * PROJC * dil;
                            P.k = base + 512; P.v = base + 1024; P.kv_rs = PROJC * dil;
                            P.o = bpart + (size_t)cfg * TC * 512 + tok0 * 512 + h * 64; P.o_rs = 512 * dil; P.o_toff = 16 * 512 * dil;
                            P.lse = lseb + (size_t)cfg * TC * 8 + tok0 * 8 + h; P.lse_rs = 8 * dil; P.lse_toff = 16 * 8 * dil;
                            P.qpos0 = j0; P.qpos_tstep = 16; P.k_lo = j0 - 64; P.nsteps = 6; P.sub_len = sub_len; P.radius = 64;
                            P.slope2 = LOG2E * fast_exp2(-(float)(h + 1)) * (float)dil; P.slope_tmul = 1.0f;
#pragma unroll
                            for (int i = 0; i < 4; ++i) P.sink2[i] = 0.f;
                            attn_item<64, 4, 1>(P, vl, lane);
                        }
                    }
                    }
                } else if (k == 4) {
                    for (int rep = 0; rep < REP_CMB; ++rep) for (int m0 = gw; m0 < TC; m0 += 4 * NGW) {
                        const int h = lane >> 3;
                        float l0[4], l1[4], l2[4]; u32x4 a[4], b[4], cc[4];
#pragma unroll
                        for (int r = 0; r < 4; ++r) { const int mm = m0 + r * NGW; const size_t m = (size_t)(mm < TC ? mm : m0);
                            l0[r] = lseb[m * 8 + h]; l1[r] = lseb[(size_t)TC * 8 + m * 8 + h]; l2[r] = lseb[(size_t)2 * TC * 8 + m * 8 + h];
                            a[r] = *((const u32x4*)(bpart + m * 512) + lane); b[r] = *((const u32x4*)(bpart + (size_t)TC * 512 + m * 512) + lane); cc[r] = *((const u32x4*)(bpart + (size_t)2 * TC * 512 + m * 512) + lane); }
#pragma unroll
                        for (int r = 0; r < 4; ++r) { const int mm = m0 + r * NGW; if (mm >= TC) continue;
                            const float mx = fmaxf(l0[r], fmaxf(l1[r], l2[r])); float w0 = fast_exp2(l0[r] - mx), w1 = fast_exp2(l1[r] - mx), w2 = fast_exp2(l2[r] - mx); const float inv = 1.0f / (w0 + w1 + w2); w0 *= inv; w1 *= inv; w2 *= inv;
                            u32x4 w;
                            w.x = cvt_pk_bf16(w0 * bf_lo(a[r].x) + w1 * bf_lo(b[r].x) + w2 * bf_lo(cc[r].x), w0 * bf_hi(a[r].x) + w1 * bf_hi(b[r].x) + w2 * bf_hi(cc[r].x));
                            w.y = cvt_pk_bf16(w0 * bf_lo(a[r].y) + w1 * bf_lo(b[r].y) + w2 * bf_lo(cc[r].y), w0 * bf_hi(a[r].y) + w1 * bf_hi(b[r].y) + w2 * bf_hi(cc[r].y));
                            w.z = cvt_pk_bf16(w0 * bf_lo(a[r].z) + w1 * bf_lo(b[r].z) + w2 * bf_lo(cc[r].z), w0 * bf_hi(a[r].z) + w1 * bf_hi(b[r].z) + w2 * bf_hi(cc[r].z));
                            w.w = cvt_pk_bf16(w0 * bf_lo(a[r].w) + w1 * bf_lo(b[r].w) + w2 * bf_lo(cc[r].w), w0 * bf_hi(a[r].w) + w1 * bf_hi(b[r].w) + w2 * bf_hi(cc[r].w));
                            *((u32x4*)(br + (size_t)mm * BRC + 512) + lane) = w; }
                    }
                } else {
                    pg8::Gemm g{br, WL + OFF_WBR, TC, D, 512, BRC, 512, 512, (size_t)D * 512}; pg8::Order S; S.init(TC, D, 3, G, bx); pg8::EpiBranch E{gates, mixb}; for (int rep = 0; rep < REP_BR; ++rep) pg8::gemm_phase(lds, g, S, E);
                }
            }
        }
        if (load_chunk >= 0) {
            const float* xin = load_chunk < 2 ? args.in[0] + (size_t)load_chunk * TC * D : args.in[1] + (size_t)(load_chunk - 2) * TC * D;
            bf16_t* xnext = (bf16_t*)(ws + ((load_chunk & 1) ? WS_XB : WS_X16));
            for (int m0 = gw; m0 < TC; m0 += 4 * NGW) {
                f32x4 v[4][4];
#pragma unroll
                for (int r = 0; r < 4; ++r) { const int mm = m0 + r * NGW; const size_t m = (size_t)(mm < TC ? mm : m0);
#pragma unroll
                    for (int j = 0; j < 4; ++j) v[r][j] = *((const f32x4*)(xin + m * D) + lane + 64 * j); }
#pragma unroll
                for (int r = 0; r < 4; ++r) { const int mm = m0 + r * NGW; if (mm >= TC) continue;
#pragma unroll
                    for (int j = 0; j < 4; ++j) { u32x2 w; w.x = cvt_pk_h(v[r][j][0], v[r][j][1]); w.y = cvt_pk_h(v[r][j][2], v[r][j][3]); *((u32x2*)(xnext + (size_t)mm * D) + lane + 64 * j) = w; } }
            }
        }
        for (int rep = 0; rep < REP_SYNC; ++rep) xcd_barrier(bar);
    }
}

extern "C" void kernel_launch(void* const* d_in, const int* in_sizes, int n_in, void* d_out, int out_size, void* d_ws, size_t ws_size, hipStream_t stream) {
    static int grid = 0;
    if (grid == 0) {
        if (n_in != 19 || ws_size < WS_END) { fprintf(stderr, "kernel_launch: need 19 inputs and %zu bytes of workspace; got %d, %zu\n", (size_t)WS_END, n_in, ws_size); grid = -1; return; }
        int dev = 0, cus = 0, per_cu = 0;
        hipGetDevice(&dev); hipDeviceGetAttribute(&cus, hipDeviceAttributeMultiprocessorCount, dev);
        if (hipFuncSetAttribute((const void*)mega_fwd, hipFuncAttributeMaxDynamicSharedMemorySize, LDS_BYTES) != hipSuccess) { fprintf(stderr, "kernel_launch: hipFuncSetAttribute failed\n"); grid = -1; return; }
        if (hipOccupancyMaxActiveBlocksPerMultiprocessor(&per_cu, (const void*)mega_fwd, 512, LDS_BYTES) != hipSuccess || per_cu < 1) { fprintf(stderr, "kernel_launch: occupancy query says %d\n", per_cu); per_cu = 1; }
        (void)hipGetLastError();
        grid = cus;
        if (grid != 256) { fprintf(stderr, "kernel_launch: built for a 256-CU device (fused LayerNorm epilogue needs one 256x256 unit per workgroup); got %d CUs\n", cus); grid = -1; return; }
    }
    if (grid < 0) return;
    if (hipMemsetAsync((char*)d_ws + WS_CTL, 0, CTL_BYTES, stream) != hipSuccess) { fprintf(stderr, "kernel_launch: memset failed\n"); return; }
    Args a{};
    for (int i = 0; i < 19; ++i) a.in[i] = (const float*)d_in[i];
    a.out = (float*)d_out; a.ws = (unsigned char*)d_ws;
    void* kargs[] = {&a};
    hipError_t e = hipLaunchCooperativeKernel((const void*)mega_fwd, dim3(grid), dim3(512), kargs, LDS_BYTES, stream);
    if (e != hipSuccess) fprintf(stderr, "cooperative launch failed: %s (grid %d)\n", hipGetErrorString(e), grid);
}
```

```cpp
#include <hip/hip_runtime.h>
#include <hip/hip_cooperative_groups.h>
#include <cstdio>
#include <cstdint>
namespace cg = cooperative_groups;

#define LAS __attribute__((address_space(3)))
typedef unsigned short bf16_t;
typedef short bf16x8 __attribute__((ext_vector_type(8)));
typedef short s16x4 __attribute__((ext_vector_type(4)));
typedef float f32x4 __attribute__((ext_vector_type(4)));
typedef float f32x2 __attribute__((ext_vector_type(2)));
typedef unsigned u32x4 __attribute__((ext_vector_type(4)));
typedef unsigned u32x2 __attribute__((ext_vector_type(2)));

constexpr int D = 1024, DFF = 2816, NLAYER = 2;
constexpr int TC = 16384;
constexpr int NCHUNK = 4;
constexpr int INC = 5888, PROJC = 2816, GATEC = 3072, BRC = 1536;
constexpr int NMEM = 256, MEMROWS = 5120;
constexpr float LN_EPS = 1e-5f;
constexpr float ALPHA = 1.41421356237309515f;
constexpr float LOG2E = 1.44269504088896341f;

constexpr size_t MiB = 1u << 20;
constexpr size_t W_LAYER_ELEMS = (size_t)5632 * 1024 + (size_t)1024 * 2816 + (size_t)5888 * 1024 + (size_t)3 * 1024 * 512 + (size_t)1024 * 1024 + (size_t)5632 * 1024 + (size_t)1024 * 2816;
constexpr size_t OFF_W1IN = 0, OFF_W1OUT = OFF_W1IN + (size_t)5632 * 1024, OFF_WIN = OFF_W1OUT + (size_t)1024 * 2816, OFF_WBR = OFF_WIN + (size_t)5888 * 1024,
                 OFF_WOUT = OFF_WBR + (size_t)3 * 1024 * 512, OFF_W2IN = OFF_WOUT + (size_t)1024 * 1024, OFF_W2OUT = OFF_W2IN + (size_t)5632 * 1024;
constexpr size_t WS_W = 0;
constexpr size_t WS_WMEM = 100 * MiB;
constexpr size_t WS_MEMB = 108 * MiB;
constexpr size_t WS_MEMKV = 118 * MiB;
constexpr size_t WS_XB = 158 * MiB;
constexpr size_t WS_U = 190 * MiB;
constexpr size_t U_H = 0;
constexpr size_t U_PROJ = 0;
constexpr size_t U_GATES = 88 * MiB;
constexpr size_t U_BR = 184 * MiB;
constexpr size_t U_BPART = 232 * MiB;
constexpr size_t U_LSE = 280 * MiB;
constexpr size_t U_MIXF = 0;
constexpr size_t U_MIXB = 232 * MiB;
constexpr size_t WS_X16 = WS_U + 282 * MiB;
constexpr size_t WS_CTL = WS_X16 + 32 * MiB;
constexpr size_t CTL_BYTES = 32768;
constexpr size_t CTL_XBUF = 65536;
constexpr size_t WS_END = WS_CTL + 1 * MiB;
static_assert(W_LAYER_ELEMS * 2 * 2 <= 100 * MiB, "weights fit");

constexpr int REP_ATT = 1, REP_UP = 1, REP_INPROJ = 1, REP_BR = 1, REP_PRO = 1, REP_SYNC = 1, REP_CMB = 1;
constexpr int LDS_BYTES = 147456 + 256;
constexpr int LDS_MISC = 147456;

__device__ __forceinline__ unsigned cvt_pk_bf16(float lo, float hi) { unsigned r; asm("v_cvt_pk_bf16_f32 %0, %1, %2" : "=v"(r) : "v"(lo), "v"(hi)); return r; }
__device__ __forceinline__ float bf_lo(unsigned u) { return __uint_as_float(u << 16); }
__device__ __forceinline__ float bf_hi(unsigned u) { return __uint_as_float(u & 0xffff0000u); }
typedef _Float16 f16x2 __attribute__((ext_vector_type(2)));
typedef _Float16 f16x8 __attribute__((ext_vector_type(8)));
__device__ __forceinline__ unsigned cvt_pk_h(float lo, float hi) { const f16x2 v = {(_Float16)lo, (_Float16)hi}; return __builtin_bit_cast(unsigned, v); }
__device__ __forceinline__ float h_lo(unsigned u) { return (float)__builtin_bit_cast(f16x2, u)[0]; }
__device__ __forceinline__ float h_hi(unsigned u) { return (float)__builtin_bit_cast(f16x2, u)[1]; }
__device__ __forceinline__ float fast_exp2(float x) { return __builtin_amdgcn_exp2f(x); }
__device__ __forceinline__ float fast_rcp(float x) { return __builtin_amdgcn_rcpf(x); }
__device__ __forceinline__ float sigmoidf_fast(float v) { return fast_rcp(1.0f + fast_exp2(-LOG2E * v)); }
__device__ __forceinline__ float rowgrp_max(float m) {
    const auto r = __builtin_amdgcn_permlane16_swap(__float_as_uint(m), __float_as_uint(m), false, false);
    const float a = fmaxf(__uint_as_float(r[0]), __uint_as_float(r[1]));
    const auto r2 = __builtin_amdgcn_permlane32_swap(__float_as_uint(a), __float_as_uint(a), false, false);
    return fmaxf(__uint_as_float(r2[0]), __uint_as_float(r2[1]));
}
__device__ __forceinline__ float rowgrp_sum(float m) {
    const auto r = __builtin_amdgcn_permlane16_swap(__float_as_uint(m), __float_as_uint(m), false, false);
    const float a = __uint_as_float(r[0]) + __uint_as_float(r[1]);
    const auto r2 = __builtin_amdgcn_permlane32_swap(__float_as_uint(a), __float_as_uint(a), false, false);
    return __uint_as_float(r2[0]) + __uint_as_float(r2[1]);
}
__device__ __forceinline__ float wave_sum(float v) {
#pragma unroll
    for (int o = 1; o < 64; o <<= 1) v += __shfl_xor(v, o);
    return v;
}

#define XB_TMO      128
#define XB_XCNT(j)  (256  + 64 * (j))
#define XB_XSUB(j)  (1280 + 64 * (j))
#define XB_XGEN(j)  (2304 + 64 * (j))
#define XB_TOP      3328
#define XB_TOPGEN   3392
#define XCD_BAR_WORDS 3456
#define XB_SPIN_CAP (1u << 18)

__device__ __forceinline__ unsigned xb_ld(unsigned* p)              { return __hip_atomic_load(p, __ATOMIC_RELAXED, __HIP_MEMORY_SCOPE_AGENT); }
__device__ __forceinline__ unsigned xb_add(unsigned* p, unsigned v) { return __hip_atomic_fetch_add(p, v, __ATOMIC_RELAXED, __HIP_MEMORY_SCOPE_AGENT); }
__device__ __forceinline__ unsigned xb_xcc_id() { return (unsigned)__builtin_amdgcn_s_getreg((3 << 11) | 20) & 0xFu; }
#define XB_SPIN(cond, bar) do { unsigned _sp = 0; while (cond) { __builtin_amdgcn_s_sleep(1); \
    if ((++_sp & 255u) == 0u) { if (xb_ld(&(bar)[XB_TMO])) break; if (_sp > XB_SPIN_CAP) { atomicAdd(&(bar)[XB_TMO], 1u); break; } } } } while (0)

struct XcdBarrier {
    unsigned* bar; unsigned x;
    volatile LAS unsigned* st;
};

__device__ __forceinline__ XcdBarrier xcd_barrier_post(unsigned* bar, volatile LAS unsigned* st) {
    XcdBarrier b; b.bar = bar; b.x = xb_xcc_id(); b.st = st;
    if (threadIdx.x == 0) (void)xb_add(&bar[XB_XCNT(b.x)], 1u);
    return b;
}
__device__ __forceinline__ void xcd_barrier_complete(unsigned* bar, unsigned x, unsigned& nloc, unsigned& nx) {
    const unsigned G = gridDim.x * gridDim.y * gridDim.z;
    unsigned sum, cnt, mine, sp = 0u;
    for (;;) {
        sum = 0u; cnt = 0u; mine = 0u;
#pragma unroll
        for (unsigned j = 0; j < 16; ++j) { const unsigned c = xb_ld(&bar[XB_XCNT(j)]); sum += c; cnt += (c > 0u) ? 1u : 0u; mine = (j == x) ? c : mine; }
        if (sum == G) break;
        __builtin_amdgcn_s_sleep(1);
        if ((++sp & 255u) == 0u) { if (xb_ld(&bar[XB_TMO])) break; if (sp > XB_SPIN_CAP) { atomicAdd(&bar[XB_TMO], 1u); break; } }
    }
    nloc = mine > 0u ? mine : 1u; nx = cnt > 0u ? cnt : 1u;
}

__device__ __forceinline__ void xcd_barrier(const XcdBarrier& b) {
    asm volatile("s_waitcnt vmcnt(0)" ::: "memory");
    __syncthreads();
    if (threadIdx.x == 0) {
        unsigned* bar = b.bar;
        __builtin_amdgcn_s_waitcnt(0);
        unsigned nloc = b.st[0], nx = b.st[1];
        if (nloc == 0u) { xcd_barrier_complete(bar, b.x, nloc, nx); b.st[0] = nloc; b.st[1] = nx; }
        const unsigned old = xb_add(&bar[XB_XSUB(b.x)], 1u);
        const unsigned gen = old / nloc;
        if (old + 1u == (gen + 1u) * nloc) {
            __builtin_amdgcn_fence(__ATOMIC_RELEASE, "agent");
            asm volatile("s_waitcnt vmcnt(0)" ::: "memory");
            const unsigned og = xb_add(&bar[XB_TOP], 1u);
            const unsigned tg = og / nx;
            if (og + 1u == (tg + 1u) * nx) xb_add(&bar[XB_TOPGEN], 1u);
            else XB_SPIN(xb_ld(&bar[XB_TOPGEN]) == tg, bar);
            __builtin_amdgcn_fence(__ATOMIC_ACQUIRE, "agent");
            xb_add(&bar[XB_XGEN(b.x)], 1u);
            asm volatile("s_waitcnt vmcnt(0)" ::: "memory");
        } else {
            XB_SPIN(xb_ld(&bar[XB_XGEN(b.x)]) == gen, bar);
            __builtin_amdgcn_fence(__ATOMIC_ACQUIRE, "agent");
            asm volatile("s_waitcnt vmcnt(0)" ::: "memory");
        }
    }
    __syncthreads();
}


namespace pg8 {
constexpr int BM = 256, BK = 64, HALF = 128, HTB = HALF * BK * 2, STAGE_BYTES = 8 * HTB, NXCD = 8, WGM = 4;
__host__ __device__ __forceinline__ int lds_byte(int r, int c) { const int st = (r >> 4) * 2 + (c >> 5), rr = r & 15, cc = c & 31, ob = rr * 64 + cc * 2; return st * 1024 + (ob ^ (((ob >> 9) & 1) << 5)); }
__host__ __device__ __forceinline__ void stage_rc(int b, int& R, int& C) { const int st = b / 1024, sb = b % 1024, swz = sb ^ (((sb >> 9) & 1) << 5); R = (st >> 1) * 16 + swz / 64; C = (st & 1) * 32 + (swz % 64) / 2; }
__host__ __device__ __forceinline__ int perm32(int rho) { const int n = rho >> 4, i = rho & 15; return 8 * (i >> 2) + 4 * n + (i & 3); }

struct Unit { int pm, pn, z; };
struct Gemm { const bf16_t* A; const bf16_t* Bt; int M, N, K, lda, ldb; size_t za, zb; };

struct Order {
    int nM, nN, nZ, nwg, G, c;
    __device__ void init(int M, int N, int nZ_, int G_, int c_) { nM = M / BM; nN = N / BM; nZ = nZ_; nwg = nM * nN; G = G_; c = c_; }
    __device__ bool next(int i, Unit& u) const {
        const int ti = i / nZ; u.z = i - ti * nZ;
        const long L = (long)ti * G + c; if (L >= nwg) return false;
        int wgid = (int)L; { const int q = nwg / NXCD, r = nwg % NXCD, xcd = wgid % NXCD, off = wgid / NXCD; wgid = (xcd < r ? xcd * (q + 1) : r * (q + 1) + (xcd - r) * q) + off; }
        const int nig = WGM * nN, gid = wgid / nig, fm = gid * WGM, gsz = (nM - fm) < WGM ? (nM - fm) : WGM;
        u.pm = fm + ((wgid % nig) % gsz); u.pn = (wgid % nig) / gsz; return true;
    }
};

template <class Epi>
__device__ __forceinline__ void gemm_phase(LAS unsigned char* lds, const Gemm g, const Order& S, const Epi& E) {
    int tid = threadIdx.x; asm volatile("" : "+v"(tid));
    const int wid = __builtin_amdgcn_readfirstlane(tid >> 6), lane = tid & 63, wr = wid >> 2, wc = wid & 3, fr = lane & 15, fq = lane >> 4;
    const int K = g.K, nt = K / BK;
    unsigned voffA[2], voffB[2];
#pragma unroll
    for (int i = 0; i < 2; ++i) { int R, C; stage_rc(tid * 16 + i * 8192, R, C); const int Rb = Epi::PERM ? ((R & ~31) + perm32(R & 31)) : R;
        voffA[i] = (unsigned)(R * g.lda + C) * 2u; voffB[i] = (unsigned)(Rb * g.ldb + C) * 2u; }
    const size_t kstep = (size_t)(BK * 2);
    const size_t hstepA = (size_t)HALF * g.lda * 2, hstepB = (size_t)HALF * g.ldb * 2;
    const unsigned ldsw = (unsigned)wid * 1024u;
    const int aoff = lds_byte(wr * 64 + fr, fq * 8), boff = lds_byte(wc * 32 + fr, fq * 8);
#define PG8_SA(b, h) (((b) * 2 + (h)) * HTB)
#define PG8_SB(b, h) ((4 + (b) * 2 + (h)) * HTB)
#define PG8_STAGE(bufoff, gbase, voff) do { _Pragma("unroll") for (int _i = 0; _i < 2; ++_i) \
        __builtin_amdgcn_global_load_lds((const unsigned*)((const char*)(gbase) + (voff)[_i]), (LAS unsigned*)(lds + (bufoff) + ldsw + _i * 8192), 16, 0, 0); } while (0)
#define PG8_LDA(dst, b, h) do { _Pragma("unroll") for (int m = 0; m < 4; ++m) _Pragma("unroll") for (int k = 0; k < 2; ++k) dst[m][k] = *(const LAS bf16x8*)(lds + PG8_SA(b, h) + aoff + m * 2048 + k * 1024); } while (0)
#define PG8_LDB(dst, b, h) do { _Pragma("unroll") for (int n = 0; n < 2; ++n) _Pragma("unroll") for (int k = 0; k < 2; ++k) dst[n][k] = *(const LAS bf16x8*)(lds + PG8_SB(b, h) + boff + n * 2048 + k * 1024); } while (0)
#define PG8_MMA(ai, bj, At, Bt) do { __builtin_amdgcn_s_setprio(1); _Pragma("unroll") for (int m = 0; m < 4; ++m) _Pragma("unroll") for (int n = 0; n < 2; ++n) _Pragma("unroll") for (int k = 0; k < 2; ++k) \
        acc[ai][bj][m][n] = Epi::F16A ? __builtin_amdgcn_mfma_f32_16x16x32_f16(__builtin_bit_cast(f16x8, Bt[n][k]), __builtin_bit_cast(f16x8, At[m][k]), acc[ai][bj][m][n], 0, 0, 0) \
                                      : __builtin_amdgcn_mfma_f32_16x16x32_bf16(Bt[n][k], At[m][k], acc[ai][bj][m][n], 0, 0, 0); __builtin_amdgcn_s_setprio(0); } while (0)
#define PG8_WAIT_V(n) asm volatile("s_waitcnt vmcnt(" #n ")" ::: "memory")
#define PG8_WAIT_L(n) asm volatile("s_waitcnt lgkmcnt(" #n ")" ::: "memory")
#define PG8_BAR __builtin_amdgcn_s_barrier()
#define PG8_SCHED __builtin_amdgcn_sched_barrier(0)
    Unit cur, nxt; int ui = 0;
    if (!S.next(0, cur)) return;
    f32x4 acc[2][2][4][2];
#pragma unroll
    for (int a = 0; a < 2; ++a)
#pragma unroll
        for (int b = 0; b < 2; ++b)
#pragma unroll
            for (int m = 0; m < 4; ++m)
#pragma unroll
                for (int n = 0; n < 2; ++n) acc[a][b][m][n] = (f32x4){0.f, 0.f, 0.f, 0.f};
    bf16x8 At[4][2], B0[2][2], B1[2][2];
    const char* cA = (const char*)(g.A + (size_t)cur.pm * BM * g.lda + (size_t)cur.z * g.za);
    const char* cB = (const char*)(g.Bt + (size_t)cur.pn * BM * g.ldb + (size_t)cur.z * g.zb);
    constexpr bool ALIGN_EPI = Epi::ALIGN && !Epi::AFTER_DRAIN;
    PG8_STAGE(PG8_SB(0, 0), cB, voffB); PG8_STAGE(PG8_SB(0, 1), cB + hstepB, voffB); PG8_STAGE(PG8_SA(0, 0), cA, voffA); PG8_STAGE(PG8_SA(0, 1), cA + hstepA, voffA);
    if (wr == 1) PG8_BAR;
    PG8_WAIT_V(2); PG8_BAR;
    PG8_STAGE(PG8_SB(1, 0), cB + kstep, voffB); PG8_STAGE(PG8_SA(1, 0), cA + kstep, voffA); PG8_STAGE(PG8_SB(1, 1), cB + hstepB + kstep, voffB);
    PG8_WAIT_V(6); PG8_BAR;
    for (;;) {
        const bool has_next = S.next(ui + 1, nxt);
        const char* nA = has_next ? (const char*)(g.A + (size_t)nxt.pm * BM * g.lda + (size_t)nxt.z * g.za) : cA;
        const char* nB = has_next ? (const char*)(g.Bt + (size_t)nxt.pn * BM * g.ldb + (size_t)nxt.z * g.zb) : cB;
        for (int t = 0; t < nt; t += 2) {
            const bool last = (t == nt - 2);
            const char* a1 = cA + (size_t)(t + 1) * kstep;
            const char* a2 = last ? nA : cA + (size_t)(t + 2) * kstep; const char* b2 = last ? nB : cB + (size_t)(t + 2) * kstep;
            const char* a3 = a2 + kstep; const char* b3 = b2 + kstep;
            PG8_LDB(B0, 0, 0); PG8_LDB(B1, 0, 1); PG8_SCHED; PG8_LDA(At, 0, 0); PG8_STAGE(PG8_SA(1, 1), a1 + hstepA, voffA);
            PG8_WAIT_V(8); PG8_WAIT_L(0); PG8_BAR; PG8_MMA(0, 0, At, B0); PG8_MMA(0, 1, At, B1); PG8_BAR; PG8_SCHED;
            PG8_LDA(At, 0, 1); PG8_STAGE(PG8_SB(0, 0), b2, voffB); PG8_STAGE(PG8_SB(0, 1), b2 + hstepB, voffB); PG8_STAGE(PG8_SA(0, 0), a2, voffA);
            PG8_WAIT_V(8); PG8_WAIT_L(0); PG8_BAR; PG8_MMA(1, 0, At, B0); PG8_MMA(1, 1, At, B1); PG8_BAR; PG8_SCHED;
            PG8_LDB(B0, 1, 0); PG8_LDB(B1, 1, 1); PG8_SCHED; PG8_LDA(At, 1, 0); PG8_STAGE(PG8_SA(0, 1), a2 + hstepA, voffA);
            PG8_WAIT_V(8); PG8_WAIT_L(0); PG8_BAR; PG8_MMA(0, 0, At, B0); PG8_MMA(0, 1, At, B1); PG8_BAR; PG8_SCHED;
            PG8_LDA(At, 1, 1); PG8_STAGE(PG8_SB(1, 0), b3, voffB); PG8_STAGE(PG8_SB(1, 1), b3 + hstepB, voffB); PG8_STAGE(PG8_SA(1, 0), a3, voffA);
            PG8_WAIT_V(8); PG8_WAIT_L(0); PG8_BAR; PG8_MMA(1, 0, At, B0); PG8_MMA(1, 1, At, B1); PG8_BAR; PG8_SCHED;
        }
        if constexpr (ALIGN_EPI) { if (wr == 0) PG8_BAR; }
        if constexpr (!Epi::AFTER_DRAIN) E(acc, cur, wr, wc, fr, fq);
        if (!has_next) break;
        if (!(Epi::KEEP_ACC && nxt.z != 0)) {
#pragma unroll
        for (int a = 0; a < 2; ++a)
#pragma unroll
            for (int b = 0; b < 2; ++b)
#pragma unroll
                for (int m = 0; m < 4; ++m)
#pragma unroll
                    for (int n = 0; n < 2; ++n) acc[a][b][m][n] = (f32x4){0.f, 0.f, 0.f, 0.f};
        }
        cur = nxt; cA = nA; cB = nB; ++ui;
        if constexpr (ALIGN_EPI) { if (wr == 1) PG8_BAR; }
    }
    PG8_WAIT_V(0);
    if constexpr (!ALIGN_EPI) { if (wr == 0) PG8_BAR; }
    PG8_BAR;
    if constexpr (Epi::AFTER_DRAIN) E.fused(acc, cur, wr, wc, fr, fq, lds, wid, lane);
#undef PG8_SA
#undef PG8_SB
#undef PG8_STAGE
#undef PG8_LDA
#undef PG8_LDB
#undef PG8_MMA
#undef PG8_WAIT_V
#undef PG8_WAIT_L
#undef PG8_BAR
#undef PG8_SCHED
}

struct EpiSwiglu {
    static constexpr bool PERM = true, AFTER_DRAIN = false, KEEP_ACC = false, ALIGN = true, F16A = true;
    bf16_t* O; int ldc;
    __device__ __forceinline__ void operator()(const f32x4 (&acc)[2][2][4][2], const Unit& u, int wr, int wc, int fr, int fq) const {
        const int row0 = u.pm * BM + wr * 64 + fr, col0 = u.pn * HALF + wc * 32 + 8 * fq;
#pragma unroll
        for (int ai = 0; ai < 2; ++ai)
#pragma unroll
            for (int m = 0; m < 4; ++m) {
                bf16_t* rowp = O + (size_t)(row0 + ai * HALF + m * 16) * ldc + col0;
                float r[8];
#pragma unroll
                for (int n = 0; n < 2; ++n)
#pragma unroll
                    for (int jj = 0; jj < 2; ++jj) {
                        const f32x2 gv = (f32x2){acc[ai][0][m][n][2 * jj], acc[ai][0][m][n][2 * jj + 1]}, uv = (f32x2){acc[ai][1][m][n][2 * jj], acc[ai][1][m][n][2 * jj + 1]};
                        f32x2 e; e.x = fast_exp2(-gv.x); e.y = fast_exp2(-gv.y);
                        const f32x2 d = e + 1.0f;
                        f32x2 q; q.x = fast_rcp(d.x); q.y = fast_rcp(d.y);
                        const f32x2 o = (gv * uv) * q;
                        r[n * 4 + 2 * jj] = o.x; r[n * 4 + 2 * jj + 1] = o.y; }
                u32x4 w; w.x = cvt_pk_bf16(r[0], r[1]); w.y = cvt_pk_bf16(r[2], r[3]); w.z = cvt_pk_bf16(r[4], r[5]); w.w = cvt_pk_bf16(r[6], r[7]);
                *(u32x4*)rowp = w;
            }
    }
};
struct EpiResidLN {
    static constexpr bool PERM = true, AFTER_DRAIN = true, KEEP_ACC = false, ALIGN = false, F16A = false;
    float* xout; bf16_t* X16; const float* gam; const float* bet; float beta;
    unsigned long long* xbuf; unsigned* cnt; unsigned want;
    __device__ __forceinline__ void fused(f32x4 (&acc)[2][2][4][2], const Unit& u, int wr, int wc, int fr, int fq, LAS unsigned char* lds, int wid, int lane) const {
        LAS f32x2* P = (LAS f32x2*)lds;
        LAS f32x2* S = (LAS f32x2*)(lds + 8192);
        const int row0 = u.pm * BM + wr * 64 + fr, col0 = u.pn * BM + wc * 32 + 8 * fq;
        {
            u32x4 hw[2][2];
#pragma unroll
            for (int bj = 0; bj < 2; ++bj) hw[0][bj] = *(const u32x4*)(X16 + (size_t)row0 * D + col0 + bj * HALF);
#pragma unroll
            for (int gi = 0; gi < 8; ++gi) {
                const int ai = gi >> 2, m = gi & 3;
                if (gi + 1 < 8) { const int ai1 = (gi + 1) >> 2, m1 = (gi + 1) & 3;
#pragma unroll
                    for (int bj = 0; bj < 2; ++bj) hw[(gi + 1) & 1][bj] = *(const u32x4*)(X16 + (size_t)(row0 + ai1 * HALF + m1 * 16) * D + col0 + bj * HALF); }
                asm volatile("" ::: "memory");
#pragma unroll
                for (int bj = 0; bj < 2; ++bj) { const u32x4 h = hw[gi & 1][bj];
                    const f32x4 x0 = (f32x4){h_lo(h.x), h_hi(h.x), h_lo(h.y), h_hi(h.y)}, x1 = (f32x4){h_lo(h.z), h_hi(h.z), h_lo(h.w), h_hi(h.w)};
                    acc[ai][bj][m][0] = x0 * ALPHA + acc[ai][bj][m][0] * beta; acc[ai][bj][m][1] = x1 * ALPHA + acc[ai][bj][m][1] * beta; }
                asm volatile("" : "+v"(acc[ai][0][m][0]), "+v"(acc[ai][0][m][1]), "+v"(acc[ai][1][m][0]), "+v"(acc[ai][1][m][1]));
            }
        }
#pragma unroll
        for (int ai = 0; ai < 2; ++ai)
#pragma unroll
            for (int m = 0; m < 4; ++m) {
                float s = 0.f;
#pragma unroll
                for (int bj = 0; bj < 2; ++bj)
#pragma unroll
                    for (int n = 0; n < 2; ++n) { const f32x4 x = acc[ai][bj][m][n]; s += (x[0] + x[1]) + (x[2] + x[3]); }
                s = rowgrp_sum(s);
                const float mw = s * (1.0f / 64.0f); float q = 0.f;
#pragma unroll
                for (int bj = 0; bj < 2; ++bj)
#pragma unroll
                    for (int n = 0; n < 2; ++n) { const f32x4 d = acc[ai][bj][m][n] - mw; q += (d[0] * d[0] + d[1] * d[1]) + (d[2] * d[2] + d[3] * d[3]); }
                q = rowgrp_sum(q);
                if (fq == 0) P[(ai * HALF + wr * 64 + m * 16 + fr) * 4 + wc] = (f32x2){mw, q};
            }
        asm volatile("s_waitcnt lgkmcnt(0)" ::: "memory"); __builtin_amdgcn_s_barrier(); asm volatile("" ::: "memory");
        const int row = wid * 32 + (lane & 31);
        if (lane < 32) {
            const f32x2 a = P[row * 4 + 0], b = P[row * 4 + 1], c = P[row * 4 + 2], d = P[row * 4 + 3];
            const float mt = (a.x + b.x + c.x + d.x) * 0.25f;
            const float da = a.x - mt, db = b.x - mt, dc = c.x - mt, dd = d.x - mt;
            const float m2 = (a.y + b.y) + (c.y + d.y) + 64.0f * ((da * da + db * db) + (dc * dc + dd * dd));
            unsigned long long* slot = xbuf + ((size_t)((u.pm & 63) * BM + row) * 4 + u.pn);
            __hip_atomic_store(slot, ((unsigned long long)__float_as_uint(m2) << 32) | __float_as_uint(mt), __ATOMIC_RELAXED, __HIP_MEMORY_SCOPE_AGENT);
        }
        asm volatile("s_waitcnt vmcnt(0)" ::: "memory");
        if (lane == 0) __hip_atomic_fetch_add(cnt + 64 * (u.pm & 63), 1u, __ATOMIC_RELAXED, __HIP_MEMORY_SCOPE_AGENT);
        if (wid == 0) {
            unsigned spins = 0;
            while ((unsigned)__builtin_amdgcn_readfirstlane(__hip_atomic_load(cnt + 64 * (u.pm & 63), __ATOMIC_RELAXED, __HIP_MEMORY_SCOPE_AGENT)) < want) { __builtin_amdgcn_s_sleep(2); if (++spins > (1u << 22)) break; }
            __builtin_amdgcn_fence(__ATOMIC_ACQUIRE, "agent");
        }
        asm volatile("s_waitcnt vmcnt(0) lgkmcnt(0)" ::: "memory"); __builtin_amdgcn_s_barrier(); asm volatile("" ::: "memory");
        if (lane < 32) {
            const unsigned long long* slot = xbuf + (size_t)((u.pm & 63) * BM + row) * 4; float mt[4], m2[4]; float ms = 0.f;
#pragma unroll
            for (int t = 0; t < 4; ++t) { const unsigned long long w = __hip_atomic_load(slot + t, __ATOMIC_RELAXED, __HIP_MEMORY_SCOPE_AGENT); mt[t] = __uint_as_float((unsigned)w); m2[t] = __uint_as_float((unsigned)(w >> 32)); ms += mt[t]; }
            const float mean = ms * 0.25f; float q = 0.f;
#pragma unroll
            for (int t = 0; t < 4; ++t) { const float dm = mt[t] - mean; q += m2[t] + 256.0f * dm * dm; }
            S[row] = (f32x2){mean, 1.0f / sqrtf(q * (1.0f / 1024.0f) + LN_EPS)};
        }
        asm volatile("s_waitcnt lgkmcnt(0)" ::: "memory"); __builtin_amdgcn_s_barrier(); asm volatile("" ::: "memory");
        f32x4 gv[2][2], bv[2][2];
#pragma unroll
        for (int bj = 0; bj < 2; ++bj)
#pragma unroll
            for (int n = 0; n < 2; ++n) { gv[bj][n] = *(const f32x4*)(gam + col0 + bj * HALF + 4 * n); bv[bj][n] = *(const f32x4*)(bet + col0 + bj * HALF + 4 * n); }
#pragma unroll
        for (int ai = 0; ai < 2; ++ai)
#pragma unroll
            for (int m = 0; m < 4; ++m) { const int r = ai * HALF + wr * 64 + m * 16 + fr; const f32x2 sr = S[r]; const size_t off = (size_t)(u.pm * BM + r) * D + col0;
#pragma unroll
                for (int bj = 0; bj < 2; ++bj) {
                    const f32x4 y0 = (acc[ai][bj][m][0] - sr.x) * sr.y * gv[bj][0] + bv[bj][0], y1 = (acc[ai][bj][m][1] - sr.x) * sr.y * gv[bj][1] + bv[bj][1];
                    if (xout) { *(f32x4*)(xout + off + bj * HALF) = y0; *(f32x4*)(xout + off + bj * HALF + 4) = y1; }
                    else { u32x4 hw; hw.x = cvt_pk_h(y0[0], y0[1]); hw.y = cvt_pk_h(y0[2], y0[3]); hw.z = cvt_pk_h(y1[0], y1[1]); hw.w = cvt_pk_h(y1[2], y1[3]); *(u32x4*)(X16 + off + bj * HALF) = hw; } }
                asm volatile("" ::: "memory"); }
    }
};
struct EpiInproj {
    static constexpr bool PERM = true, AFTER_DRAIN = false, KEEP_ACC = false, ALIGN = true, F16A = true;
    bf16_t* P; unsigned char* G;
    __device__ __forceinline__ void operator()(const f32x4 (&acc)[2][2][4][2], const Unit& u, int wr, int wc, int fr, int fq) const {
        const bool isg = u.pn >= 11;
        const int colt = isg ? (u.pn - 11) * BM : u.pn * BM;
        const int row0 = u.pm * BM + wr * 64 + fr, col0 = colt + wc * 32 + 8 * fq;
#pragma unroll
        for (int ai = 0; ai < 2; ++ai)
#pragma unroll
            for (int m = 0; m < 4; ++m) { const size_t row = (size_t)(row0 + ai * HALF + m * 16);
#pragma unroll
                for (int bj = 0; bj < 2; ++bj) { const f32x4 v0 = acc[ai][bj][m][0], v1 = acc[ai][bj][m][1];
                    if (isg) {
                        unsigned w0 = 0u, w1 = 0u;
#pragma unroll
                        for (int j = 0; j < 4; ++j) { w0 = __builtin_amdgcn_cvt_pk_u8_f32(fmaf(fast_rcp(1.0f + fast_exp2(v0[j])), 256.0f, -0.5f), j, w0); w1 = __builtin_amdgcn_cvt_pk_u8_f32(fmaf(fast_rcp(1.0f + fast_exp2(v1[j])), 256.0f, -0.5f), j, w1); }
                        *(u32x2*)(G + row * GATEC + col0 + bj * HALF) = (u32x2){w0, w1};
                    } else {
                        u32x4 w; w.x = cvt_pk_bf16(v0[0], v0[1]); w.y = cvt_pk_bf16(v0[2], v0[3]); w.z = cvt_pk_bf16(v1[0], v1[1]); w.w = cvt_pk_bf16(v1[2], v1[3]);
                        *(u32x4*)(P + row * PROJC + col0 + bj * HALF) = w; } } }
    }
};
struct EpiBf16Plain {
    static constexpr bool PERM = true, AFTER_DRAIN = false, KEEP_ACC = false, ALIGN = true, F16A = false;
    bf16_t* O; int ldc;
    __device__ __forceinline__ void operator()(const f32x4 (&acc)[2][2][4][2], const Unit& u, int wr, int wc, int fr, int fq) const {
        const int row0 = u.pm * BM + wr * 64 + fr, col0 = u.pn * BM + wc * 32 + 8 * fq;
#pragma unroll
        for (int ai = 0; ai < 2; ++ai)
#pragma unroll
            for (int m = 0; m < 4; ++m) { bf16_t* rowp = O + (size_t)(row0 + ai * HALF + m * 16) * ldc + col0;
#pragma unroll
                for (int bj = 0; bj < 2; ++bj) { const f32x4 v0 = acc[ai][bj][m][0], v1 = acc[ai][bj][m][1];
                    u32x4 w; w.x = cvt_pk_bf16(v0[0], v0[1]); w.y = cvt_pk_bf16(v0[2], v0[3]); w.z = cvt_pk_bf16(v1[0], v1[1]); w.w = cvt_pk_bf16(v1[2], v1[3]);
                    *(u32x4*)(rowp + bj * HALF) = w; } }
    }
};
struct EpiBranch {
    static constexpr bool PERM = true, AFTER_DRAIN = false, KEEP_ACC = true, ALIGN = true, F16A = false;
    const unsigned char* G; bf16_t* O;
    static __device__ __forceinline__ f32x4 dec4(unsigned w) {
        return (f32x4){fmaf((float)(w & 0xffu), 0.00390625f, 0.001953125f), fmaf((float)((w >> 8) & 0xffu), 0.00390625f, 0.001953125f),
                       fmaf((float)((w >> 16) & 0xffu), 0.00390625f, 0.001953125f), fmaf((float)(w >> 24), 0.00390625f, 0.001953125f)}; }
    __device__ __forceinline__ void operator()(f32x4 (&acc)[2][2][4][2], const Unit& u, int wr, int wc, int fr, int fq) const {
        const int row0 = u.pm * BM + wr * 64 + fr, col0 = u.pn * BM + wc * 32 + 8 * fq;
        const bool mid = u.z < 2;
        const unsigned char* g0p = G + (size_t)u.z * D + col0; const unsigned char* g1p = G + (size_t)(mid ? u.z + 1 : u.z) * D + col0;
        u32x2 gq[2][2][2];
#pragma unroll
        for (int bj = 0; bj < 2; ++bj) { gq[0][bj][0] = *(const u32x2*)(g0p + (size_t)row0 * GATEC + bj * HALF); if (mid) gq[0][bj][1] = *(const u32x2*)(g1p + (size_t)row0 * GATEC + bj * HALF); }
#pragma unroll
        for (int gi = 0; gi < 8; ++gi) {
            const int ai = gi >> 2, m = gi & 3; const size_t row = (size_t)(row0 + ai * HALF + m * 16);
            if (gi + 1 < 8) { const size_t row1 = (size_t)(row0 + ((gi + 1) >> 2) * HALF + ((gi + 1) & 3) * 16);
#pragma unroll
                for (int bj = 0; bj < 2; ++bj) { gq[(gi + 1) & 1][bj][0] = *(const u32x2*)(g0p + row1 * GATEC + bj * HALF); if (mid) gq[(gi + 1) & 1][bj][1] = *(const u32x2*)(g1p + row1 * GATEC + bj * HALF); } }
            asm volatile("" ::: "memory");
#pragma unroll
            for (int bj = 0; bj < 2; ++bj) {
                const int col = col0 + bj * HALF;
                const u32x2 gw = gq[gi & 1][bj][0];
                f32x4 g0 = dec4(gw.x), g1 = dec4(gw.y);
                if (mid) {
                    const u32x2 nw = gq[gi & 1][bj][1];
                    const f32x4 n0 = dec4(nw.x), n1 = dec4(nw.y);
#pragma unroll
                    for (int j = 0; j < 4; ++j) { g0[j] *= fast_rcp(n0[j]); g1[j] *= fast_rcp(n1[j]); }
                    acc[ai][bj][m][0] *= g0; acc[ai][bj][m][1] *= g1;
                } else {
                    const f32x4 v0 = g0 * acc[ai][bj][m][0], v1 = g1 * acc[ai][bj][m][1];
                    u32x4 w; w.x = cvt_pk_bf16(v0[0], v0[1]); w.y = cvt_pk_bf16(v0[2], v0[3]); w.z = cvt_pk_bf16(v1[0], v1[1]); w.w = cvt_pk_bf16(v1[2], v1[3]);
                    *(u32x4*)(O + row * D + col) = w; }
            }
            asm volatile("" : "+v"(acc[ai][0][m][0]), "+v"(acc[ai][0][m][1]), "+v"(acc[ai][1][m][0]), "+v"(acc[ai][1][m][1]));
        }
    }
};
}

template <bool F16>
__device__ __forceinline__ void tr_item(const float* W, int ldw, bf16_t* WT, int ldt, int k0, int n0, int c0, float scale, LAS float* scr, int lane) {
    float wv[32];
#pragma unroll
    for (int i = 0; i < 32; ++i) wv[i] = W[(size_t)(k0 + 2 * i + (lane >> 5)) * ldw + c0 + (lane & 31)];
#pragma unroll
    for (int i = 0; i < 32; ++i) scr[(2 * i + (lane >> 5)) * 33 + (lane & 31)] = wv[i];
    asm volatile("s_waitcnt lgkmcnt(0)" ::: "memory");
    const int c = lane & 7;
#pragma unroll
    for (int j = 0; j < 4; ++j) { const int n = (lane >> 3) + 8 * j; const LAS float* sp = scr + (8 * c) * 33 + n;
        u32x4 o;
        if (F16) { o.x = cvt_pk_h(sp[0 * 33] * scale, sp[1 * 33] * scale); o.y = cvt_pk_h(sp[2 * 33] * scale, sp[3 * 33] * scale); o.z = cvt_pk_h(sp[4 * 33] * scale, sp[5 * 33] * scale); o.w = cvt_pk_h(sp[6 * 33] * scale, sp[7 * 33] * scale); }
        else { o.x = cvt_pk_bf16(sp[0 * 33] * scale, sp[1 * 33] * scale); o.y = cvt_pk_bf16(sp[2 * 33] * scale, sp[3 * 33] * scale); o.z = cvt_pk_bf16(sp[4 * 33] * scale, sp[5 * 33] * scale); o.w = cvt_pk_bf16(sp[6 * 33] * scale, sp[7 * 33] * scale); }
        *(u32x4*)(WT + (size_t)(n0 + n) * ldt + k0 + 8 * c) = o; }
    asm volatile("s_waitcnt lgkmcnt(0)" ::: "memory");
}
template <int MODE>
__device__ __forceinline__ void tr_matrix(const float* W, int K, int N, int ldw, bf16_t* WT, int ldt, LAS float* scr, int gw, int ngw, int lane) {
    const int nblk = N / 32, nitems = (K / 64) * nblk;
    for (int it = gw; it < nitems; it += ngw) {
        const int kb = it / nblk, nb = it - kb * nblk, n0 = nb * 32; int c0 = n0; float scale = 1.f;
        if (MODE == 1) { const int tile = n0 >> 8, bj = (n0 >> 7) & 1, c = n0 & 127; c0 = bj * DFF + tile * 128 + c; scale = bj ? 0.6931471805599453f : LOG2E; }
        if (MODE == 2) { if (n0 < 512 || (n0 >= 768 && n0 < 1280)) scale = 0.125f * LOG2E; else if (n0 >= 2304 && n0 < 2816) scale = 0.08838834764831845f * LOG2E; else if (n0 >= 2816) scale = -LOG2E; }
        tr_item<(MODE == 1 || MODE == 2)>(W, ldw, WT, ldt, kb * 64, n0, c0, scale, scr, lane);
    }
}

struct AttnP {
    const bf16_t *q, *k, *v; bf16_t* o; float* lse;
    int q_rs, q_toff, kv_rs, o_rs, o_toff, lse_rs, lse_toff;
    int qpos0, qpos_tstep, k_lo, nsteps, sub_len, radius;
    float slope2, slope_tmul;
    float sink2[4];
};
__device__ __forceinline__ s16x4 vtr(const LAS unsigned char* p) {
    typedef short v4i16_t __attribute__((ext_vector_type(4)));
    return __builtin_bit_cast(s16x4, __builtin_amdgcn_ds_read_tr16_b64_v4i16((LAS v4i16_t*)p));
}
template <int DH, int NT, int MODE>
__device__ __forceinline__ void attn_item(const AttnP& P, LAS unsigned char* vl, int lane_in, const LAS unsigned char* kl = nullptr) {
    int lane = lane_in; asm volatile("" : "+v"(lane));
    constexpr bool MASK = MODE < 2, SINK = MODE == 0, LSE = MODE == 1, INLDS = MODE == 3;
    constexpr int NSTEPS = MODE == 0 ? 9 : (MODE == 1 ? 6 : 8), QTSTEP = MODE == 1 ? 16 : 0;
    constexpr float RADF = MODE == 0 ? 128.f : 64.f, SLOPE_TMUL = MODE == 0 ? 0.5f : 1.0f;
    constexpr int KS = DH / 32, ND = DH / 16, VP = DH * 2 + 32, NVL = DH / 16;
    const int fr = lane & 15, g = lane >> 4;
    bf16x8 qf[NT][KS];
#pragma unroll
    for (int i = 0; i < NT; ++i)
#pragma unroll
        for (int ks = 0; ks < KS; ++ks) qf[i][ks] = *(const bf16x8*)(P.q + (size_t)i * P.q_toff + (size_t)fr * P.q_rs + ks * 32 + g * 8);
    f32x4 o[NT][ND]; float mrun[NT], lrun[NT];
#pragma unroll
    for (int i = 0; i < NT; ++i) {
#pragma unroll
        for (int d = 0; d < ND; ++d) o[i][d] = (f32x4){0.f, 0.f, 0.f, 0.f};
        mrun[i] = SINK ? P.sink2[i] : -1e30f; lrun[i] = (SINK && g == 0) ? 1.f : 0.f; }
    bf16x8 kf[2][KS]; u32x4 vr[NVL];
    constexpr int CPR = DH / 8;
    const int kmax = P.sub_len - 1, klo = P.k_lo, kvrs = P.kv_rs;
    const bf16_t* kbase = P.k + g * 8; const bf16_t* vbase = P.v;
    if (!INLDS) {
#pragma unroll
        for (int a = 0; a < 2; ++a) { int kp = klo + 16 * a + fr; kp = kp < 0 ? 0 : (kp > kmax ? kmax : kp);
#pragma unroll
            for (int ks = 0; ks < KS; ++ks) kf[a][ks] = *(const bf16x8*)(kbase + (size_t)kp * kvrs + ks * 32); }
#pragma unroll
        for (int it = 0; it < NVL; ++it) { const int idx = it * 64 + lane, r = idx / CPR, ch = idx % CPR; int kp = klo + r; kp = kp < 0 ? 0 : (kp > kmax ? kmax : kp);
            vr[it] = *(const u32x4*)(vbase + (size_t)kp * kvrs + ch * 8); }
    }
    const LAS unsigned char* vrd = vl + (4 * g + (fr >> 2)) * VP + 8 * (fr & 3);
    const float qbase = (float)(4 * g - P.qpos0 - fr);
    for (int s = 0; s < NSTEPS; ++s) {
        const int k0 = klo + 32 * s;
        asm volatile("" ::: "memory");
        bf16x8 kc[2][KS];
        if (INLDS) {
#pragma unroll
            for (int a = 0; a < 2; ++a)
#pragma unroll
                for (int ks = 0; ks < KS; ++ks) kc[a][ks] = *(const LAS bf16x8*)(kl + (32 * s + 16 * a + fr) * VP + (ks * 32 + 8 * g) * 2);
        } else {
#pragma unroll
        for (int it = 0; it < NVL; ++it) { const int idx = it * 64 + lane, r = idx / CPR, ch = idx % CPR; *(LAS u32x4*)(vl + r * VP + ch * 16) = vr[it]; }
#pragma unroll
        for (int a = 0; a < 2; ++a)
#pragma unroll
            for (int ks = 0; ks < KS; ++ks) kc[a][ks] = kf[a][ks];
        }
        if (!INLDS && s + 1 < NSTEPS) {
            const int k1 = k0 + 32;
#pragma unroll
            for (int a = 0; a < 2; ++a) { int kp = k1 + 16 * a + fr; kp = kp < 0 ? 0 : (kp > kmax ? kmax : kp);
#pragma unroll
                for (int ks = 0; ks < KS; ++ks) kf[a][ks] = *(const bf16x8*)(kbase + (size_t)kp * kvrs + ks * 32); }
#pragma unroll
            for (int it = 0; it < NVL; ++it) { const int idx = it * 64 + lane, r = idx / CPR, ch = idx % CPR; int kp = k1 + r; kp = kp < 0 ? 0 : (kp > kmax ? kmax : kp);
                vr[it] = *(const u32x4*)(vbase + (size_t)kp * kvrs + ch * 8); }
        }
        asm volatile("s_waitcnt lgkmcnt(0)" ::: "memory");
        const bool edge = (k0 < 0) || (k0 + 31 > kmax);
        const float kf0 = (float)k0 + qbase;
        float koff[2][4];
#pragma unroll
        for (int a = 0; a < 2; ++a)
#pragma unroll
            for (int r = 0; r < 4; ++r) { koff[a][r] = (float)(16 * a + r); if (MASK && edge) { const int kp = k0 + 16 * a + 4 * g + r; if (kp < 0 || kp > kmax) koff[a][r] = INFINITY; } }
        bf16x8 pf[NT]; float alv[NT]; bool act[NT];
#pragma unroll
        for (int i = 0; i < NT; ++i) {
            act[i] = !(MODE == 1) || (s >= (i >> 1) && s <= (i >> 1) + 4);
            if (!act[i]) { alv[i] = 1.0f; continue; }
            f32x4 sc[2];
#pragma unroll
            for (int a = 0; a < 2; ++a) { sc[a] = (f32x4){0.f, 0.f, 0.f, 0.f};
#pragma unroll
                for (int ks = 0; ks < KS; ++ks) sc[a] = __builtin_amdgcn_mfma_f32_16x16x32_bf16(kc[a][ks], qf[i][ks], sc[a], 0, 0, 0); }
            if (MASK) {
                float slope = P.slope2;
#pragma unroll
                for (int t = 0; t < i; ++t) slope *= SLOPE_TMUL;
                const float base = kf0 - (float)(i * QTSTEP);
#pragma unroll
                for (int a = 0; a < 2; ++a)
#pragma unroll
                    for (int r = 0; r < 4; ++r) { const float ad = fabsf(base + koff[a][r]);
                        sc[a][r] = (ad <= RADF) ? fmaf(-slope, ad, sc[a][r]) : -INFINITY; }
            }
            float mx = fmaxf(fmaxf(fmaxf(sc[0][0], sc[0][1]), fmaxf(sc[0][2], sc[0][3])), fmaxf(fmaxf(sc[1][0], sc[1][1]), fmaxf(sc[1][2], sc[1][3])));
            mx = rowgrp_max(mx);
            const float mnew = fmaxf(mrun[i], mx); alv[i] = fast_exp2(mrun[i] - mnew);
            mrun[i] = mnew;
            float ps = 0.f;
#pragma unroll
            for (int a = 0; a < 2; ++a)
#pragma unroll
                for (int r = 0; r < 4; ++r) { const float p = fast_exp2(sc[a][r] - mnew); sc[a][r] = p; ps += p; }
            lrun[i] = lrun[i] * alv[i] + ps;
            union { bf16x8 v; unsigned u[4]; } pk;
            pk.u[0] = cvt_pk_bf16(sc[0][0], sc[0][1]); pk.u[1] = cvt_pk_bf16(sc[0][2], sc[0][3]); pk.u[2] = cvt_pk_bf16(sc[1][0], sc[1][1]); pk.u[3] = cvt_pk_bf16(sc[1][2], sc[1][3]);
            pf[i] = pk.v;
        }
        bool resc[NT];
#pragma unroll
        for (int i = 0; i < NT; ++i) resc[i] = act[i];
#pragma unroll
        for (int d = 0; d < ND; ++d) {
            const LAS unsigned char* vs = INLDS ? vrd + s * 32 * VP : vrd;
            const s16x4 lo = vtr(vs + d * 32), hi = vtr(vs + 16 * VP + d * 32);
            const bf16x8 vt = (bf16x8){lo[0], lo[1], lo[2], lo[3], hi[0], hi[1], hi[2], hi[3]};
#pragma unroll
            for (int i = 0; i < NT; ++i) { if (resc[i]) o[i][d] = o[i][d] * alv[i]; if (act[i]) o[i][d] = __builtin_amdgcn_mfma_f32_16x16x32_bf16(vt, pf[i], o[i][d], 0, 0, 0); }
        }
        asm volatile("" ::: "memory");
    }
#pragma unroll
    for (int i = 0; i < NT; ++i) {
        const float l = rowgrp_sum(lrun[i]);
        const float inv = 1.0f / l;
        bf16_t* orow = P.o + (size_t)i * P.o_toff + (size_t)fr * P.o_rs + 4 * g;
#pragma unroll
        for (int d = 0; d < ND; ++d) { u32x2 w; w.x = cvt_pk_bf16(o[i][d][0] * inv, o[i][d][1] * inv); w.y = cvt_pk_bf16(o[i][d][2] * inv, o[i][d][3] * inv); *(u32x2*)(orow + 16 * d) = w; }
        if (LSE) { if (g == 0) P.lse[(size_t)i * P.lse_toff + (size_t)fr * P.lse_rs] = mrun[i] + __log2f(l); }
    }
}

struct Args {
    const float* in[19];
    float* out; unsigned char* ws;
};

__global__ void __launch_bounds__(512, 2) mega_fwd(Args args) {
    extern __shared__ __attribute__((aligned(16))) unsigned char lds_raw[];
    LAS unsigned char* lds = (LAS unsigned char*)lds_raw;
    cg::grid_group grid = cg::this_grid();
    const int G = gridDim.x, bx = blockIdx.x;
    volatile LAS unsigned* MISC = (volatile LAS unsigned*)(lds + LDS_MISC);
    if (threadIdx.x < 32) MISC[threadIdx.x] = 0u;
    __syncthreads();
    grid.sync();
    const XcdBarrier bar = xcd_barrier_post((unsigned*)(args.ws + WS_CTL), MISC + 8);
    constexpr int PH_PER_CHUNK = NLAYER * 9, NPH = 2 + NCHUNK * PH_PER_CHUNK;
    for (int ph_i = 0; ph_i < NPH; ++ph_i) {
        int ph = ph_i; asm volatile("" : "+s"(ph));
        int lane = threadIdx.x & 63; asm volatile("" : "+v"(lane));
        const int wave = __builtin_amdgcn_readfirstlane(threadIdx.x >> 6);
        const int vcu = (G % 8 == 0) ? (bx % 8) * (G / 8) + bx / 8 : bx;
        const int gw = vcu * 8 + wave, NGW = G * 8;
        unsigned char* ws = args.ws;
        bf16_t* Wb = (bf16_t*)(ws + WS_W); bf16_t* Wmem = (bf16_t*)(ws + WS_WMEM); bf16_t* memb = (bf16_t*)(ws + WS_MEMB); bf16_t* memkv = (bf16_t*)(ws + WS_MEMKV);
        bf16_t* hb = (bf16_t*)(ws + WS_U + U_H); bf16_t* proj = (bf16_t*)(ws + WS_U + U_PROJ); unsigned char* gates = (unsigned char*)(ws + WS_U + U_GATES); bf16_t* br = (bf16_t*)(ws + WS_U + U_BR);
        bf16_t* bpart = (bf16_t*)(ws + WS_U + U_BPART); float* lseb = (float*)(ws + WS_U + U_LSE); float* mixf = (float*)(ws + WS_U + U_MIXF); bf16_t* mixb = (bf16_t*)(ws + WS_U + U_MIXB);
        int load_chunk = -1;
        if (ph == 0) { for (int rep = 0; rep < REP_PRO; ++rep) {
            LAS float* scr = (LAS float*)(lds + wave * 16384);
            for (int l = 0; l < NLAYER; ++l) {
                bf16_t* WL = Wb + (size_t)l * W_LAYER_ELEMS;
                tr_matrix<1>(args.in[4] + (size_t)l * D * 2 * DFF, D, 2 * DFF, 2 * DFF, WL + OFF_W1IN, D, scr, gw, NGW, lane);
                tr_matrix<0>(args.in[5] + (size_t)l * DFF * D, DFF, D, D, WL + OFF_W1OUT, DFF, scr, gw, NGW, lane);
                tr_matrix<2>(args.in[8] + (size_t)l * D * INC, D, INC, INC, WL + OFF_WIN, D, scr, gw, NGW, lane);
                tr_matrix<0>(args.in[9] + (size_t)l * D * 1024, D, 1024, 1024, Wmem + (size_t)l * 1024 * D, D, scr, gw, NGW, lane);
                for (int i = 0; i < 3; ++i) tr_matrix<0>(args.in[11] + ((size_t)l * 3 + i) * 512 * D, 512, D, D, WL + OFF_WBR + (size_t)i * D * 512, 512, scr, gw, NGW, lane);
                tr_matrix<0>(args.in[12] + (size_t)l * D * D, D, D, D, WL + OFF_WOUT, D, scr, gw, NGW, lane);
                tr_matrix<1>(args.in[15] + (size_t)l * D * 2 * DFF, D, 2 * DFF, 2 * DFF, WL + OFF_W2IN, D, scr, gw, NGW, lane);
                tr_matrix<0>(args.in[16] + (size_t)l * DFF * D, DFF, D, D, WL + OFF_W2OUT, DFF, scr, gw, NGW, lane);
            }
            for (int m = gw; m < MEMROWS; m += NGW) {
                const float* src = (m < 4096) ? args.in[2] + (size_t)m * D : args.in[3] + (size_t)(m - 4096) * D;
#pragma unroll
                for (int j = 0; j < 4; ++j) { const f32x4 v = *((const f32x4*)src + lane + 64 * j); u32x2 w; w.x = cvt_pk_bf16(v[0], v[1]); w.y = cvt_pk_bf16(v[2], v[3]); *((u32x2*)(memb + (size_t)m * D) + lane + 64 * j) = w; }
            } }
            load_chunk = 0;
        } else if (ph == 1) {
            pg8::Gemm g{memb, Wmem, MEMROWS, 2048, D, D, D, 0, 0}; pg8::Order S; S.init(MEMROWS, 2048, 1, G, bx);
            pg8::EpiBf16Plain E{memkv, 2048};
            pg8::gemm_phase(lds, g, S, E);
        } else {
            const int q = ph - 2, c = q / PH_PER_CHUNK, r = q - c * PH_PER_CHUNK;
            const bool is_prompt = c < 2;
            float* X = args.out + (size_t)c * TC * D;
            const int L = is_prompt ? 2048 : 8192;
            bf16_t* xb = (bf16_t*)(ws + ((c & 1) ? WS_XB : WS_X16));
            {
                const int l = r / 9, k = r - l * 9;
                const bf16_t* WL = Wb + (size_t)l * W_LAYER_ELEMS;
                if (k == 0 || k == 7) {
                    pg8::Gemm g{xb, WL + (k == 0 ? OFF_W1IN : OFF_W2IN), TC, 2 * DFF, D, D, D, 0, 0}; pg8::Order S; S.init(TC, 2 * DFF, 1, G, bx); pg8::EpiSwiglu E{hb, DFF}; for (int rep = 0; rep < REP_UP; ++rep) pg8::gemm_phase(lds, g, S, E);
                } else if (k == 1 || k == 8 || k == 6) {
                    const bool ffn = (k != 6); const int sidx = (k == 1) ? 0 : (k == 6 ? 1 : 2);
                    const bool last = (l == NLAYER - 1 && k == 8);
                    pg8::Gemm g{ffn ? hb : mixb, WL + (k == 1 ? OFF_W1OUT : (k == 8 ? OFF_W2OUT : OFF_WOUT)), TC, D, ffn ? DFF : D, ffn ? DFF : D, ffn ? DFF : D, 0, 0};
                    pg8::Order S; S.init(TC, D, 1, G, bx);
                    const int nuse = (c * NLAYER + l) * 3 + sidx;
                    pg8::EpiResidLN E{last ? X : nullptr, xb, args.in[sidx == 0 ? 6 : (sidx == 1 ? 13 : 17)] + l * D, args.in[sidx == 0 ? 7 : (sidx == 1 ? 14 : 18)] + l * D, ffn ? 0.5f : 1.0f,
                                      (unsigned long long*)(ws + WS_CTL + CTL_XBUF), (unsigned*)(ws + WS_CTL + 16384), 32u * (unsigned)(nuse + 1)};
                    pg8::gemm_phase(lds, g, S, E);
                    if (last && c + 1 < NCHUNK) load_chunk = c + 1;
                } else if (k == 2) {
                    pg8::Gemm g{xb, WL + OFF_WIN, TC, INC, D, D, D, 0, 0}; pg8::Order S; S.init(TC, INC, 1, G, bx); pg8::EpiInproj E{proj, gates}; for (int rep = 0; rep < REP_INPROJ; ++rep) pg8::gemm_phase(lds, g, S, E);
                } else if (k == 3) {
                    LAS unsigned char* vl = lds + wave * 9216;
                    const float* sink = args.in[10] + l * 8;
                    const int memrow0 = is_prompt ? c * 8 * NMEM : 4096 + (c - 2) * 2 * NMEM;
                    for (int rep = 0; rep < REP_ATT; ++rep) {
                    for (int u = vcu; u < 256; u += G) {
                        const int nqb = L / 256; const int qb = u % nqb, hh = (u / nqb) & 3, sq = u / (nqb * 4);
                        const bf16_t* mb = memkv + (size_t)(memrow0 + sq * NMEM) * 2048 + l * 1024 + hh * 128;
                        __syncthreads();
#pragma unroll 2
                        for (int j = 0; j < 8; ++j) { const int idx = j * 512 + (int)threadIdx.x, rrow = idx >> 4, pc = idx & 15;
                            const u32x4 kv = *(const u32x4*)(mb + (size_t)rrow * 2048 + pc * 8), vv = *(const u32x4*)(mb + 512 + (size_t)rrow * 2048 + pc * 8);
                            *(LAS u32x4*)(lds + rrow * 288 + pc * 16) = kv; *(LAS u32x4*)(lds + 73728 + rrow * 288 + pc * 16) = vv; }
                        __syncthreads();
                        AttnP P;
                        const int tok0 = sq * L + qb * 256 + wave * 32;
                        P.q = proj + (size_t)tok0 * PROJC + 2304 + hh * 128; P.q_rs = PROJC; P.q_toff = 16 * PROJC;
                        P.k = mb; P.v = mb + 512; P.kv_rs = 2048;
                        P.o = br + (size_t)tok0 * BRC + 1024 + hh * 128; P.o_rs = BRC; P.o_toff = 16 * BRC; P.lse = nullptr; P.lse_rs = 0; P.lse_toff = 0;
                        P.qpos0 = 0; P.qpos_tstep = 0; P.k_lo = 0; P.nsteps = 8; P.sub_len = NMEM; P.radius = 1 << 20;
                        P.slope2 = 0.f; P.slope_tmul = 1.f;
#pragma unroll
                        for (int i = 0; i < 4; ++i) P.sink2[i] = 0.f;
                        attn_item<128, 2, 3>(P, lds + 73728, lane, lds);
                    }
                    __syncthreads();
                    for (int it = gw; it < 4 * 2048; it += NGW) {
                        const int type = it >> 11, id = it & 2047;
                        AttnP P;
                        if (type == 0) {
                            const int hk = id & 1, tb = id >> 1; const int tok0 = tb * 16; const int sq = tok0 / L, pos0 = tok0 - sq * L;
                            const bf16_t* base = proj + (size_t)(sq * L) * PROJC;
                            P.q = proj + (size_t)tok0 * PROJC + hk * 256; P.q_rs = PROJC; P.q_toff = 64;
                            P.k = base + 512 + hk * 64; P.v = base + 512 + 128 + hk * 64; P.kv_rs = PROJC;
                            P.o = br + (size_t)tok0 * BRC + hk * 256; P.o_rs = BRC; P.o_toff = 64; P.lse = nullptr; P.lse_rs = 0; P.lse_toff = 0;
                            P.qpos0 = pos0; P.qpos_tstep = 0; P.k_lo = pos0 - 128; P.nsteps = 9; P.sub_len = L; P.radius = 128;
                            P.slope2 = LOG2E * fast_exp2(-(float)(hk * 4 + 1)); P.slope_tmul = 0.5f;
#pragma unroll
                            for (int i = 0; i < 4; ++i) P.sink2[i] = sink[hk * 4 + i] * LOG2E;
                            attn_item<64, 4, 0>(P, vl, lane);
                        } else {
                            const int cfg = type - 1, dil = cfg == 0 ? 1 : (cfg == 1 ? 4 : 16);
                            const int h = id & 7, blk = id >> 3;
                            const int sub_len = L / dil, bps = sub_len / 64;
                            const int sr = blk / bps, jb = blk - sr * bps; const int sq = sr / dil, rs = sr - sq * dil; const int j0 = jb * 64;
                            const bf16_t* base = proj + (size_t)(sq * L + rs) * PROJC + 768 + h * 64;
                            const size_t tok0 = (size_t)sq * L + rs + (size_t)j0 * dil;
                            P.q = proj + tok0 * PROJC + 768 + h * 64; P.q_rs = PROJC * dil; P.q_toff = 16 * PROJC * dil;
                            P.k = base + 512; P.v = base + 1024; P.kv_rs = PROJC * dil;
                            P.o = bpart + (size_t)cfg * TC * 512 + tok0 * 512 + h * 64; P.o_rs = 512 * dil; P.o_toff = 16 * 512 * dil;
                            P.lse = lseb + (size_t)cfg * TC * 8 + tok0 * 8 + h; P.lse_rs = 8 * dil; P.lse_toff = 16 * 8 * dil;
                            P.qpos0 = j0; P.qpos_tstep = 16; P.k_lo = j0 - 64; P.nsteps = 6; P.sub_len = sub_len; P.radius = 64;
                            P.slope2 = LOG2E * fast_exp2(-(float)(h + 1)) * (float)dil; P.slope_tmul = 1.0f;
#pragma unroll
                            for (int i = 0; i < 4; ++i) P.sink2[i] = 0.f;
                            attn_item<64, 4, 1>(P, vl, lane);
                        }
                    }
                    }
                } else if (k == 4) {
                    for (int rep = 0; rep < REP_CMB; ++rep) for (int m0 = gw; m0 < TC; m0 += 4 * NGW) {
                        const int h = lane >> 3;
                        float l0[4], l1[4], l2[4]; u32x4 a[4], b[4], cc[4];
#pragma unroll
                        for (int r = 0; r < 4; ++r) { const int mm = m0 + r * NGW; const size_t m = (size_t)(mm < TC ? mm : m0);
                            l0[r] = lseb[m * 8 + h]; l1[r] = lseb[(size_t)TC * 8 + m * 8 + h]; l2[r] = lseb[(size_t)2 * TC * 8 + m * 8 + h];
                            a[r] = *((const u32x4*)(bpart + m * 512) + lane); b[r] = *((const u32x4*)(bpart + (size_t)TC * 512 + m * 512) + lane); cc[r] = *((const u32x4*)(bpart + (size_t)2 * TC * 512 + m * 512) + lane); }
#pragma unroll
                        for (int r = 0; r < 4; ++r) { const int mm = m0 + r * NGW; if (mm >= TC) continue;
                            const float mx = fmaxf(l0[r], fmaxf(l1[r], l2[r])); float w0 = fast_exp2(l0[r] - mx), w1 = fast_exp2(l1[r] - mx), w2 = fast_exp2(l2[r] - mx); const float inv = 1.0f / (w0 + w1 + w2); w0 *= inv; w1 *= inv; w2 *= inv;
                            u32x4 w;
                            w.x = cvt_pk_bf16(w0 * bf_lo(a[r].x) + w1 * bf_lo(b[r].x) + w2 * bf_lo(cc[r].x), w0 * bf_hi(a[r].x) + w1 * bf_hi(b[r].x) + w2 * bf_hi(cc[r].x));
                            w.y = cvt_pk_bf16(w0 * bf_lo(a[r].y) + w1 * bf_lo(b[r].y) + w2 * bf_lo(cc[r].y), w0 * bf_hi(a[r].y) + w1 * bf_hi(b[r].y) + w2 * bf_hi(cc[r].y));
                            w.z = cvt_pk_bf16(w0 * bf_lo(a[r].z) + w1 * bf_lo(b[r].z) + w2 * bf_lo(cc[r].z), w0 * bf_hi(a[r].z) + w1 * bf_hi(b[r].z) + w2 * bf_hi(cc[r].z));
                            w.w = cvt_pk_bf16(w0 * bf_lo(a[r].w) + w1 * bf_lo(b[r].w) + w2 * bf_lo(cc[r].w), w0 * bf_hi(a[r].w) + w1 * bf_hi(b[r].w) + w2 * bf_hi(cc[r].w));
                            *((u32x4*)(br + (size_t)mm * BRC + 512) + lane) = w; }
                    }
                } else {
                    pg8::Gemm g{br, WL + OFF_WBR, TC, D, 512, BRC, 512, 512, (size_t)D * 512}; pg8::Order S; S.init(TC, D, 3, G, bx); pg8::EpiBranch E{gates, mixb}; for (int rep = 0; rep < REP_BR; ++rep) pg8::gemm_phase(lds, g, S, E);
                }
            }
        }
        if (load_chunk >= 0) {
            const float* xin = load_chunk < 2 ? args.in[0] + (size_t)load_chunk * TC * D : args.in[1] + (size_t)(load_chunk - 2) * TC * D;
            bf16_t* xnext = (bf16_t*)(ws + ((load_chunk & 1) ? WS_XB : WS_X16));
            for (int m0 = gw; m0 < TC; m0 += 4 * NGW) {
                f32x4 v[4][4];
#pragma unroll
                for (int r = 0; r < 4; ++r) { const int mm = m0 + r * NGW; const size_t m = (size_t)(mm < TC ? mm : m0);
#pragma unroll
                    for (int j = 0; j < 4; ++j) v[r][j] = *((const f32x4*)(xin + m * D) + lane + 64 * j); }
#pragma unroll
                for (int r = 0; r < 4; ++r) { const int mm = m0 + r * NGW; if (mm >= TC) continue;
#pragma unroll
                    for (int j = 0; j < 4; ++j) { u32x2 w; w.x = cvt_pk_h(v[r][j][0], v[r][j][1]); w.y = cvt_pk_h(v[r][j][2], v[r][j][3]); *((u32x2*)(xnext + (size_t)mm * D) + lane + 64 * j) = w; } }
            }
        }
        for (int rep = 0; rep < REP_SYNC; ++rep) xcd_barrier(bar);
    }
}

extern "C" void kernel_launch(void* const* d_in, const int* in_sizes, int n_in, void* d_out, int out_size, void* d_ws, size_t ws_size, hipStream_t stream) {
    static int grid = 0;
    if (grid == 0) {
        if (n_in != 19 || ws_size < WS_END) { fprintf(stderr, "kernel_launch: need 19 inputs and %zu bytes of workspace; got %d, %zu\n", (size_t)WS_END, n_in, ws_size); grid = -1; return; }
        int dev = 0, cus = 0, per_cu = 0;
        hipGetDevice(&dev); hipDeviceGetAttribute(&cus, hipDeviceAttributeMultiprocessorCount, dev);
        if (hipFuncSetAttribute((const void*)mega_fwd, hipFuncAttributeMaxDynamicSharedMemorySize, LDS_BYTES) != hipSuccess) { fprintf(stderr, "kernel_launch: hipFuncSetAttribute failed\n"); grid = -1; return; }
        if (hipOccupancyMaxActiveBlocksPerMultiprocessor(&per_cu, (const void*)mega_fwd, 512, LDS_BYTES) != hipSuccess || per_cu < 1) { fprintf(stderr, "kernel_launch: occupancy query says %d\n", per_cu); per_cu = 1; }
        (void)hipGetLastError();
        grid = cus;
        if (grid != 256) { fprintf(stderr, "kernel_launch: built for a 256-CU device (fused LayerNorm epilogue needs one 256x256 unit per workgroup); got %d CUs\n", cus); grid = -1; return; }
    }
    if (grid < 0) return;
    if (hipMemsetAsync((char*)d_ws + WS_CTL, 0, CTL_BYTES, stream) != hipSuccess) { fprintf(stderr, "kernel_launch: memset failed\n"); return; }
    Args a{};
    for (int i = 0; i < 19; ++i) a.in[i] = (const float*)d_in[i];
    a.out = (float*)d_out; a.ws = (unsigned char*)d_ws;
    void* kargs[] = {&a};
    hipError_t e = hipLaunchCooperativeKernel((const void*)mega_fwd, dim3(grid), dim3(512), kargs, LDS_BYTES, stream);
    if (e != hipSuccess) fprintf(stderr, "cooperative launch failed: %s (grid %d)\n", hipGetErrorString(e), grid);
}
```
